# Optimizing an MI355X kernel written in HIP

```python
import math
import jax, jax.numpy as jnp
from jax import lax
import numpy as np

D_MODEL = 1024
BATCH = 8
SEQ = 4096
DEPTH = 4

HEAD_DIM = 64
D_ATTN = D_MODEL // 2
D_RWKV = D_MODEL - D_ATTN
D_MIX = D_ATTN + D_RWKV
N_ATTN_HEADS = D_ATTN // HEAD_DIM
N_RWKV_HEADS = D_RWKV // HEAD_DIM
DILATED_BRANCHES = ((128, 1), (512, 4), (2048, 16))
Q_BLOCK = 128
LORA_DECAY = 32
LORA_AAA = 32
LORA_MV = 32
LORA_GATE = 96
D_FF = 4 * D_MODEL
NORM_EPS = 1e-6
GN_EPS = 64e-5
N_SHIFT = 3 * D_RWKV + LORA_DECAY + LORA_AAA + LORA_GATE
N_COLS_FIRST = 3 * D_ATTN + N_SHIFT
N_COLS_REST = N_COLS_FIRST + LORA_MV

kernel_name = "hybrid_dilated_attn_rwkv7_sandwich"


def _rms_norm(x, g):
    xf = x.astype(jnp.float32)
    y = xf * lax.rsqrt(jnp.mean(xf * xf, axis=-1, keepdims=True) + NORM_EPS)
    return (y * g.astype(jnp.float32)).astype(x.dtype)


def _token_shift(z, mu):
    prev = jnp.pad(z, ((0, 0), (1, 0), (0, 0)))[:, :-1]
    return z + (prev - z) * mu


def _dilated_branch(q, k, v, window, dilation):
    B, S, H, Dh = q.shape
    L = S // dilation
    K = window // dilation
    qb = math.gcd(L, Q_BLOCK)
    nb = L // qb

    def phase(t):
        return t.reshape(B, L, dilation, H, Dh).transpose(0, 2, 3, 1, 4)

    qs, ks, vs = phase(q), phase(k), phase(v)
    pad = ((0, 0), (0, 0), (0, 0), (K, 0), (0, 0))
    kp, vp = jnp.pad(ks, pad), jnp.pad(vs, pad)
    idx = jnp.arange(nb)[:, None] * qb + jnp.arange(qb + K)[None, :]
    kb = kp[:, :, :, idx, :]
    vb = vp[:, :, :, idx, :]
    qblk = qs.reshape(B, dilation, H, nb, qb, Dh)
    s = jnp.einsum('bdhnqc,bdhnkc->bdhnqk', qblk, kb) * (1.0 / math.sqrt(Dh))
    j = jnp.arange(qb)[:, None]
    m_idx = jnp.arange(qb + K)[None, :]
    dist = j + K - m_idx
    blk = jnp.arange(nb)[:, None, None]
    valid = (dist >= 0) & (dist <= K) & (blk * qb + m_idx - K >= 0)
    s = jnp.where(valid, s, -jnp.inf)
    m = jnp.max(s, axis=-1)
    p = jnp.exp(s - m[..., None])
    l = jnp.sum(p, axis=-1)
    acc = jnp.einsum('bdhnqk,bdhnkc->bdhnqc', p, vb)
    acc = acc.reshape(B, dilation, H, L, Dh).transpose(0, 3, 1, 2, 4).reshape(B, S, H, Dh)
    m = m.reshape(B, dilation, H, L).transpose(0, 3, 1, 2).reshape(B, S, H)
    l = l.reshape(B, dilation, H, L).transpose(0, 3, 1, 2).reshape(B, S, H)
    return m, l, acc


def _dilated_attention(q, k, v):
    B, S, _ = q.shape
    heads = lambda t: t.astype(jnp.float32).reshape(B, S, N_ATTN_HEADS, HEAD_DIM)
    qh, kh, vh = heads(q), heads(k), heads(v)
    outs = [_dilated_branch(qh, kh, vh, w, d) for (w, d) in DILATED_BRANCHES]
    m_all = jnp.maximum(jnp.maximum(outs[0][0], outs[1][0]), outs[2][0])
    num = sum(jnp.exp(m - m_all)[..., None] * acc for (m, l, acc) in outs)
    den = sum(jnp.exp(m - m_all) * l for (m, l, acc) in outs)
    o = num / den[..., None]
    return o.reshape(B, S, D_ATTN).astype(q.dtype)


def _rwkv7_scan(r, w, k, v, kk, b):
    B, S, H, N = r.shape

    def step(state, inp):
        r_t, w_t, k_t, v_t, kk_t, b_t = inp
        sa = jnp.einsum('bhij,bhj->bhi', state, kk_t)
        state = (state * w_t[:, :, None, :]
                 - sa[..., None] * b_t[:, :, None, :]
                 + v_t[..., None] * k_t[:, :, None, :])
        y = jnp.einsum('bhij,bhj->bhi', state, r_t)
        return state, y

    xs = tuple(jnp.moveaxis(t, 1, 0) for t in (r, w, k, v, kk, b))
    state0 = jnp.zeros((B, H, N, N), jnp.float32)
    _, ys = lax.scan(step, state0, xs)
    return jnp.moveaxis(ys, 0, 1)


def _rwkv7(r, k, v, xw, xa, xg, w0, w_up, a0, a_up, g_up, k_k, k_a, r_k, gn_w, gn_b):
    B, S, _ = r.shape
    H, N = N_RWKV_HEADS, HEAD_DIM
    f32 = jnp.float32
    heads = lambda t: t.astype(f32).reshape(B, S, H, N)
    logw = -jax.nn.softplus(-(w0 + jnp.tanh(xw) @ w_up).astype(f32)) - 0.5
    decay = jnp.exp(-jnp.exp(logw))
    a = jax.nn.sigmoid((a0 + xa @ a_up).astype(f32))
    g = (jax.nn.sigmoid(xg) @ g_up).astype(f32)
    kk = heads(k * k_k)
    kk = kk / jnp.maximum(jnp.sqrt(jnp.sum(kk * kk, axis=-1, keepdims=True)), 1e-12)
    k_mod = k.astype(f32) * (1.0 + (a - 1.0) * k_a.astype(f32))
    rh, kh, vh, ah, wh = heads(r), heads(k_mod), heads(v), heads(a), heads(decay)
    y = _rwkv7_scan(rh, wh, kh, vh, kk, kk * ah)
    mean = jnp.mean(y, axis=-1, keepdims=True)
    var = jnp.mean(jnp.square(y - mean), axis=-1, keepdims=True)
    yn = ((y - mean) * lax.rsqrt(var + GN_EPS)).reshape(B, S, D_RWKV)
    yn = yn * gn_w.astype(f32) + gn_b.astype(f32)
    bonus = jnp.sum(rh * kh * r_k.astype(f32), axis=-1, keepdims=True) * vh
    out = (yn + bonus.reshape(B, S, D_RWKV)) * g
    return out.astype(r.dtype)


def setup_inputs(seed: int = 0) -> dict:
    key = jax.random.key(seed)
    ks = iter(jax.random.split(key, 40))
    f32 = jnp.float32
    nrm = lambda shape, scale: jax.random.normal(next(ks), shape, f32) * scale
    gain = lambda shape: 1.0 + nrm(shape, 0.05)
    L1 = DEPTH - 1
    return {
        "x": nrm((BATCH, SEQ, D_MODEL), 1.0),
        "norm_mix_pre": gain((DEPTH, D_MODEL)),
        "norm_mix_post": gain((DEPTH, D_MODEL)),
        "norm_ffn_pre": gain((DEPTH, D_MODEL)),
        "norm_ffn_post": gain((DEPTH, D_MODEL)),
        "w_in_first": nrm((D_MODEL, N_COLS_FIRST), D_MODEL ** -0.5),
        "w_in_rest": nrm((L1, D_MODEL, N_COLS_REST), D_MODEL ** -0.5),
        "mu_shift": jax.random.uniform(next(ks), (DEPTH, N_SHIFT), f32),
        "mu_shift_mv": jax.random.uniform(next(ks), (L1, LORA_MV), f32),
        "attn_out_gain": gain((DEPTH, D_ATTN)),
        "decay_w0": jax.random.uniform(next(ks), (DEPTH, D_RWKV), f32, -5.0, 0.0),
        "decay_up": nrm((DEPTH, LORA_DECAY, D_RWKV), 0.5 * LORA_DECAY ** -0.5),
        "aaa_a0": nrm((DEPTH, D_RWKV), 0.1),
        "aaa_up": nrm((DEPTH, LORA_AAA, D_RWKV), 0.5 * LORA_AAA ** -0.5),
        "mv_v0": nrm((L1, D_RWKV), 0.5),
        "mv_up": nrm((L1, LORA_MV, D_RWKV), 0.5 * LORA_MV ** -0.5),
        "gate_up": nrm((DEPTH, LORA_GATE, D_RWKV), LORA_GATE ** -0.5),
        "k_k": 0.85 + nrm((DEPTH, D_RWKV), 0.1),
        "k_a": 1.0 + nrm((DEPTH, D_RWKV), 0.1),
        "r_k": nrm((DEPTH, N_RWKV_HEADS, HEAD_DIM), 0.1),
        "gn_w": gain((DEPTH, D_RWKV)),
        "gn_b": nrm((DEPTH, D_RWKV), 0.02),
        "w_out": nrm((DEPTH, D_MIX, D_MODEL), D_MIX ** -0.5),
        "w_ffn_up": nrm((DEPTH, D_MODEL, D_FF), D_MODEL ** -0.5),
        "w_ffn_down": nrm((DEPTH, D_FF, D_MODEL), D_FF ** -0.5),
    }


def reference(x, norm_mix_pre, norm_mix_post, norm_ffn_pre, norm_ffn_post,
              w_in_first, w_in_rest, mu_shift, mu_shift_mv, attn_out_gain,
              decay_w0, decay_up, aaa_a0, aaa_up, mv_v0, mv_up, gate_up,
              k_k, k_a, r_k, gn_w, gn_b, w_out, w_ffn_up, w_ffn_down):
    v_first = None
    o0, o1, o2 = 3 * D_RWKV, 3 * D_RWKV + LORA_DECAY, 3 * D_RWKV + LORA_DECAY + LORA_AAA
    for i in range(DEPTH):
        h = _rms_norm(x, norm_mix_pre[i])
        z = h @ (w_in_first if i == 0 else w_in_rest[i - 1])
        q = z[..., 0:D_ATTN]
        k = z[..., D_ATTN:2 * D_ATTN]
        v = z[..., 2 * D_ATTN:3 * D_ATTN]
        zs = _token_shift(z[..., 3 * D_ATTN:3 * D_ATTN + N_SHIFT], mu_shift[i])
        r_r = zs[..., 0:D_RWKV]
        k_r = zs[..., D_RWKV:2 * D_RWKV]
        v_r = zs[..., 2 * D_RWKV:3 * D_RWKV]
        xw = zs[..., o0:o1]
        xa = zs[..., o1:o2]
        xg = zs[..., o2:N_SHIFT]
        if i == 0:
            v_first = v_r
        else:
            xmv = _token_shift(z[..., N_COLS_FIRST:], mu_shift_mv[i - 1])
            vgate = jax.nn.sigmoid(mv_v0[i - 1] + xmv @ mv_up[i - 1])
            v_r = v_r + (v_first - v_r) * vgate
        attn = _rms_norm(_dilated_attention(q, k, v), attn_out_gain[i])
        rw = _rwkv7(r_r, k_r, v_r, xw, xa, xg, decay_w0[i], decay_up[i], aaa_a0[i],
                    aaa_up[i], gate_up[i], k_k[i], k_a[i], r_k[i], gn_w[i], gn_b[i])
        mixed = jnp.concatenate([attn, rw], axis=-1) @ w_out[i]
        x = x + _rms_norm(mixed, norm_mix_post[i])
        h = _rms_norm(x, norm_ffn_pre[i])
        f = jnp.square(jax.nn.relu(h @ w_ffn_up[i])) @ w_ffn_down[i]
        x = x + _rms_norm(f, norm_ffn_post[i])
    return x
```

```cpp
#include <hip/hip_runtime.h>
#include <hip/hip_cooperative_groups.h>
#include <cstdio>
#include <cstdint>
namespace cg = cooperative_groups;
#ifndef MK_MULTI
#define MK_MULTI 0
#endif
namespace pg8 {
#define PG8_LAS __attribute__((address_space(3)))
typedef unsigned short bf16_t;
typedef short bf16x8 __attribute__((ext_vector_type(8)));
typedef float f32x4 __attribute__((ext_vector_type(4)));
typedef unsigned u32x4 __attribute__((ext_vector_type(4)));
constexpr int BM = 256, BK = 64, HALF = 128, HTB = HALF * BK * 2  , STAGE_BYTES = 8 * HTB, NXCD = 8, WGM = 8;

__host__ __device__ __forceinline__ int lds_byte(int r, int c) { const int st = (r >> 4) * 2 + (c >> 5), rr = r & 15, cc = c & 31, ob = rr * 64 + cc * 2; return st * 1024 + (ob ^ (((ob >> 9) & 1) << 5)); }
__host__ __device__ __forceinline__ void stage_rc(int b, int& R, int& C) { const int st = b / 1024, sb = b % 1024, swz = sb ^ (((sb >> 9) & 1) << 5); R = (st >> 1) * 16 + swz / 64; C = (st & 1) * 32 + (swz % 64) / 2; }
__host__ __device__ __forceinline__ int perm32(int rho) { const int n = rho >> 4, i = rho & 15; return 8 * (i >> 2) + 4 * n + (i & 3); }

struct Unit { int pm, pn; };
struct Gemm { const bf16_t* A; const bf16_t* Bt; int M, N, K; };
struct StaticOrder {
    int nM, nN, nwg, G, c;
    __host__ __device__ void init(int M, int N, int G_, int c_) { nM = M / BM; nN = N / BM; nwg = nM * nN; G = G_; c = c_; }
    __host__ __device__ bool next(int i, Unit& u) const {
        const long L = (long)i * G + c; if (L >= nwg) return false;
        int wgid = (int)L; { const int q = nwg / NXCD, r = nwg % NXCD, xcd = wgid % NXCD, off = wgid / NXCD; wgid = (xcd < r ? xcd * (q + 1) : r * (q + 1) + (xcd - r) * q) + off; }
        const int nig = WGM * nN, gid = wgid / nig, fm = gid * WGM, gsz = (nM - fm) < WGM ? (nM - fm) : WGM;
        u.pm = fm + ((wgid % nig) % gsz); u.pn = (wgid % nig) / gsz; return true;
    }
    __device__ __forceinline__ void a_ready(const Unit&) const {}
    __device__ __forceinline__ void done(const Unit&) const {}
};
__device__ __forceinline__ unsigned cvt_pk_bf16(float lo, float hi) { unsigned r; asm volatile("v_cvt_pk_bf16_f32 %0, %1, %2" : "=v"(r) : "v"(lo), "v"(hi)); return r; }
typedef float f32x2 __attribute__((ext_vector_type(2)));
__device__ __forceinline__ int mk_tid() { int t = threadIdx.x; asm volatile("" : "+v"(t)); return t; }
template <int ACT> struct EpiAct {
    static constexpr bool PERM = true, AFTER_DRAIN = false;
    bf16_t* O; int ldc;
    __device__ __forceinline__ void operator()(const f32x4 (&acc)[2][2][4][2], const Unit& u, int wr, int wc, int fr, int fq) const {
        const int row0 = u.pm * BM + wr * 64 + fr; const int col0 = u.pn * BM + wc * 32 + 8 * fq;
#pragma unroll
        for (int ai = 0; ai < 2; ++ai)
#pragma unroll
            for (int m = 0; m < 4; ++m) { bf16_t* rowp = O + (size_t)(row0 + ai * HALF + m * 16) * ldc + col0;
#pragma unroll
                for (int bj = 0; bj < 2; ++bj) { f32x4 v0 = acc[ai][bj][m][0], v1 = acc[ai][bj][m][1];
                    if (ACT == 1) {
#pragma unroll
                        for (int e = 0; e < 4; ++e) { float a = v0[e] > 0.f ? v0[e] : 0.f, b = v1[e] > 0.f ? v1[e] : 0.f; v0[e] = a * a; v1[e] = b * b; } }
                    u32x4 w; w.x = cvt_pk_bf16(v0[0], v0[1]); w.y = cvt_pk_bf16(v0[2], v0[3]); w.z = cvt_pk_bf16(v1[0], v1[1]); w.w = cvt_pk_bf16(v1[2], v1[3]);
                    *(u32x4*)(rowp + bj * HALF) = w; } }
    }
};
template <class Epi, class Sched, bool ALIGN_EPI = false, bool SP2 = false>
__device__ __forceinline__ void gemm_phase(PG8_LAS unsigned char* lds, const Gemm g, const Sched& S, const Epi& E) {
    const int tid = mk_tid(), wid = __builtin_amdgcn_readfirstlane(tid >> 6), lane = tid & 63, wr = wid >> 2, wc = wid & 3, fr = lane & 15, fq = lane >> 4;
    const int K = g.K, nt = K / BK;
    unsigned voffA[2], voffB[2];
#pragma unroll
    for (int i = 0; i < 2; ++i) { int R, C; stage_rc(tid * 16 + i * 8192, R, C); const int Rb = Epi::PERM ? ((R & ~31) + perm32(R & 31)) : R;
        voffA[i] = (unsigned)(R * K + C) * 2u; voffB[i] = (unsigned)(Rb * K + C) * 2u; }
    const size_t kstep = (size_t)(BK * 2);
    const size_t hstep = (size_t)HALF * K * 2;
    const size_t tstep = 2 * hstep;
    const unsigned ldsw = (unsigned)wid * 1024u;
    const int aoff = lds_byte(wr * 64 + fr, fq * 8), boff = lds_byte(wc * 32 + fr, fq * 8);
#define PG8_SA(b, h) (((b) * 2 + (h)) * HTB)
#define PG8_SB(b, h) ((4 + (b) * 2 + (h)) * HTB)
#define PG8_STAGE(bufoff, gbase, voff) do { _Pragma("unroll") for (int _i = 0; _i < 2; ++_i) \
        __builtin_amdgcn_global_load_lds((const unsigned*)((const char*)(gbase) + (voff)[_i]), (PG8_LAS unsigned*)(lds + (bufoff) + ldsw + _i * 8192), 16, 0, 0); } while (0)
#define PG8_LDA(dst, b, h) do { _Pragma("unroll") for (int m = 0; m < 4; ++m) _Pragma("unroll") for (int k = 0; k < 2; ++k) dst[m][k] = *(const PG8_LAS bf16x8*)(lds + PG8_SA(b, h) + aoff + m * 2048 + k * 1024); } while (0)
#define PG8_LDB(dst, b, h) do { _Pragma("unroll") for (int n = 0; n < 2; ++n) _Pragma("unroll") for (int k = 0; k < 2; ++k) dst[n][k] = *(const PG8_LAS bf16x8*)(lds + PG8_SB(b, h) + boff + n * 2048 + k * 1024); } while (0)
#define PG8_MMA(ai, bj, At, Bt) do { __builtin_amdgcn_s_setprio(1); _Pragma("unroll") for (int m = 0; m < 4; ++m) _Pragma("unroll") for (int n = 0; n < 2; ++n) _Pragma("unroll") for (int k = 0; k < 2; ++k) \
        acc[ai][bj][m][n] = __builtin_amdgcn_mfma_f32_16x16x32_bf16(Bt[n][k], At[m][k], acc[ai][bj][m][n], 0, 0, 0); __builtin_amdgcn_s_setprio(0); } while (0)
#define PG8_WAIT_V(n) asm volatile("s_waitcnt vmcnt(" #n ")" ::: "memory")
#define PG8_WAIT_L(n) asm volatile("s_waitcnt lgkmcnt(" #n ")" ::: "memory")
#define PG8_BAR __builtin_amdgcn_s_barrier()
#define PG8_SCHED __builtin_amdgcn_sched_barrier(0)
    Unit cur, nxt; int ui = 0;
    if (!S.next(0, cur)) return;
    f32x4 acc[2][2][4][2];
#pragma unroll
    for (int a = 0; a < 2; ++a)
#pragma unroll
        for (int b = 0; b < 2; ++b)
#pragma unroll
            for (int m = 0; m < 4; ++m)
#pragma unroll
                for (int n = 0; n < 2; ++n) acc[a][b][m][n] = (f32x4){0.f, 0.f, 0.f, 0.f};
    bf16x8 At[4][2], B0[2][2], B1[2][2];
    const char* cA = (const char*)g.A + (size_t)cur.pm * tstep; const char* cB = (const char*)g.Bt + (size_t)cur.pn * tstep;
    S.a_ready(cur);
    if constexpr (SP2) {
        PG8_STAGE(PG8_SB(0, 0), cB, voffB); PG8_STAGE(PG8_SB(0, 1), cB + hstep, voffB); PG8_STAGE(PG8_SA(0, 0), cA, voffA); PG8_STAGE(PG8_SA(0, 1), cA + hstep, voffA);
        if (wr == 1) PG8_BAR;
        PG8_WAIT_V(2); PG8_BAR;
        PG8_STAGE(PG8_SB(1, 0), cB + kstep, voffB); PG8_STAGE(PG8_SA(1, 0), cA + kstep, voffA); PG8_STAGE(PG8_SB(1, 1), cB + hstep + kstep, voffB);
        PG8_WAIT_V(6); PG8_BAR;
    } else {
        PG8_STAGE(PG8_SB(0, 0), cB, voffB); PG8_STAGE(PG8_SA(0, 0), cA, voffA); PG8_STAGE(PG8_SB(0, 1), cB + hstep, voffB); PG8_STAGE(PG8_SA(0, 1), cA + hstep, voffA);
        if (wr == 1) PG8_BAR;
        PG8_WAIT_V(4); PG8_BAR;
        PG8_STAGE(PG8_SB(1, 0), cB + kstep, voffB); PG8_STAGE(PG8_SA(1, 0), cA + kstep, voffA); PG8_STAGE(PG8_SB(1, 1), cB + hstep + kstep, voffB);
        PG8_WAIT_V(6); PG8_BAR;
    }
    for (;;) {
        const bool has_next = S.next(ui + 1, nxt);
        const char* nA = has_next ? (const char*)g.A + (size_t)nxt.pm * tstep : cA; const char* nB = has_next ? (const char*)g.Bt + (size_t)nxt.pn * tstep : cB;
        for (int t = 0; t < nt; t += 2) {
            const bool last = (t == nt - 2);
            const char* a1 = cA + (size_t)(t + 1) * kstep;
            const char* a2 = last ? nA : cA + (size_t)(t + 2) * kstep; const char* b2 = last ? nB : cB + (size_t)(t + 2) * kstep;
            const char* a3 = a2 + kstep; const char* b3 = b2 + kstep;
            if (last && has_next) S.a_ready(nxt);
            if constexpr (SP2) {
            PG8_LDB(B0, 0, 0); PG8_LDB(B1, 0, 1); PG8_SCHED; PG8_LDA(At, 0, 0); PG8_STAGE(PG8_SA(1, 1), a1 + hstep, voffA);
            PG8_WAIT_V(8); PG8_WAIT_L(0); PG8_BAR; PG8_MMA(0, 0, At, B0); PG8_MMA(0, 1, At, B1); PG8_BAR; PG8_SCHED;
            PG8_LDA(At, 0, 1); PG8_STAGE(PG8_SB(0, 0), b2, voffB); PG8_STAGE(PG8_SB(0, 1), b2 + hstep, voffB); PG8_STAGE(PG8_SA(0, 0), a2, voffA);
            PG8_WAIT_V(8); PG8_WAIT_L(0); PG8_BAR; PG8_MMA(1, 0, At, B0); PG8_MMA(1, 1, At, B1); PG8_BAR; PG8_SCHED;
            PG8_LDB(B0, 1, 0); PG8_LDB(B1, 1, 1); PG8_SCHED; PG8_LDA(At, 1, 0); PG8_STAGE(PG8_SA(0, 1), a2 + hstep, voffA);
            PG8_WAIT_V(8); PG8_WAIT_L(0); PG8_BAR; PG8_MMA(0, 0, At, B0); PG8_MMA(0, 1, At, B1); PG8_BAR; PG8_SCHED;
            PG8_LDA(At, 1, 1); PG8_STAGE(PG8_SB(1, 0), b3, voffB); PG8_STAGE(PG8_SB(1, 1), b3 + hstep, voffB); PG8_STAGE(PG8_SA(1, 0), a3, voffA);
            PG8_WAIT_V(8); PG8_WAIT_L(0); PG8_BAR; PG8_MMA(1, 0, At, B0); PG8_MMA(1, 1, At, B1); PG8_BAR; PG8_SCHED;
            } else {
            PG8_LDB(B0, 0, 0); PG8_SCHED; PG8_LDA(At, 0, 0); PG8_STAGE(PG8_SA(1, 1), a1 + hstep, voffA);
            PG8_WAIT_L(8); PG8_BAR; PG8_WAIT_L(0); PG8_MMA(0, 0, At, B0); PG8_BAR; PG8_SCHED;
            PG8_LDB(B1, 0, 1); PG8_STAGE(PG8_SB(0, 0), b2, voffB);
            PG8_BAR; PG8_WAIT_L(0); PG8_MMA(0, 1, At, B1); PG8_BAR;
            PG8_LDA(At, 0, 1); PG8_STAGE(PG8_SA(0, 0), a2, voffA);
            PG8_BAR; PG8_WAIT_L(0); PG8_MMA(1, 0, At, B0); PG8_BAR; PG8_SCHED;
            PG8_STAGE(PG8_SB(0, 1), b2 + hstep, voffB);
            PG8_WAIT_V(6); PG8_BAR; PG8_MMA(1, 1, At, B1); PG8_BAR;
            PG8_LDB(B0, 1, 0); PG8_SCHED; PG8_LDA(At, 1, 0); PG8_STAGE(PG8_SA(0, 1), a2 + hstep, voffA);
            PG8_WAIT_L(8); PG8_BAR; PG8_WAIT_L(0); PG8_MMA(0, 0, At, B0); PG8_BAR; PG8_SCHED;
            PG8_LDB(B1, 1, 1); PG8_STAGE(PG8_SB(1, 0), b3, voffB);
            PG8_BAR; PG8_WAIT_L(0); PG8_MMA(0, 1, At, B1); PG8_BAR;
            PG8_LDA(At, 1, 1); PG8_STAGE(PG8_SA(1, 0), a3, voffA);
            PG8_BAR; PG8_WAIT_L(0); PG8_MMA(1, 0, At, B0); PG8_BAR; PG8_SCHED;
            PG8_STAGE(PG8_SB(1, 1), b3 + hstep, voffB);
            PG8_WAIT_V(6); PG8_BAR; PG8_MMA(1, 1, At, B1); PG8_BAR;
            }
        }
        if constexpr (ALIGN_EPI) { if (wr == 0) PG8_BAR; }
        if constexpr (!Epi::AFTER_DRAIN) { E(acc, cur, wr, wc, fr, fq); S.done(cur); }
        if (!has_next) break;
#pragma unroll
        for (int a = 0; a < 2; ++a)
#pragma unroll
            for (int b = 0; b < 2; ++b)
#pragma unroll
                for (int m = 0; m < 4; ++m)
#pragma unroll
                    for (int n = 0; n < 2; ++n) acc[a][b][m][n] = (f32x4){0.f, 0.f, 0.f, 0.f};
        cur = nxt; cA = nA; cB = nB; ++ui;
        if constexpr (ALIGN_EPI) { if (wr == 1) PG8_BAR; }
    }
    PG8_WAIT_V(0);
    if constexpr (!ALIGN_EPI) { if (wr == 0) PG8_BAR; }
    PG8_BAR;
    if constexpr (Epi::AFTER_DRAIN) { E.fused(acc, cur, wr, wc, fr, fq, lds, wid, lane); S.done(cur); }
#undef PG8_SA
#undef PG8_SB
#undef PG8_STAGE
#undef PG8_LDA
#undef PG8_LDB
#undef PG8_MMA
#undef PG8_WAIT_V
#undef PG8_WAIT_L
#undef PG8_BAR
#undef PG8_SCHED
}
}
constexpr int NB = 8, SEQ = 4096, DM = 1024, NT = NB * SEQ, DEPTH = 4, DFF = 4096;
constexpr int NZ = 3328;
constexpr int ZQ = 0, ZK = 512, ZV = 1024, ZR = 1536, ZKR = 2048, ZVR = 2560, ZXW = 3072, ZMV = 3232;
constexpr size_t MiB = 1u << 20;
constexpr size_t WS_WIN = 1 * MiB, WS_WOUT = 27 * MiB, WS_WUP = 35 * MiB, WS_WDN = 67 * MiB, WS_LT = 99 * MiB;
constexpr size_t WS_XN = 100 * MiB, WS_VF = 164 * MiB, WS_BON = 196 * MiB, WS_BIG = 198 * MiB;
constexpr size_t WS_Z = WS_BIG, WS_YS = 406 * MiB, WS_G = 438 * MiB, WS_VC = 470 * MiB, WS_H = WS_BIG, WS_Y1 = WS_BIG, WS_END = 502 * MiB;
constexpr int LDS_BYTES = 147456;

#define LAS __attribute__((address_space(3)))
typedef unsigned short bf16;
typedef float f32x4 __attribute__((ext_vector_type(4)));
typedef unsigned u32x4 __attribute__((ext_vector_type(4)));
typedef unsigned u32x2 __attribute__((ext_vector_type(2)));
typedef short bf16x8 __attribute__((ext_vector_type(8)));
typedef short s16x4 __attribute__((ext_vector_type(4)));

__device__ __forceinline__ float bf2f(unsigned u) { return __uint_as_float(u << 16); }
__device__ __forceinline__ float bflo(unsigned u) { return __uint_as_float(u << 16); }
__device__ __forceinline__ float bfhi(unsigned u) { return __uint_as_float(u & 0xffff0000u); }
__device__ __forceinline__ unsigned f2bf(float f) { unsigned u = __float_as_uint(f); return (u + 0x7fffu + ((u >> 16) & 1u)) >> 16; }
__device__ __forceinline__ unsigned pk2(float lo, float hi) { return f2bf(lo) | (f2bf(hi) << 16); }
__device__ __forceinline__ float wave_sum(float v) {
#pragma unroll
    for (int o = 1; o < 64; o <<= 1) v += __shfl_xor(v, o);
    return v;
}
__device__ __forceinline__ float dppf(float v, const int ctrl_sel) {
    int r;
    if (ctrl_sel == 0) r = __builtin_amdgcn_update_dpp(0, __float_as_int(v), 0xB1, 0xF, 0xF, false);
    else if (ctrl_sel == 1) r = __builtin_amdgcn_update_dpp(0, __float_as_int(v), 0x4E, 0xF, 0xF, false);
    else if (ctrl_sel == 2) r = __builtin_amdgcn_update_dpp(0, __float_as_int(v), 0x141, 0xF, 0xF, false);
    else r = __builtin_amdgcn_update_dpp(0, __float_as_int(v), 0x140, 0xF, 0xF, false);
    return __int_as_float(r);
}
__device__ __forceinline__ float rowsum16(float v) { v += dppf(v, 0); v += dppf(v, 1); v += dppf(v, 2); v += dppf(v, 3); return v; }
__device__ __forceinline__ float sigmoidf_(float x) { return 1.0f / (1.0f + __expf(-x)); }

struct Params { const float* in[25]; float* out; unsigned char* ws; int ph_lo, ph_hi; };
#define MK_IDS const int tid = pg8::mk_tid(), lane = tid & 63, wave = __builtin_amdgcn_readfirstlane(tid >> 6); const int gw = blockIdx.x * 8 + wave; (void)gw; (void)lane

__device__ __forceinline__ void transpose_item(const float* W, int K, int N, bf16* WT, LAS float* scr, int item, int lane) {
    const int nblk = N / 32, kb = item / nblk, nb = item % nblk, k0 = 64 * kb, n0 = 32 * nb;
#pragma unroll 8
    for (int i = 0; i < 32; ++i) { const int kk = 2 * i + (lane >> 5); scr[kk * 33 + (lane & 31)] = W[(size_t)(k0 + kk) * N + n0 + (lane & 31)]; }
    asm volatile("s_waitcnt lgkmcnt(0)" ::: "memory");
    const int c = lane & 7;
#pragma unroll
    for (int j = 0; j < 4; ++j) { const int n = (lane >> 3) + 8 * j; const LAS float* s = scr + (8 * c) * 33 + n;
        u32x4 o; o.x = pk2(s[0 * 33], s[1 * 33]); o.y = pk2(s[2 * 33], s[3 * 33]); o.z = pk2(s[4 * 33], s[5 * 33]); o.w = pk2(s[6 * 33], s[7 * 33]);
        *(u32x4*)(WT + (size_t)(n0 + n) * K + k0 + 8 * c) = o; }
    asm volatile("s_waitcnt lgkmcnt(0)" ::: "memory");
}

__device__ __forceinline__ void prologue(const Params& p, LAS unsigned char* lds, int gw, int NGW, int wave, int lane) {
    unsigned char* ws = p.ws;
    LAS float* scr = (LAS float*)(lds + wave * 16384);
    constexpr int I_IN0 = 16 * 101, I_INR = 16 * 102, I_OUT = 16 * 32, I_UP = 16 * 128, I_DN = 64 * 32;
    constexpr int NITEMS = I_IN0 + 3 * I_INR + 4 * I_OUT + 4 * I_UP + 4 * I_DN;
    for (int it = gw; it < NITEMS; it += NGW) {
        int r = it;
        if (r < I_IN0) { transpose_item(p.in[5], 1024, 3232, (bf16*)(ws + WS_WIN), scr, r, lane); continue; } r -= I_IN0;
        if (r < 3 * I_INR) { const int l = r / I_INR; transpose_item(p.in[6] + (size_t)l * 1024 * 3264, 1024, 3264, (bf16*)(ws + WS_WIN) + (size_t)(l + 1) * NZ * 1024, scr, r % I_INR, lane); continue; } r -= 3 * I_INR;
        if (r < 4 * I_OUT) { const int l = r / I_OUT; transpose_item(p.in[22] + (size_t)l * 1024 * 1024, 1024, 1024, (bf16*)(ws + WS_WOUT) + (size_t)l * 1024 * 1024, scr, r % I_OUT, lane); continue; } r -= 4 * I_OUT;
        if (r < 4 * I_UP) { const int l = r / I_UP; transpose_item(p.in[23] + (size_t)l * 1024 * 4096, 1024, 4096, (bf16*)(ws + WS_WUP) + (size_t)l * 4096 * 1024, scr, r % I_UP, lane); continue; } r -= 4 * I_UP;
        { const int l = r / I_DN; transpose_item(p.in[24] + (size_t)l * 4096 * 1024, 4096, 1024, (bf16*)(ws + WS_WDN) + (size_t)l * 1024 * 4096, scr, r % I_DN, lane); }
    }
    {
        const int gt = gw * 64 + lane, NG = NGW * 64;
        const u32x4 z4 = {0u, 0u, 0u, 0u};
        for (int l = 0; l < 4; ++l) { const int r0 = (l == 0) ? 3232 : 3264; const int nvec = (NZ - r0) * 1024 / 8;
            u32x4* base = (u32x4*)((bf16*)(ws + WS_WIN) + ((size_t)l * NZ + r0) * 1024);
            for (int i = gt; i < nvec; i += NG) base[i] = z4; }
        bf16* LT = (bf16*)(ws + WS_LT);
        for (int i = gt; i < 4 * 512 * 192; i += NG) { const int l = i / (512 * 192), rem = i % (512 * 192), c = rem / 192, m = rem % 192; float v;
            if (m < 32) v = p.in[11][((size_t)l * 32 + m) * 512 + c];
            else if (m < 64) v = p.in[13][((size_t)l * 32 + (m - 32)) * 512 + c];
            else if (m < 160) v = p.in[16][((size_t)l * 96 + (m - 64)) * 512 + c];
            else v = (l > 0) ? p.in[15][((size_t)(l - 1) * 32 + (m - 160)) * 512 + c] : 0.f;
            LT[i] = (bf16)f2bf(v); }
    }
    const float* x = p.in[0]; const float* g = p.in[1]; bf16* XN = (bf16*)(ws + WS_XN);
    for (int row = gw; row < NT; row += NGW) {
        const f32x4* xr = (const f32x4*)(x + (size_t)row * DM) + lane; f32x4* orow = (f32x4*)(p.out + (size_t)row * DM) + lane;
        f32x4 v[4]; float s = 0.f;
#pragma unroll
        for (int j = 0; j < 4; ++j) { v[j] = xr[64 * j]; orow[64 * j] = v[j]; s += (v[j].x * v[j].x + v[j].y * v[j].y) + (v[j].z * v[j].z + v[j].w * v[j].w); }
        const float rstd = 1.0f / sqrtf(wave_sum(s) * (1.0f / DM) + 1e-6f);
        u32x2* o8 = (u32x2*)(XN + (size_t)row * DM) + lane;
#pragma unroll
        for (int j = 0; j < 4; ++j) { const f32x4 gg = ((const f32x4*)g)[lane + 64 * j]; u32x2 w; w.x = pk2(v[j].x * rstd * gg.x, v[j].y * rstd * gg.y); w.y = pk2(v[j].z * rstd * gg.z, v[j].w * rstd * gg.w); o8[64 * j] = w; }
    }
}

__device__ __forceinline__ void norm_phase(const bf16* Y, float* X, bf16* XN, const float* gpost, const float* gnext, int gw, int NGW, int lane) {
    for (int row = gw; row < NT; row += NGW) {
        const u32x4* yr = (const u32x4*)(Y + (size_t)row * DM); f32x4* xr = (f32x4*)(X + (size_t)row * DM);
        float y[16]; float ss = 0.f;
#pragma unroll
        for (int k = 0; k < 2; ++k) { const u32x4 w = yr[k * 64 + lane];
            y[k * 8 + 0] = bflo(w.x); y[k * 8 + 1] = bfhi(w.x); y[k * 8 + 2] = bflo(w.y); y[k * 8 + 3] = bfhi(w.y); y[k * 8 + 4] = bflo(w.z); y[k * 8 + 5] = bfhi(w.z); y[k * 8 + 6] = bflo(w.w); y[k * 8 + 7] = bfhi(w.w); }
#pragma unroll
        for (int e = 0; e < 16; ++e) ss += y[e] * y[e];
        const float rstd = 1.0f / sqrtf(wave_sum(ss) * (1.0f / DM) + 1e-6f);
        float xn[16]; float s2 = 0.f;
#pragma unroll
        for (int k = 0; k < 2; ++k)
#pragma unroll
            for (int q = 0; q < 2; ++q) { const int vi = k * 128 + lane * 2 + q; f32x4 xv = xr[vi]; const f32x4 gg = ((const f32x4*)gpost)[vi];
#pragma unroll
                for (int e = 0; e < 4; ++e) { const float t = xv[e] + y[k * 8 + q * 4 + e] * rstd * gg[e]; xv[e] = t; xn[k * 8 + q * 4 + e] = t; s2 += t * t; }
                xr[vi] = xv; }
        if (gnext) {
            const float r2 = 1.0f / sqrtf(wave_sum(s2) * (1.0f / DM) + 1e-6f);
            u32x4* o = (u32x4*)(XN + (size_t)row * DM);
#pragma unroll
            for (int k = 0; k < 2; ++k) { const f32x4 g0 = ((const f32x4*)gnext)[k * 128 + lane * 2], g1 = ((const f32x4*)gnext)[k * 128 + lane * 2 + 1]; u32x4 w;
                w.x = pk2(xn[k * 8 + 0] * r2 * g0.x, xn[k * 8 + 1] * r2 * g0.y); w.y = pk2(xn[k * 8 + 2] * r2 * g0.z, xn[k * 8 + 3] * r2 * g0.w);
                w.z = pk2(xn[k * 8 + 4] * r2 * g1.x, xn[k * 8 + 5] * r2 * g1.y); w.w = pk2(xn[k * 8 + 6] * r2 * g1.z, xn[k * 8 + 7] * r2 * g1.w);
                o[k * 64 + lane] = w; }
        }
    }
}

__device__ __forceinline__ void post_phase(bf16* MIX, const bf16* YS, const bf16* GB, const bf16* VC, const float* BON, const float* again, const float* gnw, const float* gnb, int gw, int NGW, int lane) {
    for (int row = gw; row < NT; row += NGW) {
        u32x4* mrow = (u32x4*)(MIX + (size_t)row * DM);
        {
            const u32x4 w = mrow[lane]; float o[8] = {bflo(w.x), bfhi(w.x), bflo(w.y), bfhi(w.y), bflo(w.z), bfhi(w.z), bflo(w.w), bfhi(w.w)}; float ss = 0.f;
#pragma unroll
            for (int e = 0; e < 8; ++e) ss += o[e] * o[e];
            const float rstd = 1.0f / sqrtf(wave_sum(ss) * (1.0f / 512.0f) + 1e-6f);
            const f32x4 g0 = ((const f32x4*)again)[lane * 2], g1 = ((const f32x4*)again)[lane * 2 + 1]; u32x4 r;
            r.x = pk2(o[0] * rstd * g0.x, o[1] * rstd * g0.y); r.y = pk2(o[2] * rstd * g0.z, o[3] * rstd * g0.w); r.z = pk2(o[4] * rstd * g1.x, o[5] * rstd * g1.y); r.w = pk2(o[6] * rstd * g1.z, o[7] * rstd * g1.w);
            mrow[lane] = r;
        }
        {
            const u32x4 w = ((const u32x4*)(YS + (size_t)row * 512))[lane]; float y[8] = {bflo(w.x), bfhi(w.x), bflo(w.y), bfhi(w.y), bflo(w.z), bfhi(w.z), bflo(w.w), bfhi(w.w)};
            float s1 = 0.f;
#pragma unroll
            for (int e = 0; e < 8; ++e) s1 += y[e];
            s1 += __shfl_xor(s1, 1); s1 += __shfl_xor(s1, 2); s1 += __shfl_xor(s1, 4);
            const float mean = s1 * (1.0f / 64.0f); float s2 = 0.f;
#pragma unroll
            for (int e = 0; e < 8; ++e) { y[e] -= mean; s2 += y[e] * y[e]; }
            s2 += __shfl_xor(s2, 1); s2 += __shfl_xor(s2, 2); s2 += __shfl_xor(s2, 4);
            const float rs = 1.0f / sqrtf(s2 * (1.0f / 64.0f) + 64e-5f);
            const u32x4 vw = ((const u32x4*)(VC + (size_t)row * 512))[lane], gw4 = ((const u32x4*)(GB + (size_t)row * 512))[lane];
            const float v[8] = {bflo(vw.x), bfhi(vw.x), bflo(vw.y), bfhi(vw.y), bflo(vw.z), bfhi(vw.z), bflo(vw.w), bfhi(vw.w)};
            const float g[8] = {bflo(gw4.x), bfhi(gw4.x), bflo(gw4.y), bfhi(gw4.y), bflo(gw4.z), bfhi(gw4.z), bflo(gw4.w), bfhi(gw4.w)};
            const float bon = BON[(size_t)row * 8 + (lane >> 3)];
            const f32x4 w0 = ((const f32x4*)gnw)[lane * 2], w1 = ((const f32x4*)gnw)[lane * 2 + 1], b0 = ((const f32x4*)gnb)[lane * 2], b1 = ((const f32x4*)gnb)[lane * 2 + 1];
            const float gwv[8] = {w0.x, w0.y, w0.z, w0.w, w1.x, w1.y, w1.z, w1.w}, gbv[8] = {b0.x, b0.y, b0.z, b0.w, b1.x, b1.y, b1.z, b1.w};
            float o[8];
#pragma unroll
            for (int e = 0; e < 8; ++e) o[e] = (y[e] * rs * gwv[e] + gbv[e] + bon * v[e]) * g[e];
            u32x4 r; r.x = pk2(o[0], o[1]); r.y = pk2(o[2], o[3]); r.z = pk2(o[4], o[5]); r.w = pk2(o[6], o[7]);
            mrow[64 + lane] = r;
        }
    }
}

__device__ __forceinline__ void attn_unit(LAS unsigned char* lds, const bf16* Z, bf16* MIX, int unit, int wave, int lane) {
    const int b = unit >> 4, t0 = (unit & 15) * 256;
    LAS float* ACC = (LAS float*)lds;
    LAS float* ML = (LAS float*)(lds + 256 * 68 * 4);
    LAS unsigned char* VST = lds + 256 * 68 * 4 + 2048 + wave * 4096;
    const int li = lane & 15, quad = lane >> 4;
    const float C = 0.125f * 1.4426950408889634f;
    const size_t rowbase = (size_t)b * SEQ;
    for (int h = 0; h < 8; ++h) {
#pragma unroll 1
        for (int br = 0; br < 3; ++br) {
            const int lg = br * 2; const int L = SEQ >> lg;
#pragma unroll 1
            for (int u = 0; u < 2; ++u) {
                const int tu = wave * 2 + u;
                int r, i0;
                if (br == 0) { r = 0; i0 = t0 + tu * 16; } else if (br == 1) { r = tu & 3; i0 = (t0 >> 2) + (tu >> 2) * 16; } else { r = tu; i0 = t0 >> 4; }
                const int tq = ((i0 + li) << lg) + r;
                const bf16* qp = Z + (rowbase + tq) * NZ + ZQ + h * 64 + quad * 8;
                const bf16x8 q0 = *(const bf16x8*)qp, q1 = *(const bf16x8*)(qp + 32);
                f32x4 s[9];
#pragma unroll
                for (int kt = 0; kt < 9; ++kt) {
                    int ik = i0 - 128 + kt * 16 + li; ik = ik < 0 ? 0 : ik;
                    const bf16* kp = Z + (rowbase + (ik << lg) + r) * NZ + ZK + h * 64 + quad * 8;
                    const bf16x8 k0 = *(const bf16x8*)kp, k1 = *(const bf16x8*)(kp + 32);
                    f32x4 a = {0.f, 0.f, 0.f, 0.f};
                    a = __builtin_amdgcn_mfma_f32_16x16x32_bf16(k0, q0, a, 0, 0, 0);
                    a = __builtin_amdgcn_mfma_f32_16x16x32_bf16(k1, q1, a, 0, 0, 0);
                    s[kt] = a;
                }
                float mx = -1e30f;
#pragma unroll
                for (int kt = 0; kt < 9; ++kt)
#pragma unroll
                    for (int j = 0; j < 4; ++j) { const int key = kt * 16 + quad * 4 + j; const int dist = 128 + li - key; const int ik = i0 - 128 + key;
                        const bool valid = (dist >= 0) && (dist <= 128) && (ik >= 0);
                        const float sv = valid ? s[kt][j] : -1e30f; s[kt][j] = sv; mx = fmaxf(mx, sv); }
                mx = fmaxf(mx, __shfl_xor(mx, 16)); mx = fmaxf(mx, __shfl_xor(mx, 32));
                float lsum = 0.f;
#pragma unroll
                for (int kt = 0; kt < 9; ++kt)
#pragma unroll
                    for (int j = 0; j < 4; ++j) { const float pv = __builtin_amdgcn_exp2f((s[kt][j] - mx) * C); s[kt][j] = pv; lsum += pv; }
                lsum += __shfl_xor(lsum, 16); lsum += __shfl_xor(lsum, 32);
                f32x4 o[4];
#pragma unroll
                for (int dt = 0; dt < 4; ++dt) o[dt] = (f32x4){0.f, 0.f, 0.f, 0.f};
#pragma unroll
                for (int cc = 0; cc < 5; ++cc) {
                    asm volatile("s_waitcnt lgkmcnt(0)" ::: "memory");
#pragma unroll
                    for (int it = 0; it < 4; ++it) { const int idx = it * 64 + lane, rr = idx >> 3, c16 = idx & 7; int ik = i0 - 128 + cc * 32 + rr; ik = ik < 0 ? 0 : (ik > L - 1 ? L - 1 : ik);
                        const u32x4 vv = *(const u32x4*)(Z + (rowbase + (ik << lg) + r) * NZ + ZV + h * 64 + c16 * 8);
                        *(LAS u32x4*)(VST + rr * 128 + c16 * 16) = vv; }
                    asm volatile("s_waitcnt vmcnt(0) lgkmcnt(0)" ::: "memory");
                    bf16x8 pa;
                    { const f32x4 p0 = s[2 * cc]; const unsigned a0 = pk2(p0[0], p0[1]), a1 = pk2(p0[2], p0[3]); unsigned a2 = 0u, a3 = 0u;
                      if (cc < 4) { const f32x4 p1 = s[2 * cc + 1 < 9 ? 2 * cc + 1 : 8]; a2 = pk2(p1[0], p1[1]); a3 = pk2(p1[2], p1[3]); }
                      const u32x4 pw = {a0, a1, a2, a3}; pa = __builtin_bit_cast(bf16x8, pw); }
#pragma unroll
                    for (int dt = 0; dt < 4; ++dt) {
                        LAS unsigned char* ap = VST + (quad * 4 + (li >> 2)) * 128 + (dt * 16 + (li & 3) * 4) * 2;
                        const s16x4 b1 = __builtin_bit_cast(s16x4, __builtin_amdgcn_ds_read_tr16_b64_v4i16((LAS s16x4*)ap));
                        const s16x4 b2 = __builtin_bit_cast(s16x4, __builtin_amdgcn_ds_read_tr16_b64_v4i16((LAS s16x4*)(ap + 16 * 128)));
                        const bf16x8 vb = {b1[0], b1[1], b1[2], b1[3], b2[0], b2[1], b2[2], b2[3]};
                        o[dt] = __builtin_amdgcn_mfma_f32_16x16x32_bf16(pa, vb, o[dt], 0, 0, 0);
                    }
                }
#pragma unroll
                for (int j = 0; j < 4; ++j) {
                    const int qq = quad * 4 + j;
                    const float mr = __shfl(mx, qq), lr = __shfl(lsum, qq);
                    const int tl = (br == 0) ? tu * 16 + qq : (br == 1) ? ((((tu >> 2) * 16 + qq) << 2) + (tu & 3)) : qq * 16 + tu;
                    LAS float* arow = ACC + tl * 68;
                    if (br == 0) {
#pragma unroll
                        for (int dt = 0; dt < 4; ++dt) arow[dt * 16 + li] = o[dt][j];
                        if (li == 0) { ML[tl * 2] = mr; ML[tl * 2 + 1] = lr; }
                    } else {
                        const float m0 = ML[tl * 2], l0 = ML[tl * 2 + 1];
                        const float mn = fmaxf(m0, mr); const float a0 = __builtin_amdgcn_exp2f((m0 - mn) * C), a1 = __builtin_amdgcn_exp2f((mr - mn) * C);
                        const float ln = l0 * a0 + lr * a1;
                        float val[4];
#pragma unroll
                        for (int dt = 0; dt < 4; ++dt) val[dt] = arow[dt * 16 + li] * a0 + o[dt][j] * a1;
                        asm volatile("s_waitcnt lgkmcnt(0)" ::: "memory");
                        if (br == 1) {
#pragma unroll
                            for (int dt = 0; dt < 4; ++dt) arow[dt * 16 + li] = val[dt];
                            if (li == 0) { ML[tl * 2] = mn; ML[tl * 2 + 1] = ln; }
                        } else {
                            const float inv = 1.0f / ln; bf16* orow = MIX + (rowbase + t0 + tl) * DM + h * 64 + li;
#pragma unroll
                            for (int dt = 0; dt < 4; ++dt) orow[dt * 16] = (bf16)f2bf(val[dt] * inv);
                        }
                    }
                }
            }
            __syncthreads();
        }
    }
}

constexpr int TC = 32;
constexpr int SC_RS = 0, SC_WW = 8192, SC_KS = 16384, SC_KK = 24576, SC_BV = 32768, SC_VS = 40960, SC_ACT = 49152, ACT_PITCH = 400, SC_INVN = SC_ACT + TC * ACT_PITCH, SC_BONP = SC_INVN + 128;
__device__ __forceinline__ void scan_unit(LAS unsigned char* lds, const Params& p, int layer, int unit, int tid, int wave, int lane) {
    const int chain = unit >> 1, hf = unit & 1, b = chain >> 3, h = chain & 7;
    unsigned char* ws = p.ws;
    const bf16* Z = (const bf16*)(ws + WS_Z); bf16* VF = (bf16*)(ws + WS_VF); bf16* YS = (bf16*)(ws + WS_YS); bf16* GB = (bf16*)(ws + WS_G); bf16* VC = (bf16*)(ws + WS_VC); float* BON = (float*)(ws + WS_BON);
    const bf16* LT = (const bf16*)(ws + WS_LT) + (size_t)layer * 512 * 192;
    const float* mu = p.in[7] + (size_t)layer * 1696; const float* mumv = (layer > 0) ? p.in[8] + (size_t)(layer - 1) * 32 : nullptr;
    LAS float* RS = (LAS float*)(lds + SC_RS); LAS float* WW = (LAS float*)(lds + SC_WW); LAS float* KS = (LAS float*)(lds + SC_KS); LAS float* KK = (LAS float*)(lds + SC_KK);
    LAS float* BV = (LAS float*)(lds + SC_BV); LAS float* VS = (LAS float*)(lds + SC_VS); LAS unsigned char* ACT = lds + SC_ACT; LAS float* INVN = (LAS float*)(lds + SC_INVN); LAS float* BONP = (LAS float*)(lds + SC_BONP);
    const int li = lane & 15, quad = lane >> 4;
    const size_t rowbase = (size_t)b * SEQ;
    const int tt = wave >> 2, ct = wave & 3, cl = ct * 16 + li, cg_ = h * 64 + cl;
    const float w0c = p.in[10][layer * 512 + cg_], a0c = p.in[12][layer * 512 + cg_], v0c = (layer > 0) ? p.in[14][(layer - 1) * 512 + cg_] : 0.f;
    const float kkc = p.in[17][layer * 512 + cg_], kac = p.in[18][layer * 512 + cg_], rkc = p.in[19][layer * 512 + cg_];
    bf16x8 Bf[6];
#pragma unroll
    for (int ks = 0; ks < 6; ++ks) Bf[ks] = *(const bf16x8*)(LT + (size_t)cg_ * 192 + ks * 32 + quad * 8);
    const float kk_lane = p.in[17][layer * 512 + h * 64 + lane];
    const int irow = hf * 32 + wave * 4 + quad, j0 = li * 4;
    float S0 = 0.f, S1 = 0.f, S2 = 0.f, S3 = 0.f, ykeep = 0.f;
#pragma unroll 1
    for (int tch = 0; tch < SEQ; tch += TC) {
#pragma unroll 1
        for (int k = 0; k < 6; ++k) {
            const int idx = tid + 512 * k, t = idx / 96, cgp = idx % 96;
            int zc, mui; bool mv = false;
            if (cgp < 16) zc = ZR + h * 64 + cgp * 4; else if (cgp < 32) zc = ZKR + h * 64 + (cgp - 16) * 4; else if (cgp < 48) zc = ZVR + h * 64 + (cgp - 32) * 4; else zc = ZXW + (cgp - 48) * 4;
            mui = zc - ZR; if (zc >= ZMV) { mv = true; mui = zc - ZMV; }
            const int tg = tch + t;
            const u32x2 cw = *(const u32x2*)(Z + (rowbase + tg) * NZ + zc);
            u32x2 pw = {0u, 0u}; if (tg > 0) pw = *(const u32x2*)(Z + (rowbase + tg - 1) * NZ + zc);
            f32x4 m4 = {0.f, 0.f, 0.f, 0.f}; if (!mv) m4 = *(const f32x4*)(mu + mui); else if (mumv) m4 = *(const f32x4*)(mumv + mui);
            const float c0 = bflo(cw.x), c1 = bfhi(cw.x), c2 = bflo(cw.y), c3 = bfhi(cw.y), p0 = bflo(pw.x), p1 = bfhi(pw.x), p2 = bflo(pw.y), p3 = bfhi(pw.y);
            f32x4 v = {c0 + (p0 - c0) * m4.x, c1 + (p1 - c1) * m4.y, c2 + (p2 - c2) * m4.z, c3 + (p3 - c3) * m4.w};
            if (cgp < 16) *(LAS f32x4*)(RS + t * 64 + cgp * 4) = v;
            else if (cgp < 32) *(LAS f32x4*)(KS + t * 64 + (cgp - 16) * 4) = v;
            else if (cgp < 48) *(LAS f32x4*)(VS + t * 64 + (cgp - 32) * 4) = v;
            else { const int ac = (cgp - 48) * 4;
                if (ac < 32) { v.x = tanhf(v.x); v.y = tanhf(v.y); v.z = tanhf(v.z); v.w = tanhf(v.w); }
                else if (ac >= 64 && ac < 160) { v.x = sigmoidf_(v.x); v.y = sigmoidf_(v.y); v.z = sigmoidf_(v.z); v.w = sigmoidf_(v.w); }
                u32x2 w; w.x = pk2(v.x, v.y); w.y = pk2(v.z, v.w); *(LAS u32x2*)(ACT + t * ACT_PITCH + ac * 2) = w; }
        }
        __syncthreads();
#pragma unroll
        for (int q = 0; q < 4; ++q) { const int t = wave * 4 + q; const float kv = KS[t * 64 + lane] * kk_lane; const float ss = wave_sum(kv * kv); if (lane == 0) INVN[t] = 1.0f / fmaxf(sqrtf(ss), 1e-12f); }
        __syncthreads();
        {
            bf16x8 Af[6];
#pragma unroll
            for (int ks = 0; ks < 6; ++ks) Af[ks] = *(const LAS bf16x8*)(ACT + (tt * 16 + li) * ACT_PITCH + ks * 64 + quad * 16);
            const f32x4 z4 = {0.f, 0.f, 0.f, 0.f};
            const f32x4 LW = __builtin_amdgcn_mfma_f32_16x16x32_bf16(Af[0], Bf[0], z4, 0, 0, 0);
            const f32x4 AA = __builtin_amdgcn_mfma_f32_16x16x32_bf16(Af[1], Bf[1], z4, 0, 0, 0);
            f32x4 G = __builtin_amdgcn_mfma_f32_16x16x32_bf16(Af[2], Bf[2], z4, 0, 0, 0);
            G = __builtin_amdgcn_mfma_f32_16x16x32_bf16(Af[3], Bf[3], G, 0, 0, 0);
            G = __builtin_amdgcn_mfma_f32_16x16x32_bf16(Af[4], Bf[4], G, 0, 0, 0);
            const f32x4 VG = __builtin_amdgcn_mfma_f32_16x16x32_bf16(Af[5], Bf[5], z4, 0, 0, 0);
#pragma unroll
            for (int j = 0; j < 4; ++j) {
                const int t = tt * 16 + quad * 4 + j; const size_t grow = rowbase + tch + t;
                const float r = RS[t * 64 + cl], k = KS[t * 64 + cl]; float v = VS[t * 64 + cl];
                const float xx = -(w0c + LW[j]); const float sp = xx > 20.f ? xx : __logf(1.0f + __expf(xx));
                const float w = __expf(-__expf(-sp - 0.5f));
                const float a = sigmoidf_(a0c + AA[j]);
                const float kkv = k * kkc * INVN[t]; const float kmod = k * (1.0f + (a - 1.0f) * kac); const float bv = kkv * a;
                if (layer > 0) { const float vg = sigmoidf_(v0c + VG[j]); const float vf = bf2f(VF[grow * 512 + cg_]); v = v + (vf - v) * vg; }
                else if (hf == 0) VF[grow * 512 + cg_] = (bf16)f2bf(v);
                asm volatile("s_waitcnt lgkmcnt(0)" ::: "memory");
                WW[t * 64 + cl] = w; KS[t * 64 + cl] = kmod; KK[t * 64 + cl] = kkv; BV[t * 64 + cl] = bv; VS[t * 64 + cl] = v;
                if (hf == 0) { GB[grow * 512 + cg_] = (bf16)f2bf(G[j]); VC[grow * 512 + cg_] = (bf16)f2bf(v); }
                float bp = r * kmod * rkc; bp += __shfl_xor(bp, 1); bp += __shfl_xor(bp, 2); bp += __shfl_xor(bp, 4); bp += __shfl_xor(bp, 8);
                if (li == 0) BONP[t * 4 + ct] = bp;
            }
        }
        __syncthreads();
        if (hf == 0 && tid < TC) BON[(rowbase + tch + tid) * 8 + h] = (BONP[tid * 4] + BONP[tid * 4 + 1]) + (BONP[tid * 4 + 2] + BONP[tid * 4 + 3]);
#pragma unroll 4
        for (int t = 0; t < TC; ++t) {
            const f32x4 w = *(const LAS f32x4*)(WW + t * 64 + j0), kk = *(const LAS f32x4*)(KK + t * 64 + j0), bv = *(const LAS f32x4*)(BV + t * 64 + j0), kx = *(const LAS f32x4*)(KS + t * 64 + j0), rx = *(const LAS f32x4*)(RS + t * 64 + j0);
            const float v = VS[t * 64 + irow];
            float sa = (S0 * kk.x + S1 * kk.y) + (S2 * kk.z + S3 * kk.w);
            sa = rowsum16(sa);
            S0 = S0 * w.x + (v * kx.x - sa * bv.x); S1 = S1 * w.y + (v * kx.y - sa * bv.y); S2 = S2 * w.z + (v * kx.z - sa * bv.z); S3 = S3 * w.w + (v * kx.w - sa * bv.w);
            float y = (S0 * rx.x + S1 * rx.y) + (S2 * rx.z + S3 * rx.w);
            y = rowsum16(y);
            ykeep = (li == (t & 15)) ? y : ykeep;
            if ((t & 15) == 15) YS[(rowbase + tch + (t & ~15) + li) * 512 + h * 64 + irow] = (bf16)f2bf(ykeep);
        }
        __syncthreads();
    }
}

#ifndef MK_NO_SCAN
#define SCAN_CALL scan_unit(lds, p, l, u, tid, wave, lane)
#else
#define SCAN_CALL
#endif
#ifndef MK_NO_ATTN
#define ATTN_CALL attn_unit(lds, Zb, XN, u - 128, wave, lane)
#else
#define ATTN_CALL
#endif
__global__ void __launch_bounds__(512, 2) mk_fwd(Params p) {
    extern __shared__ __attribute__((aligned(16))) unsigned char lds_raw[];
    LAS unsigned char* lds = (LAS unsigned char*)lds_raw;
    cg::grid_group grid = cg::this_grid();
    const int G = gridDim.x, NGW = G * 8;
    unsigned char* ws = p.ws;
    bf16* XN = (bf16*)(ws + WS_XN); bf16* Zb = (bf16*)(ws + WS_Z); bf16* Hb = (bf16*)(ws + WS_H); bf16* Y1 = (bf16*)(ws + WS_Y1);
    int ph = 0;
#define PH_ON (ph >= p.ph_lo && ph < p.ph_hi)
#define PH_END do { if (ph + 1 < p.ph_hi) grid.sync(); } while (0)
    if (PH_ON) { MK_IDS; prologue(p, lds, gw, NGW, wave, lane); PH_END; } ++ph;
#pragma unroll 1
    for (int l = 0; l < DEPTH; ++l) {
        if (PH_ON) { pg8::Gemm g{XN, (const bf16*)(ws + WS_WIN) + (size_t)l * NZ * 1024, NT, NZ, 1024}; pg8::StaticOrder S; S.init(NT, NZ, G, (int)blockIdx.x);
            pg8::EpiAct<0> E{Zb, NZ}; pg8::gemm_phase<pg8::EpiAct<0>, pg8::StaticOrder, true, true>(lds, g, S, E); PH_END; } ++ph;
        if (PH_ON) { MK_IDS;
            for (int u = blockIdx.x; u < 256; u += G) { if (u < 128) { SCAN_CALL; } else { ATTN_CALL; } __syncthreads(); }
            PH_END; } ++ph;
        if (PH_ON) { MK_IDS; post_phase(XN, (const bf16*)(ws + WS_YS), (const bf16*)(ws + WS_G), (const bf16*)(ws + WS_VC), (const float*)(ws + WS_BON), p.in[9] + l * 512, p.in[20] + l * 512, p.in[21] + l * 512, gw, NGW, lane); PH_END; } ++ph;
        if (PH_ON) { pg8::Gemm g{XN, (const bf16*)(ws + WS_WOUT) + (size_t)l * 1024 * 1024, NT, 1024, 1024}; pg8::StaticOrder S; S.init(NT, 1024, G, (int)blockIdx.x);
            pg8::EpiAct<0> E{Y1, 1024}; pg8::gemm_phase<pg8::EpiAct<0>, pg8::StaticOrder, true, true>(lds, g, S, E); PH_END; } ++ph;
        if (PH_ON) { MK_IDS; norm_phase(Y1, p.out, XN, p.in[2] + l * 1024, p.in[3] + l * 1024, gw, NGW, lane); PH_END; } ++ph;
        if (PH_ON) { pg8::Gemm g{XN, (const bf16*)(ws + WS_WUP) + (size_t)l * 4096 * 1024, NT, DFF, 1024}; pg8::StaticOrder S; S.init(NT, DFF, G, (int)blockIdx.x);
            pg8::EpiAct<1> E{Hb, DFF}; pg8::gemm_phase<pg8::EpiAct<1>, pg8::StaticOrder, true, true>(lds, g, S, E); PH_END; } ++ph;
        if (PH_ON) { pg8::Gemm g{Hb, (const bf16*)(ws + WS_WDN) + (size_t)l * 1024 * 4096, NT, 1024, DFF}; pg8::StaticOrder S; S.init(NT, 1024, G, (int)blockIdx.x);
            pg8::EpiAct<0> E{XN, 1024}; pg8::gemm_phase<pg8::EpiAct<0>, pg8::StaticOrder, true, true>(lds, g, S, E); PH_END; } ++ph;
        if (PH_ON) { MK_IDS; norm_phase(XN, p.out, XN, p.in[4] + l * 1024, (l + 1 < DEPTH) ? p.in[1] + (l + 1) * 1024 : nullptr, gw, NGW, lane); PH_END; } ++ph;
    }
}
constexpr int N_PHASES = 1 + 8 * DEPTH;

extern "C" void kernel_launch(void* const* d_in, const int* in_sizes, int n_in, void* d_out, int out_size, void* d_ws, size_t ws_size, hipStream_t stream) {
    static int grid = 0;
    if (grid == 0) {
        if (n_in != 25 || out_size != NT * DM || ws_size < WS_END) { fprintf(stderr, "kernel_launch: unexpected sizes n_in=%d out=%d ws=%zu\n", n_in, out_size, ws_size); grid = -1; return; }
        int dev = 0, cus = 0, per_cu = 0;
        hipGetDevice(&dev); hipDeviceGetAttribute(&cus, hipDeviceAttributeMultiprocessorCount, dev);
        if (hipFuncSetAttribute((const void*)mk_fwd, hipFuncAttributeMaxDynamicSharedMemorySize, LDS_BYTES) != hipSuccess) { fprintf(stderr, "kernel_launch: hipFuncSetAttribute failed\n"); grid = -1; return; }
        if (hipOccupancyMaxActiveBlocksPerMultiprocessor(&per_cu, (const void*)mk_fwd, 512, LDS_BYTES) != hipSuccess || per_cu < 1) { fprintf(stderr, "kernel_launch: occupancy query gave %d\n", per_cu); per_cu = 1; }
        (void)hipGetLastError();
        grid = cus * per_cu;
        fprintf(stderr, "kernel_launch: grid %d (cus %d x %d)\n", grid, cus, per_cu);
    }
    if (grid < 0) return;
    Params p{};
    for (int i = 0; i < 25; ++i) p.in[i] = (const float*)d_in[i];
    p.out = (float*)d_out; p.ws = (unsigned char*)d_ws;
#if MK_MULTI
    for (int ph = 0; ph < N_PHASES; ++ph) { p.ph_lo = ph; p.ph_hi = ph + 1; hipLaunchKernelGGL(mk_fwd, dim3(grid), dim3(512), LDS_BYTES, stream, p); }
#else
    p.ph_lo = 0; p.ph_hi = N_PHASES;
    void* args[] = {&p};
    hipError_t e = hipLaunchCooperativeKernel((const void*)mk_fwd, dim3(grid), dim3(512), args, LDS_BYTES, stream);
    if (e != hipSuccess) fprintf(stderr, "kernel_launch: cooperative launch failed: %s (grid %d)\n", hipGetErrorString(e), grid);
#endif
}
```

```cpp
#include <hip/hip_runtime.h>
#include <hip/hip_cooperative_groups.h>
#include <cstdio>
#include <cstdint>
namespace cg = cooperative_groups;
#ifndef MK_MULTI
#define MK_MULTI 0
#endif
namespace pg8 {
#define PG8_LAS __attribute__((address_space(3)))
typedef unsigned short bf16_t;
typedef short bf16x8 __attribute__((ext_vector_type(8)));
typedef float f32x4 __attribute__((ext_vector_type(4)));
typedef unsigned u32x4 __attribute__((ext_vector_type(4)));
constexpr int BM = 256, BK = 64, HALF = 128, HTB = HALF * BK * 2  , STAGE_BYTES = 8 * HTB, NXCD = 8, WGM = 8;

__host__ __device__ __forceinline__ int lds_byte(int r, int c) { const int st = (r >> 4) * 2 + (c >> 5), rr = r & 15, cc = c & 31, ob = rr * 64 + cc * 2; return st * 1024 + (ob ^ (((ob >> 9) & 1) << 5)); }
__host__ __device__ __forceinline__ void stage_rc(int b, int& R, int& C) { const int st = b / 1024, sb = b % 1024, swz = sb ^ (((sb >> 9) & 1) << 5); R = (st >> 1) * 16 + swz / 64; C = (st & 1) * 32 + (swz % 64) / 2; }
__host__ __device__ __forceinline__ int perm32(int rho) { const int n = rho >> 4, i = rho & 15; return 8 * (i >> 2) + 4 * n + (i & 3); }

struct Unit { int pm, pn; };
struct Gemm { const bf16_t* A; const bf16_t* Bt; int M, N, K; };
struct StaticOrder {
    int nM, nN, nwg, G, c;
    __host__ __device__ void init(int M, int N, int G_, int c_) { nM = M / BM; nN = N / BM; nwg = nM * nN; G = G_; c = c_; }
    __host__ __device__ bool next(int i, Unit& u) const {
        const long L = (long)i * G + c; if (L >= nwg) return false;
        int wgid = (int)L; { const int q = nwg / NXCD, r = nwg % NXCD, xcd = wgid % NXCD, off = wgid / NXCD; wgid = (xcd < r ? xcd * (q + 1) : r * (q + 1) + (xcd - r) * q) + off; }
        const int nig = WGM * nN, gid = wgid / nig, fm = gid * WGM, gsz = (nM - fm) < WGM ? (nM - fm) : WGM;
        u.pm = fm + ((wgid % nig) % gsz); u.pn = (wgid % nig) / gsz; return true;
    }
    __device__ __forceinline__ void a_ready(const Unit&) const {}
    __device__ __forceinline__ void done(const Unit&) const {}
};
__device__ __forceinline__ unsigned cvt_pk_bf16(float lo, float hi) { unsigned r; asm volatile("v_cvt_pk_bf16_f32 %0, %1, %2" : "=v"(r) : "v"(lo), "v"(hi)); return r; }
typedef float f32x2 __attribute__((ext_vector_type(2)));
__device__ __forceinline__ int mk_tid() { int t = threadIdx.x; asm volatile("" : "+v"(t)); return t; }
template <int ACT> struct EpiAct {
    static constexpr bool PERM = true, AFTER_DRAIN = false;
    bf16_t* O; int ldc;
    __device__ __forceinline__ void operator()(const f32x4 (&acc)[2][2][4][2], const Unit& u, int wr, int wc, int fr, int fq) const {
        const int row0 = u.pm * BM + wr * 64 + fr; const int col0 = u.pn * BM + wc * 32 + 8 * fq;
#pragma unroll
        for (int ai = 0; ai < 2; ++ai)
#pragma unroll
            for (int m = 0; m < 4; ++m) { bf16_t* rowp = O + (size_t)(row0 + ai * HALF + m * 16) * ldc + col0;
#pragma unroll
                for (int bj = 0; bj < 2; ++bj) { f32x4 v0 = acc[ai][bj][m][0], v1 = acc[ai][bj][m][1];
                    if (ACT == 1) {
#pragma unroll
                        for (int e = 0; e < 4; ++e) { float a = v0[e] > 0.f ? v0[e] : 0.f, b = v1[e] > 0.f ? v1[e] : 0.f; v0[e] = a * a; v1[e] = b * b; } }
                    u32x4 w; w.x = cvt_pk_bf16(v0[0], v0[1]); w.y = cvt_pk_bf16(v0[2], v0[3]); w.z = cvt_pk_bf16(v1[0], v1[1]); w.w = cvt_pk_bf16(v1[2], v1[3]);
                    *(u32x4*)(rowp + bj * HALF) = w; } }
    }
};
template <class Epi, class Sched, bool ALIGN_EPI = false, bool SP2 = false>
__device__ __forceinline__ void gemm_phase(PG8_LAS unsigned char* lds, const Gemm g, const Sched& S, const Epi& E) {
    const int tid = mk_tid(), wid = __builtin_amdgcn_readfirstlane(tid >> 6), lane = tid & 63, wr = wid >> 2, wc = wid & 3, fr = lane & 15, fq = lane >> 4;
    const int K = g.K, nt = K / BK;
    unsigned voffA[2], voffB[2];
#pragma unroll
    for (int i = 0; i < 2; ++i) { int R, C; stage_rc(tid * 16 + i * 8192, R, C); const int Rb = Epi::PERM ? ((R & ~31) + perm32(R & 31)) : R;
        voffA[i] = (unsigned)(R * K + C) * 2u; voffB[i] = (unsigned)(Rb * K + C) * 2u; }
    const size_t kstep = (size_t)(BK * 2);
    const size_t hstep = (size_t)HALF * K * 2;
    const size_t tstep = 2 * hstep;
    const unsigned ldsw = (unsigned)wid * 1024u;
    const int aoff = lds_byte(wr * 64 + fr, fq * 8), boff = lds_byte(wc * 32 + fr, fq * 8);
#define PG8_SA(b, h) (((b) * 2 + (h)) * HTB)
#define PG8_SB(b, h) ((4 + (b) * 2 + (h)) * HTB)
#define PG8_STAGE(bufoff, gbase, voff) do { _Pragma("unroll") for (int _i = 0; _i < 2; ++_i) \
        __builtin_amdgcn_global_load_lds((const unsigned*)((const char*)(gbase) + (voff)[_i]), (PG8_LAS unsigned*)(lds + (bufoff) + ldsw + _i * 8192), 16, 0, 0); } while (0)
#define PG8_LDA(dst, b, h) do { _Pragma("unroll") for (int m = 0; m < 4; ++m) _Pragma("unroll") for (int k = 0; k < 2; ++k) dst[m][k] = *(const PG8_LAS bf16x8*)(lds + PG8_SA(b, h) + aoff + m * 2048 + k * 1024); } while (0)
#define PG8_LDB(dst, b, h) do { _Pragma("unroll") for (int n = 0; n < 2; ++n) _Pragma("unroll") for (int k = 0; k < 2; ++k) dst[n][k] = *(const PG8_LAS bf16x8*)(lds + PG8_SB(b, h) + boff + n * 2048 + k * 1024); } while (0)
#define PG8_MMA(ai, bj, At, Bt) do { __builtin_amdgcn_s_setprio(1); _Pragma("unroll") for (int m = 0; m < 4; ++m) _Pragma("unroll") for (int n = 0; n < 2; ++n) _Pragma("unroll") for (int k = 0; k < 2; ++k) \
        acc[ai][bj][m][n] = __builtin_amdgcn_mfma_f32_16x16x32_bf16(Bt[n][k], At[m][k], acc[ai][bj][m][n], 0, 0, 0); __builtin_amdgcn_s_setprio(0); } while (0)
#define PG8_WAIT_V(n) asm volatile("s_waitcnt vmcnt(" #n ")" ::: "memory")
#define PG8_WAIT_L(n) asm volatile("s_waitcnt lgkmcnt(" #n ")" ::: "memory")
#define PG8_BAR __builtin_amdgcn_s_barrier()
#define PG8_SCHED __builtin_amdgcn_sched_barrier(0)
    Unit cur, nxt; int ui = 0;
    if (!S.next(0, cur)) return;
    f32x4 acc[2][2][4][2];
#pragma unroll
    for (int a = 0; a < 2; ++a)
#pragma unroll
        for (int b = 0; b < 2; ++b)
#pragma unroll
            for (int m = 0; m < 4; ++m)
#pragma unroll
                for (int n = 0; n < 2; ++n) acc[a][b][m][n] = (f32x4){0.f, 0.f, 0.f, 0.f};
    bf16x8 At[4][2], B0[2][2], B1[2][2];
    const char* cA = (const char*)g.A + (size_t)cur.pm * tstep; const char* cB = (const char*)g.Bt + (size_t)cur.pn * tstep;
    S.a_ready(cur);
    if constexpr (SP2) {
        PG8_STAGE(PG8_SB(0, 0), cB, voffB); PG8_STAGE(PG8_SB(0, 1), cB + hstep, voffB); PG8_STAGE(PG8_SA(0, 0), cA, voffA); PG8_STAGE(PG8_SA(0, 1), cA + hstep, voffA);
        if (wr == 1) PG8_BAR;
        PG8_WAIT_V(2); PG8_BAR;
        PG8_STAGE(PG8_SB(1, 0), cB + kstep, voffB); PG8_STAGE(PG8_SA(1, 0), cA + kstep, voffA); PG8_STAGE(PG8_SB(1, 1), cB + hstep + kstep, voffB);
        PG8_WAIT_V(6); PG8_BAR;
    } else {
        PG8_STAGE(PG8_SB(0, 0), cB, voffB); PG8_STAGE(PG8_SA(0, 0), cA, voffA); PG8_STAGE(PG8_SB(0, 1), cB + hstep, voffB); PG8_STAGE(PG8_SA(0, 1), cA + hstep, voffA);
        if (wr == 1) PG8_BAR;
        PG8_WAIT_V(4); PG8_BAR;
        PG8_STAGE(PG8_SB(1, 0), cB + kstep, voffB); PG8_STAGE(PG8_SA(1, 0), cA + kstep, voffA); PG8_STAGE(PG8_SB(1, 1), cB + hstep + kstep, voffB);
        PG8_WAIT_V(6); PG8_BAR;
    }
    for (;;) {
        const bool has_next = S.next(ui + 1, nxt);
        const char* nA = has_next ? (const char*)g.A + (size_t)nxt.pm * tstep : cA; const char* nB = has_next ? (const char*)g.Bt + (size_t)nxt.pn * tstep : cB;
        for (int t = 0; t < nt; t += 2) {
            const bool last = (t == nt - 2);
            const char* a1 = cA + (size_t)(t + 1) * kstep;
            const char* a2 = last ? nA : cA + (size_t)(t + 2) * kstep; const char* b2 = last ? nB : cB + (size_t)(t + 2) * kstep;
            const char* a3 = a2 + kstep; const char* b3 = b2 + kstep;
            if (last && has_next) S.a_ready(nxt);
            if constexpr (SP2) {
            PG8_LDB(B0, 0, 0); PG8_LDB(B1, 0, 1); PG8_SCHED; PG8_LDA(At, 0, 0); PG8_STAGE(PG8_SA(1, 1), a1 + hstep, voffA);
            PG8_WAIT_V(8); PG8_WAIT_L(0); PG8_BAR; PG8_MMA(0, 0, At, B0); PG8_MMA(0, 1, At, B1); PG8_BAR; PG8_SCHED;
            PG8_LDA(At, 0, 1); PG8_STAGE(PG8_SB(0, 0), b2, voffB); PG8_STAGE(PG8_SB(0, 1), b2 + hstep, voffB); PG8_STAGE(PG8_SA(0, 0), a2, voffA);
            PG8_WAIT_V(8); PG8_WAIT_L(0); PG8_BAR; PG8_MMA(1, 0, At, B0); PG8_MMA(1, 1, At, B1); PG8_BAR; PG8_SCHED;
            PG8_LDB(B0, 1, 0); PG8_LDB(B1, 1, 1); PG8_SCHED; PG8_LDA(At, 1, 0); PG8_STAGE(PG8_SA(0, 1), a2 + hstep, voffA);
            PG8_WAIT_V(8); PG8_WAIT_L(0); PG8_BAR; PG8_MMA(0, 0, At, B0); PG8_MMA(0, 1, At, B1); PG8_BAR; PG8_SCHED;
            PG8_LDA(At, 1, 1); PG8_STAGE(PG8_SB(1, 0), b3, voffB); PG8_STAGE(PG8_SB(1, 1), b3 + hstep, voffB); PG8_STAGE(PG8_SA(1, 0), a3, voffA);
            PG8_WAIT_V(8); PG8_WAIT_L(0); PG8_BAR; PG8_MMA(1, 0, At, B0); PG8_MMA(1, 1, At, B1); PG8_BAR; PG8_SCHED;
            } else {
            PG8_LDB(B0, 0, 0); PG8_SCHED; PG8_LDA(At, 0, 0); PG8_STAGE(PG8_SA(1, 1), a1 + hstep, voffA);
            PG8_WAIT_L(8); PG8_BAR; PG8_WAIT_L(0); PG8_MMA(0, 0, At, B0); PG8_BAR; PG8_SCHED;
            PG8_LDB(B1, 0, 1); PG8_STAGE(PG8_SB(0, 0), b2, voffB);
            PG8_BAR; PG8_WAIT_L(0); PG8_MMA(0, 1, At, B1); PG8_BAR;
            PG8_LDA(At, 0, 1); PG8_STAGE(PG8_SA(0, 0), a2, voffA);
            PG8_BAR; PG8_WAIT_L(0); PG8_MMA(1, 0, At, B0); PG8_BAR; PG8_SCHED;
            PG8_STAGE(PG8_SB(0, 1), b2 + hstep, voffB);
            PG8_WAIT_V(6); PG8_BAR; PG8_MMA(1, 1, At, B1); PG8_BAR;
            PG8_LDB(B0, 1, 0); PG8_SCHED; PG8_LDA(At, 1, 0); PG8_STAGE(PG8_SA(0, 1), a2 + hstep, voffA);
            PG8_WAIT_L(8); PG8_BAR; PG8_WAIT_L(0); PG8_MMA(0, 0, At, B0); PG8_BAR; PG8_SCHED;
            PG8_LDB(B1, 1, 1); PG8_STAGE(PG8_SB(1, 0), b3, voffB);
            PG8_BAR; PG8_WAIT_L(0); PG8_MMA(0, 1, At, B1); PG8_BAR;
            PG8_LDA(At, 1, 1); PG8_STAGE(PG8_SA(1, 0), a3, voffA);
            PG8_BAR; PG8_WAIT_L(0); PG8_MMA(1, 0, At, B0); PG8_BAR; PG8_SCHED;
            PG8_STAGE(PG8_SB(1, 1), b3 + hstep, voffB);
            PG8_WAIT_V(6); PG8_BAR; PG8_MMA(1, 1, At, B1); PG8_BAR;
            }
        }
        if constexpr (ALIGN_EPI) { if (wr == 0) PG8_BAR; }
        if constexpr (!Epi::AFTER_DRAIN) { E(acc, cur, wr, wc, fr, fq); S.done(cur); }
        if (!has_next) break;
#pragma unroll
        for (int a = 0; a < 2; ++a)
#pragma unroll
            for (int b = 0; b < 2; ++b)
#pragma unroll
                for (int m = 0; m < 4; ++m)
#pragma unroll
                    for (int n = 0; n < 2; ++n) acc[a][b][m][n] = (f32x4){0.f, 0.f, 0.f, 0.f};
        cur = nxt; cA = nA; cB = nB; ++ui;
        if constexpr (ALIGN_EPI) { if (wr == 1) PG8_BAR; }
    }
    PG8_WAIT_V(0);
    if constexpr (!ALIGN_EPI) { if (wr == 0) PG8_BAR; }
    PG8_BAR;
    if constexpr (Epi::AFTER_DRAIN) { E.fused(acc, cur, wr, wc, fr, fq, lds, wid, lane); S.done(cur); }
#undef PG8_SA
#undef PG8_SB
#undef PG8_STAGE
#undef PG8_LDA
#undef PG8_LDB
#undef PG8_MMA
#undef PG8_WAIT_V
#undef PG8_WAIT_L
#undef PG8_BAR
#undef PG8_SCHED
}
}
constexpr int NB = 8, SEQ = 4096, DM = 1024, NT = NB * SEQ, DEPTH = 4, DFF = 4096;
constexpr int NZ = 3328;
constexpr int ZQ = 0, ZK = 512, ZV = 1024, ZR = 1536, ZKR = 2048, ZVR = 2560, ZXW = 3072, ZMV = 3232;
constexpr size_t MiB = 1u << 20;
constexpr size_t WS_WIN = 1 * MiB, WS_WOUT = 27 * MiB, WS_WUP = 35 * MiB, WS_WDN = 67 * MiB, WS_LT = 99 * MiB;
constexpr size_t WS_XN = 100 * MiB, WS_VF = 164 * MiB, WS_BON = 196 * MiB, WS_BIG = 198 * MiB;
constexpr size_t WS_Z = WS_BIG, WS_YS = 406 * MiB, WS_G = 438 * MiB, WS_VC = 470 * MiB, WS_H = WS_BIG, WS_Y1 = WS_BIG, WS_END = 502 * MiB;
constexpr int LDS_BYTES = 147456;

#define LAS __attribute__((address_space(3)))
typedef unsigned short bf16;
typedef float f32x4 __attribute__((ext_vector_type(4)));
typedef unsigned u32x4 __attribute__((ext_vector_type(4)));
typedef unsigned u32x2 __attribute__((ext_vector_type(2)));
typedef short bf16x8 __attribute__((ext_vector_type(8)));
typedef short s16x4 __attribute__((ext_vector_type(4)));

__device__ __forceinline__ float bf2f(unsigned u) { return __uint_as_float(u << 16); }
__device__ __forceinline__ float bflo(unsigned u) { return __uint_as_float(u << 16); }
__device__ __forceinline__ float bfhi(unsigned u) { return __uint_as_float(u & 0xffff0000u); }
__device__ __forceinline__ unsigned f2bf(float f) { unsigned u = __float_as_uint(f); return (u + 0x7fffu + ((u >> 16) & 1u)) >> 16; }
__device__ __forceinline__ unsigned pk2(float lo, float hi) { return f2bf(lo) | (f2bf(hi) << 16); }
__device__ __forceinline__ float wave_sum(float v) {
#pragma unroll
    for (int o = 1; o < 64; o <<= 1) v += __shfl_xor(v, o);
    return v;
}
__device__ __forceinline__ float dppf(float v, const int ctrl_sel) {
    int r;
    if (ctrl_sel == 0) r = __builtin_amdgcn_update_dpp(0, __float_as_int(v), 0xB1, 0xF, 0xF, false);
    else if (ctrl_sel == 1) r = __builtin_amdgcn_update_dpp(0, __float_as_int(v), 0x4E, 0xF, 0xF, false);
    else if (ctrl_sel == 2) r = __builtin_amdgcn_update_dpp(0, __float_as_int(v), 0x141, 0xF, 0xF, false);
    else r = __builtin_amdgcn_update_dpp(0, __float_as_int(v), 0x140, 0xF, 0xF, false);
    return __int_as_float(r);
}
__device__ __forceinline__ float rowsum16(float v) { v += dppf(v, 0); v += dppf(v, 1); v += dppf(v, 2); v += dppf(v, 3); return v; }
__device__ __forceinline__ float sigmoidf_(float x) { return 1.0f / (1.0f + __expf(-x)); }

struct Params { const float* in[25]; float* out; unsigned char* ws; int ph_lo, ph_hi; };
#define MK_IDS const int tid = pg8::mk_tid(), lane = tid & 63, wave = __builtin_amdgcn_readfirstlane(tid >> 6); const int gw = blockIdx.x * 8 + wave; (void)gw; (void)lane

__device__ __forceinline__ void transpose_item(const float* W, int K, int N, bf16* WT, LAS float* scr, int item, int lane) {
    const int nblk = N / 32, kb = item / nblk, nb = item % nblk, k0 = 64 * kb, n0 = 32 * nb;
#pragma unroll 8
    for (int i = 0; i < 32; ++i) { const int kk = 2 * i + (lane >> 5); scr[kk * 33 + (lane & 31)] = W[(size_t)(k0 + kk) * N + n0 + (lane & 31)]; }
    asm volatile("s_waitcnt lgkmcnt(0)" ::: "memory");
    const int c = lane & 7;
#pragma unroll
    for (int j = 0; j < 4; ++j) { const int n = (lane >> 3) + 8 * j; const LAS float* s = scr + (8 * c) * 33 + n;
        u32x4 o; o.x = pk2(s[0 * 33], s[1 * 33]); o.y = pk2(s[2 * 33], s[3 * 33]); o.z = pk2(s[4 * 33], s[5 * 33]); o.w = pk2(s[6 * 33], s[7 * 33]);
        *(u32x4*)(WT + (size_t)(n0 + n) * K + k0 + 8 * c) = o; }
    asm volatile("s_waitcnt lgkmcnt(0)" ::: "memory");
}

__device__ __forceinline__ void prologue(const Params& p, LAS unsigned char* lds, int gw, int NGW, int wave, int lane) {
    unsigned char* ws = p.ws;
    LAS float* scr = (LAS float*)(lds + wave * 16384);
    constexpr int I_IN0 = 16 * 101, I_INR = 16 * 102, I_OUT = 16 * 32, I_UP = 16 * 128, I_DN = 64 * 32;
    constexpr int NITEMS = I_IN0 + 3 * I_INR + 4 * I_OUT + 4 * I_UP + 4 * I_DN;
    for (int it = gw; it < NITEMS; it += NGW) {
        int r = it;
        if (r < I_IN0) { transpose_item(p.in[5], 1024, 3232, (bf16*)(ws + WS_WIN), scr, r, lane); continue; } r -= I_IN0;
        if (r < 3 * I_INR) { const int l = r / I_INR; transpose_item(p.in[6] + (size_t)l * 1024 * 3264, 1024, 3264, (bf16*)(ws + WS_WIN) + (size_t)(l + 1) * NZ * 1024, scr, r % I_INR, lane); continue; } r -= 3 * I_INR;
        if (r < 4 * I_OUT) { const int l = r / I_OUT; transpose_item(p.in[22] + (size_t)l * 1024 * 1024, 1024, 1024, (bf16*)(ws + WS_WOUT) + (size_t)l * 1024 * 1024, scr, r % I_OUT, lane); continue; } r -= 4 * I_OUT;
        if (r < 4 * I_UP) { const int l = r / I_UP; transpose_item(p.in[23] + (size_t)l * 1024 * 4096, 1024, 4096, (bf16*)(ws + WS_WUP) + (size_t)l * 4096 * 1024, scr, r % I_UP, lane); continue; } r -= 4 * I_UP;
        { const int l = r / I_DN; transpose_item(p.in[24] + (size_t)l * 4096 * 1024, 4096, 1024, (bf16*)(ws + WS_WDN) + (size_t)l * 1024 * 4096, scr, r % I_DN, lane); }
    }
    {
        const int gt = gw * 64 + lane, NG = NGW * 64;
        const u32x4 z4 = {0u, 0u, 0u, 0u};
        for (int l = 0; l < 4; ++l) { const int r0 = (l == 0) ? 3232 : 3264; const int nvec = (NZ - r0) * 1024 / 8;
            u32x4* base = (u32x4*)((bf16*)(ws + WS_WIN) + ((size_t)l * NZ + r0) * 1024);
            for (int i = gt; i < nvec; i += NG) base[i] = z4; }
        bf16* LT = (bf16*)(ws + WS_LT);
        for (int i = gt; i < 4 * 512 * 192; i += NG) { const int l = i / (512 * 192), rem = i % (512 * 192), c = rem / 192, m = rem % 192; float v;
            if (m < 32) v = p.in[11][((size_t)l * 32 + m) * 512 + c];
            else if (m < 64) v = p.in[13][((size_t)l * 32 + (m - 32)) * 512 + c];
            else if (m < 160) v = p.in[16][((size_t)l * 96 + (m - 64)) * 512 + c];
            else v = (l > 0) ? p.in[15][((size_t)(l - 1) * 32 + (m - 160)) * 512 + c] : 0.f;
            LT[i] = (bf16)f2bf(v); }
    }
    const float* x = p.in[0]; const float* g = p.in[1]; bf16* XN = (bf16*)(ws + WS_XN);
    for (int row = gw; row < NT; row += NGW) {
        const f32x4* xr = (const f32x4*)(x + (size_t)row * DM) + lane; f32x4* orow = (f32x4*)(p.out + (size_t)row * DM) + lane;
        f32x4 v[4]; float s = 0.f;
#pragma unroll
        for (int j = 0; j < 4; ++j) { v[j] = xr[64 * j]; orow[64 * j] = v[j]; s += (v[j].x * v[j].x + v[j].y * v[j].y) + (v[j].z * v[j].z + v[j].w * v[j].w); }
        const float rstd = 1.0f / sqrtf(wave_sum(s) * (1.0f / DM) + 1e-6f);
        u32x2* o8 = (u32x2*)(XN + (size_t)row * DM) + lane;
#pragma unroll
        for (int j = 0; j < 4; ++j) { const f32x4 gg = ((const f32x4*)g)[lane + 64 * j]; u32x2 w; w.x = pk2(v[j].x * rstd * gg.x, v[j].y * rstd * gg.y); w.y = pk2(v[j].z * rstd * gg.z, v[j].w * rstd * gg.w); o8[64 * j] = w; }
    }
}

__device__ __forceinline__ void norm_phase(const bf16* Y, float* X, bf16* XN, const float* gpost, const float* gnext, int gw, int NGW, int lane) {
    for (int row = gw; row < NT; row += NGW) {
        const u32x4* yr = (const u32x4*)(Y + (size_t)row * DM); f32x4* xr = (f32x4*)(X + (size_t)row * DM);
        float y[16]; float ss = 0.f;
#pragma unroll
        for (int k = 0; k < 2; ++k) { const u32x4 w = yr[k * 64 + lane];
            y[k * 8 + 0] = bflo(w.x); y[k * 8 + 1] = bfhi(w.x); y[k * 8 + 2] = bflo(w.y); y[k * 8 + 3] = bfhi(w.y); y[k * 8 + 4] = bflo(w.z); y[k * 8 + 5] = bfhi(w.z); y[k * 8 + 6] = bflo(w.w); y[k * 8 + 7] = bfhi(w.w); }
#pragma unroll
        for (int e = 0; e < 16; ++e) ss += y[e] * y[e];
        const float rstd = 1.0f / sqrtf(wave_sum(ss) * (1.0f / DM) + 1e-6f);
        float xn[16]; float s2 = 0.f;
#pragma unroll
        for (int k = 0; k < 2; ++k)
#pragma unroll
            for (int q = 0; q < 2; ++q) { const int vi = k * 128 + lane * 2 + q; f32x4 xv = xr[vi]; const f32x4 gg = ((const f32x4*)gpost)[vi];
#pragma unroll
                for (int e = 0; e < 4; ++e) { const float t = xv[e] + y[k * 8 + q * 4 + e] * rstd * gg[e]; xv[e] = t; xn[k * 8 + q * 4 + e] = t; s2 += t * t; }
                xr[vi] = xv; }
        if (gnext) {
            const float r2 = 1.0f / sqrtf(wave_sum(s2) * (1.0f / DM) + 1e-6f);
            u32x4* o = (u32x4*)(XN + (size_t)row * DM);
#pragma unroll
            for (int k = 0; k < 2; ++k) { const f32x4 g0 = ((const f32x4*)gnext)[k * 128 + lane * 2], g1 = ((const f32x4*)gnext)[k * 128 + lane * 2 + 1]; u32x4 w;
                w.x = pk2(xn[k * 8 + 0] * r2 * g0.x, xn[k * 8 + 1] * r2 * g0.y); w.y = pk2(xn[k * 8 + 2] * r2 * g0.z, xn[k * 8 + 3] * r2 * g0.w);
                w.z = pk2(xn[k * 8 + 4] * r2 * g1.x, xn[k * 8 + 5] * r2 * g1.y); w.w = pk2(xn[k * 8 + 6] * r2 * g1.z, xn[k * 8 + 7] * r2 * g1.w);
                o[k * 64 + lane] = w; }
        }
    }
}

__device__ __forceinline__ void post_phase(bf16* MIX, const bf16* YS, const bf16* GB, const bf16* VC, const float* BON, const float* again, const float* gnw, const float* gnb, int gw, int NGW, int lane) {
    for (int row = gw; row < NT; row += NGW) {
        u32x4* mrow = (u32x4*)(MIX + (size_t)row * DM);
        {
            const u32x4 w = mrow[lane]; float o[8] = {bflo(w.x), bfhi(w.x), bflo(w.y), bfhi(w.y), bflo(w.z), bfhi(w.z), bflo(w.w), bfhi(w.w)}; float ss = 0.f;
#pragma unroll
            for (int e = 0; e < 8; ++e) ss += o[e] * o[e];
            const float rstd = 1.0f / sqrtf(wave_sum(ss) * (1.0f / 512.0f) + 1e-6f);
            const f32x4 g0 = ((const f32x4*)again)[lane * 2], g1 = ((const f32x4*)again)[lane * 2 + 1]; u32x4 r;
            r.x = pk2(o[0] * rstd * g0.x, o[1] * rstd * g0.y); r.y = pk2(o[2] * rstd * g0.z, o[3] * rstd * g0.w); r.z = pk2(o[4] * rstd * g1.x, o[5] * rstd * g1.y); r.w = pk2(o[6] * rstd * g1.z, o[7] * rstd * g1.w);
            mrow[lane] = r;
        }
        {
            const u32x4 w = ((const u32x4*)(YS + (size_t)row * 512))[lane]; float y[8] = {bflo(w.x), bfhi(w.x), bflo(w.y), bfhi(w.y), bflo(w.z), bfhi(w.z), bflo(w.w), bfhi(w.w)};
            float s1 = 0.f;
#pragma unroll
            for (int e = 0; e < 8; ++e) s1 += y[e];
            s1 += __shfl_xor(s1, 1); s1 += __shfl_xor(s1, 2); s1 += __shfl_xor(s1, 4);
            const float mean = s1 * (1.0f / 64.0f); float s2 = 0.f;
#pragma unroll
            for (int e = 0; e < 8; ++e) { y[e] -= mean; s2 += y[e] * y[e]; }
            s2 += __shfl_xor(s2, 1); s2 += __shfl_xor(s2, 2); s2 += __shfl_xor(s2, 4);
            const float rs = 1.0f / sqrtf(s2 * (1.0f / 64.0f) + 64e-5f);
            const u32x4 vw = ((const u32x4*)(VC + (size_t)row * 512))[lane], gw4 = ((const u32x4*)(GB + (size_t)row * 512))[lane];
            const float v[8] = {bflo(vw.x), bfhi(vw.x), bflo(vw.y), bfhi(vw.y), bflo(vw.z), bfhi(vw.z), bflo(vw.w), bfhi(vw.w)};
            const float g[8] = {bflo(gw4.x), bfhi(gw4.x), bflo(gw4.y), bfhi(gw4.y), bflo(gw4.z), bfhi(gw4.z), bflo(gw4.w), bfhi(gw4.w)};
            const float bon = BON[(size_t)row * 8 + (lane >> 3)];
            const f32x4 w0 = ((const f32x4*)gnw)[lane * 2], w1 = ((const f32x4*)gnw)[lane * 2 + 1], b0 = ((const f32x4*)gnb)[lane * 2], b1 = ((const f32x4*)gnb)[lane * 2 + 1];
            const float gwv[8] = {w0.x, w0.y, w0.z, w0.w, w1.x, w1.y, w1.z, w1.w}, gbv[8] = {b0.x, b0.y, b0.z, b0.w, b1.x, b1.y, b1.z, b1.w};
            float o[8];
#pragma unroll
            for (int e = 0; e < 8; ++e) o[e] = (y[e] * rs * gwv[e] + gbv[e] + bon * v[e]) * g[e];
            u32x4 r; r.x = pk2(o[0], o[1]); r.y = pk2(o[2], o[3]); r.z = pk2(o[4], o[5]); r.w = pk2(o[6], o[7]);
            mrow[64 + lane] = r;
        }
    }
}

__device__ __forceinline__ void attn_unit(LAS unsigned char* lds, const bf16* Z, bf16* MIX, int unit, int wave, int lane) {
    const int b = unit >> 4, t0 = (unit & 15) * 256;
    LAS float* ACC = (LAS float*)lds;
    LAS float* ML = (LAS float*)(lds + 256 * 68 * 4);
    LAS unsigned char* VST = lds + 256 * 68 * 4 + 2048 + wave * 4096;
    const int li = lane & 15, quad = lane >> 4;
    const float C = 0.125f * 1.4426950408889634f;
    const size_t rowbase = (size_t)b * SEQ;
    for (int h = 0; h < 8; ++h) {
#pragma unroll 1
        for (int br = 0; br < 3; ++br) {
            const int lg = br * 2; const int L = SEQ >> lg;
#pragma unroll 1
            for (int u = 0; u < 2; ++u) {
                const int tu = wave * 2 + u;
                int r, i0;
                if (br == 0) { r = 0; i0 = t0 + tu * 16; } else if (br == 1) { r = tu & 3; i0 = (t0 >> 2) + (tu >> 2) * 16; } else { r = tu; i0 = t0 >> 4; }
                const int tq = ((i0 + li) << lg) + r;
                const bf16* qp = Z + (rowbase + tq) * NZ + ZQ + h * 64 + quad * 8;
                const bf16x8 q0 = *(const bf16x8*)qp, q1 = *(const bf16x8*)(qp + 32);
                f32x4 s[9];
#pragma unroll
                for (int kt = 0; kt < 9; ++kt) {
                    int ik = i0 - 128 + kt * 16 + li; ik = ik < 0 ? 0 : ik;
                    const bf16* kp = Z + (rowbase + (ik << lg) + r) * NZ + ZK + h * 64 + quad * 8;
                    const bf16x8 k0 = *(const bf16x8*)kp, k1 = *(const bf16x8*)(kp + 32);
                    f32x4 a = {0.f, 0.f, 0.f, 0.f};
                    a = __builtin_amdgcn_mfma_f32_16x16x32_bf16(k0, q0, a, 0, 0, 0);
                    a = __builtin_amdgcn_mfma_f32_16x16x32_bf16(k1, q1, a, 0, 0, 0);
                    s[kt] = a;
                }
                u32x4 vv[5][4];
#pragma unroll
                for (int cc = 0; cc < 5; ++cc)
#pragma unroll
                    for (int it = 0; it < 4; ++it) { const int idx = it * 64 + lane, rr = idx >> 3, c16 = idx & 7; int ik = i0 - 128 + cc * 32 + rr; ik = ik < 0 ? 0 : (ik > L - 1 ? L - 1 : ik);
                        vv[cc][it] = *(const u32x4*)(Z + (rowbase + (ik << lg) + r) * NZ + ZV + h * 64 + c16 * 8); }
                float mx = -1e30f;
#pragma unroll
                for (int kt = 0; kt < 9; ++kt)
#pragma unroll
                    for (int j = 0; j < 4; ++j) { const int key = kt * 16 + quad * 4 + j; const int dist = 128 + li - key; const int ik = i0 - 128 + key;
                        const bool valid = (dist >= 0) && (dist <= 128) && (ik >= 0);
                        const float sv = valid ? s[kt][j] : -1e30f; s[kt][j] = sv; mx = fmaxf(mx, sv); }
                mx = fmaxf(mx, __shfl_xor(mx, 16)); mx = fmaxf(mx, __shfl_xor(mx, 32));
                float lsum = 0.f;
#pragma unroll
                for (int kt = 0; kt < 9; ++kt)
#pragma unroll
                    for (int j = 0; j < 4; ++j) { const float pv = __builtin_amdgcn_exp2f((s[kt][j] - mx) * C); s[kt][j] = pv; lsum += pv; }
                lsum += __shfl_xor(lsum, 16); lsum += __shfl_xor(lsum, 32);
                f32x4 o[4];
#pragma unroll
                for (int dt = 0; dt < 4; ++dt) o[dt] = (f32x4){0.f, 0.f, 0.f, 0.f};
#pragma unroll
                for (int cc = 0; cc < 5; ++cc) {
                    asm volatile("s_waitcnt lgkmcnt(0)" ::: "memory");
#pragma unroll
                    for (int it = 0; it < 4; ++it) { const int idx = it * 64 + lane, rr = idx >> 3, c16 = idx & 7;
                        *(LAS u32x4*)(VST + rr * 128 + c16 * 16) = vv[cc][it]; }
                    asm volatile("s_waitcnt lgkmcnt(0)" ::: "memory");
                    bf16x8 pa;
                    { const f32x4 p0 = s[2 * cc]; const unsigned a0 = pk2(p0[0], p0[1]), a1 = pk2(p0[2], p0[3]); unsigned a2 = 0u, a3 = 0u;
                      if (cc < 4) { const f32x4 p1 = s[2 * cc + 1 < 9 ? 2 * cc + 1 : 8]; a2 = pk2(p1[0], p1[1]); a3 = pk2(p1[2], p1[3]); }
                      const u32x4 pw = {a0, a1, a2, a3}; pa = __builtin_bit_cast(bf16x8, pw); }
#pragma unroll
                    for (int dt = 0; dt < 4; ++dt) {
                        LAS unsigned char* ap = VST + (quad * 4 + (li >> 2)) * 128 + (dt * 16 + (li & 3) * 4) * 2;
                        const s16x4 b1 = __builtin_bit_cast(s16x4, __builtin_amdgcn_ds_read_tr16_b64_v4i16((LAS s16x4*)ap));
                        const s16x4 b2 = __builtin_bit_cast(s16x4, __builtin_amdgcn_ds_read_tr16_b64_v4i16((LAS s16x4*)(ap + 16 * 128)));
                        const bf16x8 vb = {b1[0], b1[1], b1[2], b1[3], b2[0], b2[1], b2[2], b2[3]};
                        o[dt] = __builtin_amdgcn_mfma_f32_16x16x32_bf16(pa, vb, o[dt], 0, 0, 0);
                    }
                }
#pragma unroll
                for (int j = 0; j < 4; ++j) {
                    const int qq = quad * 4 + j;
                    const float mr = __shfl(mx, qq), lr = __shfl(lsum, qq);
                    const int tl = (br == 0) ? tu * 16 + qq : (br == 1) ? ((((tu >> 2) * 16 + qq) << 2) + (tu & 3)) : qq * 16 + tu;
                    LAS float* arow = ACC + tl * 68;
                    if (br == 0) {
#pragma unroll
                        for (int dt = 0; dt < 4; ++dt) arow[dt * 16 + li] = o[dt][j];
                        if (li == 0) { ML[tl * 2] = mr; ML[tl * 2 + 1] = lr; }
                    } else {
                        const float m0 = ML[tl * 2], l0 = ML[tl * 2 + 1];
                        const float mn = fmaxf(m0, mr); const float a0 = __builtin_amdgcn_exp2f((m0 - mn) * C), a1 = __builtin_amdgcn_exp2f((mr - mn) * C);
                        const float ln = l0 * a0 + lr * a1;
                        float val[4];
#pragma unroll
                        for (int dt = 0; dt < 4; ++dt) val[dt] = arow[dt * 16 + li] * a0 + o[dt][j] * a1;
                        asm volatile("s_waitcnt lgkmcnt(0)" ::: "memory");
                        if (br == 1) {
#pragma unroll
                            for (int dt = 0; dt < 4; ++dt) arow[dt * 16 + li] = val[dt];
                            if (li == 0) { ML[tl * 2] = mn; ML[tl * 2 + 1] = ln; }
                        } else {
                            const float inv = 1.0f / ln; bf16* orow = MIX + (rowbase + t0 + tl) * DM + h * 64 + li;
#pragma unroll
                            for (int dt = 0; dt < 4; ++dt) orow[dt * 16] = (bf16)f2bf(val[dt] * inv);
                        }
                    }
                }
            }
            __syncthreads();
        }
    }
}

constexpr int TC = 32;
constexpr int SC_RS = 0, SC_WW = 8192, SC_KS = 16384, SC_KK = 24576, SC_BV = 32768, SC_VS = 40960, SC_ACT = 49152, ACT_PITCH = 400, SC_INVN = SC_ACT + TC * ACT_PITCH, SC_BONP = SC_INVN + 128, SC_MU = SC_BONP + 512;
__device__ __forceinline__ void scan_unit(LAS unsigned char* lds, const Params& p, int layer, int unit, int tid, int wave, int lane) {
    const int chain = unit >> 1, hf = unit & 1, b = chain >> 3, h = chain & 7;
    unsigned char* ws = p.ws;
    const bf16* Z = (const bf16*)(ws + WS_Z); bf16* VF = (bf16*)(ws + WS_VF); bf16* YS = (bf16*)(ws + WS_YS); bf16* GB = (bf16*)(ws + WS_G); bf16* VC = (bf16*)(ws + WS_VC); float* BON = (float*)(ws + WS_BON);
    const bf16* LT = (const bf16*)(ws + WS_LT) + (size_t)layer * 512 * 192;
    const float* mu = p.in[7] + (size_t)layer * 1696; const float* mumv = (layer > 0) ? p.in[8] + (size_t)(layer - 1) * 32 : nullptr;
    LAS float* RS = (LAS float*)(lds + SC_RS); LAS float* WW = (LAS float*)(lds + SC_WW); LAS float* KS = (LAS float*)(lds + SC_KS); LAS float* KK = (LAS float*)(lds + SC_KK);
    LAS float* BV = (LAS float*)(lds + SC_BV); LAS float* VS = (LAS float*)(lds + SC_VS); LAS unsigned char* ACT = lds + SC_ACT; LAS float* INVN = (LAS float*)(lds + SC_INVN); LAS float* BONP = (LAS float*)(lds + SC_BONP);
    const int li = lane & 15, quad = lane >> 4;
    const size_t rowbase = (size_t)b * SEQ;
    const int tt = wave >> 2, ct = wave & 3, cl = ct * 16 + li, cg_ = h * 64 + cl;
    const float w0c = p.in[10][layer * 512 + cg_], a0c = p.in[12][layer * 512 + cg_], v0c = (layer > 0) ? p.in[14][(layer - 1) * 512 + cg_] : 0.f;
    const float kkc = p.in[17][layer * 512 + cg_], kac = p.in[18][layer * 512 + cg_], rkc = p.in[19][layer * 512 + cg_];
    bf16x8 Bf[6];
#pragma unroll
    for (int ks = 0; ks < 6; ++ks) Bf[ks] = *(const bf16x8*)(LT + (size_t)cg_ * 192 + ks * 32 + quad * 8);
    const float kk_lane = p.in[17][layer * 512 + h * 64 + lane];
    const int irow = hf * 32 + wave * 4 + quad, j0 = li * 4;
    float S0 = 0.f, S1 = 0.f, S2 = 0.f, S3 = 0.f, ykeep = 0.f;
    LAS float* MU = (LAS float*)(lds + SC_MU);
    if (tid < 96) { const int cgp = tid; int zc;
        if (cgp < 16) zc = ZR + h * 64 + cgp * 4; else if (cgp < 32) zc = ZKR + h * 64 + (cgp - 16) * 4; else if (cgp < 48) zc = ZVR + h * 64 + (cgp - 32) * 4; else zc = ZXW + (cgp - 48) * 4;
        f32x4 m4 = {0.f, 0.f, 0.f, 0.f}; if (zc < ZMV) m4 = *(const f32x4*)(mu + (zc - ZR)); else if (mumv) m4 = *(const f32x4*)(mumv + (zc - ZMV));
        *(LAS f32x4*)(MU + cgp * 4) = m4; }
    u32x2 pc[6], pp[6]; unsigned short pvf[4] = {0, 0, 0, 0};
    const int t1 = tid >> 4, q1 = tid & 15;
#define SC_ZC(k) ((k) == 0 ? ZR + h * 64 + q1 * 4 : (k) == 1 ? ZKR + h * 64 + q1 * 4 : (k) == 2 ? ZVR + h * 64 + q1 * 4 : ZXW + ((k) - 3) * 64 + q1 * 4)
#define SC_ISSUE(tchv) do { _Pragma("unroll") for (int k = 0; k < 6; ++k) { const int zc = SC_ZC(k); const int tg = (tchv) + t1; \
        pc[k] = *(const u32x2*)(Z + (rowbase + tg) * NZ + zc); const int tgp = tg > 0 ? tg - 1 : 0; pp[k] = *(const u32x2*)(Z + (rowbase + tgp) * NZ + zc); } \
        if (layer > 0) { _Pragma("unroll") for (int j = 0; j < 4; ++j) pvf[j] = VF[(rowbase + (tchv) + tt * 16 + quad * 4 + j) * 512 + cg_]; } } while (0)
    SC_ISSUE(0);
    __syncthreads();
#pragma unroll 1
    for (int tch = 0; tch < SEQ; tch += TC) {
        unsigned short cvf[4];
#pragma unroll
        for (int j = 0; j < 4; ++j) cvf[j] = pvf[j];
        const float pz = (tch + t1 > 0) ? 1.0f : 0.0f;
#pragma unroll
        for (int k = 0; k < 6; ++k) {
            const u32x2 cw = pc[k], pw = pp[k];
            const f32x4 m4 = *(const LAS f32x4*)(MU + (k * 16 + q1) * 4);
            const float c0 = bflo(cw.x), c1 = bfhi(cw.x), c2 = bflo(cw.y), c3 = bfhi(cw.y), p0 = bflo(pw.x) * pz, p1 = bfhi(pw.x) * pz, p2 = bflo(pw.y) * pz, p3 = bfhi(pw.y) * pz;
            f32x4 v = {c0 + (p0 - c0) * m4.x, c1 + (p1 - c1) * m4.y, c2 + (p2 - c2) * m4.z, c3 + (p3 - c3) * m4.w};
            if (k == 0) *(LAS f32x4*)(RS + t1 * 64 + q1 * 4) = v;
            else if (k == 1) *(LAS f32x4*)(KS + t1 * 64 + q1 * 4) = v;
            else if (k == 2) *(LAS f32x4*)(VS + t1 * 64 + q1 * 4) = v;
            else {
                const int ac = (k - 3) * 64 + q1 * 4;
                const bool is_t = ac < 32, is_s = (ac >= 64) && (ac < 160);
                const float A = is_t ? 1.0f : 0.0f, B = is_t ? -2.0f : 1.0f, Cc = is_t ? 2.0f : -1.0f;
                f32x4 a;
#pragma unroll
                for (int e = 0; e < 4; ++e) { const float f = A + B / (1.0f + __expf(Cc * v[e])); a[e] = (is_t || is_s) ? f : v[e]; }
                u32x2 w; w.x = pk2(a.x, a.y); w.y = pk2(a.z, a.w); *(LAS u32x2*)(ACT + t1 * ACT_PITCH + ac * 2) = w; }
        }
        if (tch + TC < SEQ) SC_ISSUE(tch + TC);
        __syncthreads();
#pragma unroll
        for (int q = 0; q < 4; ++q) { const int t = wave * 4 + q; const float kv = KS[t * 64 + lane] * kk_lane; const float ss = wave_sum(kv * kv); if (lane == 0) INVN[t] = 1.0f / fmaxf(sqrtf(ss), 1e-12f); }
        __syncthreads();
        {
            bf16x8 Af[6];
#pragma unroll
            for (int ks = 0; ks < 6; ++ks) Af[ks] = *(const LAS bf16x8*)(ACT + (tt * 16 + li) * ACT_PITCH + ks * 64 + quad * 16);
            const f32x4 z4 = {0.f, 0.f, 0.f, 0.f};
            const f32x4 LW = __builtin_amdgcn_mfma_f32_16x16x32_bf16(Af[0], Bf[0], z4, 0, 0, 0);
            const f32x4 AA = __builtin_amdgcn_mfma_f32_16x16x32_bf16(Af[1], Bf[1], z4, 0, 0, 0);
            f32x4 G = __builtin_amdgcn_mfma_f32_16x16x32_bf16(Af[2], Bf[2], z4, 0, 0, 0);
            G = __builtin_amdgcn_mfma_f32_16x16x32_bf16(Af[3], Bf[3], G, 0, 0, 0);
            G = __builtin_amdgcn_mfma_f32_16x16x32_bf16(Af[4], Bf[4], G, 0, 0, 0);
            const f32x4 VG = __builtin_amdgcn_mfma_f32_16x16x32_bf16(Af[5], Bf[5], z4, 0, 0, 0);
#pragma unroll
            for (int j = 0; j < 4; ++j) {
                const int t = tt * 16 + quad * 4 + j; const size_t grow = rowbase + tch + t;
                const float r = RS[t * 64 + cl], k = KS[t * 64 + cl]; float v = VS[t * 64 + cl];
                const float xx = -(w0c + LW[j]); const float sp = xx > 20.f ? xx : __logf(1.0f + __expf(xx));
                const float w = __expf(-__expf(-sp - 0.5f));
                const float a = sigmoidf_(a0c + AA[j]);
                const float kkv = k * kkc * INVN[t]; const float kmod = k * (1.0f + (a - 1.0f) * kac); const float bv = kkv * a;
                if (layer > 0) { const float vg = sigmoidf_(v0c + VG[j]); const float vf = bf2f((unsigned)cvf[j]); v = v + (vf - v) * vg; }
                else if (hf == 0) VF[grow * 512 + cg_] = (bf16)f2bf(v);
                asm volatile("s_waitcnt lgkmcnt(0)" ::: "memory");
                WW[t * 64 + cl] = w; KS[t * 64 + cl] = kmod; KK[t * 64 + cl] = kkv; BV[t * 64 + cl] = bv; VS[t * 64 + cl] = v;
                if (hf == 0) { GB[grow * 512 + cg_] = (bf16)f2bf(G[j]); VC[grow * 512 + cg_] = (bf16)f2bf(v); }
                float bp = r * kmod * rkc; bp += __shfl_xor(bp, 1); bp += __shfl_xor(bp, 2); bp += __shfl_xor(bp, 4); bp += __shfl_xor(bp, 8);
                if (li == 0) BONP[t * 4 + ct] = bp;
            }
        }
        __syncthreads();
        if (hf == 0 && tid < TC) BON[(rowbase + tch + tid) * 8 + h] = (BONP[tid * 4] + BONP[tid * 4 + 1]) + (BONP[tid * 4 + 2] + BONP[tid * 4 + 3]);
#pragma unroll 4
        for (int t = 0; t < TC; ++t) {
            const f32x4 w = *(const LAS f32x4*)(WW + t * 64 + j0), kk = *(const LAS f32x4*)(KK + t * 64 + j0), bv = *(const LAS f32x4*)(BV + t * 64 + j0), kx = *(const LAS f32x4*)(KS + t * 64 + j0), rx = *(const LAS f32x4*)(RS + t * 64 + j0);
            const float v = VS[t * 64 + irow];
            float sa = (S0 * kk.x + S1 * kk.y) + (S2 * kk.z + S3 * kk.w);
            sa = rowsum16(sa);
            S0 = S0 * w.x + (v * kx.x - sa * bv.x); S1 = S1 * w.y + (v * kx.y - sa * bv.y); S2 = S2 * w.z + (v * kx.z - sa * bv.z); S3 = S3 * w.w + (v * kx.w - sa * bv.w);
            float y = (S0 * rx.x + S1 * rx.y) + (S2 * rx.z + S3 * rx.w);
            y = rowsum16(y);
            ykeep = (li == (t & 15)) ? y : ykeep;
            if ((t & 15) == 15) YS[(rowbase + tch + (t & ~15) + li) * 512 + h * 64 + irow] = (bf16)f2bf(ykeep);
        }
        __syncthreads();
    }
}

#ifndef MK_NO_SCAN
#define SCAN_CALL scan_unit(lds, p, l, u, tid, wave, lane)
#else
#define SCAN_CALL
#endif
#ifndef MK_NO_ATTN
#define ATTN_CALL attn_unit(lds, Zb, XN, u - 128, wave, lane)
#else
#define ATTN_CALL
#endif
__global__ void __launch_bounds__(512, 2) mk_fwd(Params p) {
    extern __shared__ __attribute__((aligned(16))) unsigned char lds_raw[];
    LAS unsigned char* lds = (LAS unsigned char*)lds_raw;
    cg::grid_group grid = cg::this_grid();
    const int G = gridDim.x, NGW = G * 8;
    unsigned char* ws = p.ws;
    bf16* XN = (bf16*)(ws + WS_XN); bf16* Zb = (bf16*)(ws + WS_Z); bf16* Hb = (bf16*)(ws + WS_H); bf16* Y1 = (bf16*)(ws + WS_Y1);
    int ph = 0;
#define PH_ON (ph >= p.ph_lo && ph < p.ph_hi)
#define PH_END do { if (ph + 1 < p.ph_hi) grid.sync(); } while (0)
    if (PH_ON) { MK_IDS; prologue(p, lds, gw, NGW, wave, lane); PH_END; } ++ph;
#pragma unroll 1
    for (int l = 0; l < DEPTH; ++l) {
        if (PH_ON) { pg8::Gemm g{XN, (const bf16*)(ws + WS_WIN) + (size_t)l * NZ * 1024, NT, NZ, 1024}; pg8::StaticOrder S; S.init(NT, NZ, G, (int)blockIdx.x);
            pg8::EpiAct<0> E{Zb, NZ}; pg8::gemm_phase<pg8::EpiAct<0>, pg8::StaticOrder, true, true>(lds, g, S, E); PH_END; } ++ph;
        if (PH_ON) { MK_IDS;
            for (int u = blockIdx.x; u < 128; u += G) { SCAN_CALL; __syncthreads(); }
            for (int u = (blockIdx.x >= 128 ? blockIdx.x : blockIdx.x + ((127 - blockIdx.x) / G + 1) * G); u < 256; u += G) { ATTN_CALL; __syncthreads(); }
            PH_END; } ++ph;
        if (PH_ON) { MK_IDS; post_phase(XN, (const bf16*)(ws + WS_YS), (const bf16*)(ws + WS_G), (const bf16*)(ws + WS_VC), (const float*)(ws + WS_BON), p.in[9] + l * 512, p.in[20] + l * 512, p.in[21] + l * 512, gw, NGW, lane); PH_END; } ++ph;
        if (PH_ON) { pg8::Gemm g{XN, (const bf16*)(ws + WS_WOUT) + (size_t)l * 1024 * 1024, NT, 1024, 1024}; pg8::StaticOrder S; S.init(NT, 1024, G, (int)blockIdx.x);
            pg8::EpiAct<0> E{Y1, 1024}; pg8::gemm_phase<pg8::EpiAct<0>, pg8::StaticOrder, true, true>(lds, g, S, E); PH_END; } ++ph;
        if (PH_ON) { MK_IDS; norm_phase(Y1, p.out, XN, p.in[2] + l * 1024, p.in[3] + l * 1024, gw, NGW, lane); PH_END; } ++ph;
        if (PH_ON) { pg8::Gemm g{XN, (const bf16*)(ws + WS_WUP) + (size_t)l * 4096 * 1024, NT, DFF, 1024}; pg8::StaticOrder S; S.init(NT, DFF, G, (int)blockIdx.x);
            pg8::EpiAct<1> E{Hb, DFF}; pg8::gemm_phase<pg8::EpiAct<1>, pg8::StaticOrder, true, true>(lds, g, S, E); PH_END; } ++ph;
        if (PH_ON) { pg8::Gemm g{Hb, (const bf16*)(ws + WS_WDN) + (size_t)l * 1024 * 4096, NT, 1024, DFF}; pg8::StaticOrder S; S.init(NT, 1024, G, (int)blockIdx.x);
            pg8::EpiAct<0> E{XN, 1024}; pg8::gemm_phase<pg8::EpiAct<0>, pg8::StaticOrder, true, true>(lds, g, S, E); PH_END; } ++ph;
        if (PH_ON) { MK_IDS; norm_phase(XN, p.out, XN, p.in[4] + l * 1024, (l + 1 < DEPTH) ? p.in[1] + (l + 1) * 1024 : nullptr, gw, NGW, lane); PH_END; } ++ph;
    }
}
constexpr int N_PHASES = 1 + 8 * DEPTH;

extern "C" void kernel_launch(void* const* d_in, const int* in_sizes, int n_in, void* d_out, int out_size, void* d_ws, size_t ws_size, hipStream_t stream) {
    static int grid = 0;
    if (grid == 0) {
        if (n_in != 25 || out_size != NT * DM || ws_size < WS_END) { fprintf(stderr, "kernel_launch: unexpected sizes n_in=%d out=%d ws=%zu\n", n_in, out_size, ws_size); grid = -1; return; }
        int dev = 0, cus = 0, per_cu = 0;
        hipGetDevice(&dev); hipDeviceGetAttribute(&cus, hipDeviceAttributeMultiprocessorCount, dev);
        if (hipFuncSetAttribute((const void*)mk_fwd, hipFuncAttributeMaxDynamicSharedMemorySize, LDS_BYTES) != hipSuccess) { fprintf(stderr, "kernel_launch: hipFuncSetAttribute failed\n"); grid = -1; return; }
        if (hipOccupancyMaxActiveBlocksPerMultiprocessor(&per_cu, (const void*)mk_fwd, 512, LDS_BYTES) != hipSuccess || per_cu < 1) { fprintf(stderr, "kernel_launch: occupancy query gave %d\n", per_cu); per_cu = 1; }
        (void)hipGetLastError();
        grid = cus * per_cu;
        fprintf(stderr, "kernel_launch: grid %d (cus %d x %d)\n", grid, cus, per_cu);
    }
    if (grid < 0) return;
    Params p{};
    for (int i = 0; i < 25; ++i) p.in[i] = (const float*)d_in[i];
    p.out = (float*)d_out; p.ws = (unsigned char*)d_ws;
#if MK_MULTI
    for (int ph = 0; ph < N_PHASES; ++ph) { p.ph_lo = ph; p.ph_hi = ph + 1; hipLaunchKernelGGL(mk_fwd, dim3(grid), dim3(512), LDS_BYTES, stream, p); }
#else
    p.ph_lo = 0; p.ph_hi = N_PHASES;
    void* args[] = {&p};
    hipError_t e = hipLaunchCooperativeKernel((const void*)mk_fwd, dim3(grid), dim3(512), args, LDS_BYTES, stream);
    if (e != hipSuccess) fprintf(stderr, "kernel_launch: cooperative launch failed: %s (grid %d)\n", hipGetErrorString(e), grid);
#endif
}
```

```cpp
#include <hip/hip_runtime.h>
#include <hip/hip_cooperative_groups.h>
#include <cstdio>
#include <cstdint>
namespace cg = cooperative_groups;
#ifndef MK_MULTI
#define MK_MULTI 0
#endif
namespace pg8 {
#define PG8_LAS __attribute__((address_space(3)))
typedef unsigned short bf16_t;
typedef short bf16x8 __attribute__((ext_vector_type(8)));
typedef float f32x4 __attribute__((ext_vector_type(4)));
typedef unsigned u32x4 __attribute__((ext_vector_type(4)));
constexpr int BM = 256, BK = 64, HALF = 128, HTB = HALF * BK * 2  , STAGE_BYTES = 8 * HTB, NXCD = 8, WGM = 8;

__host__ __device__ __forceinline__ int lds_byte(int r, int c) { const int st = (r >> 4) * 2 + (c >> 5), rr = r & 15, cc = c & 31, ob = rr * 64 + cc * 2; return st * 1024 + (ob ^ (((ob >> 9) & 1) << 5)); }
__host__ __device__ __forceinline__ void stage_rc(int b, int& R, int& C) { const int st = b / 1024, sb = b % 1024, swz = sb ^ (((sb >> 9) & 1) << 5); R = (st >> 1) * 16 + swz / 64; C = (st & 1) * 32 + (swz % 64) / 2; }
__host__ __device__ __forceinline__ int perm32(int rho) { const int n = rho >> 4, i = rho & 15; return 8 * (i >> 2) + 4 * n + (i & 3); }

struct Unit { int pm, pn; };
struct Gemm { const bf16_t* A; const bf16_t* Bt; int M, N, K; };
struct StaticOrder {
    int nM, nN, nwg, G, c;
    __host__ __device__ void init(int M, int N, int G_, int c_) { nM = M / BM; nN = N / BM; nwg = nM * nN; G = G_; c = c_; }
    __host__ __device__ bool next(int i, Unit& u) const {
        const long L = (long)i * G + c; if (L >= nwg) return false;
        int wgid = (int)L; { const int q = nwg / NXCD, r = nwg % NXCD, xcd = wgid % NXCD, off = wgid / NXCD; wgid = (xcd < r ? xcd * (q + 1) : r * (q + 1) + (xcd - r) * q) + off; }
        const int nig = WGM * nN, gid = wgid / nig, fm = gid * WGM, gsz = (nM - fm) < WGM ? (nM - fm) : WGM;
        u.pm = fm + ((wgid % nig) % gsz); u.pn = (wgid % nig) / gsz; return true;
    }
    __device__ __forceinline__ void a_ready(const Unit&) const {}
    __device__ __forceinline__ void done(const Unit&) const {}
};
__device__ __forceinline__ unsigned cvt_pk_bf16(float lo, float hi) { unsigned r; asm volatile("v_cvt_pk_bf16_f32 %0, %1, %2" : "=v"(r) : "v"(lo), "v"(hi)); return r; }
typedef float f32x2 __attribute__((ext_vector_type(2)));
__device__ __forceinline__ int mk_tid(const int w) { unsigned m = ~0u; asm volatile("" : "+s"(m)); const int l = __builtin_amdgcn_mbcnt_hi(m, __builtin_amdgcn_mbcnt_lo(m, 0u)); int t = w * 64 + l; asm volatile("" : "+v"(t)); return t; }
template <int ACT> struct EpiAct {
    static constexpr bool PERM = true, AFTER_DRAIN = false;
    bf16_t* O; int ldc;
    __device__ __forceinline__ void operator()(const f32x4 (&acc)[2][2][4][2], const Unit& u, int wr, int wc, int fr, int fq) const {
        const int row0 = u.pm * BM + wr * 64 + fr; const int col0 = u.pn * BM + wc * 32 + 8 * fq;
#pragma unroll
        for (int ai = 0; ai < 2; ++ai)
#pragma unroll
            for (int m = 0; m < 4; ++m) { bf16_t* rowp = O + (size_t)(row0 + ai * HALF + m * 16) * ldc + col0;
#pragma unroll
                for (int bj = 0; bj < 2; ++bj) { f32x4 v0 = acc[ai][bj][m][0], v1 = acc[ai][bj][m][1];
                    if (ACT == 1) {
#pragma unroll
                        for (int e = 0; e < 4; ++e) { float a = v0[e] > 0.f ? v0[e] : 0.f, b = v1[e] > 0.f ? v1[e] : 0.f; v0[e] = a * a; v1[e] = b * b; } }
                    u32x4 w; w.x = cvt_pk_bf16(v0[0], v0[1]); w.y = cvt_pk_bf16(v0[2], v0[3]); w.z = cvt_pk_bf16(v1[0], v1[1]); w.w = cvt_pk_bf16(v1[2], v1[3]);
                    *(u32x4*)(rowp + bj * HALF) = w; } }
    }
};
template <class Epi, class Sched, bool ALIGN_EPI = false, bool SP2 = false>
__device__ __forceinline__ void gemm_phase(PG8_LAS unsigned char* lds, const Gemm g, const Sched& S, const Epi& E, const int wave_s) {
    const int tid = mk_tid(wave_s), wid = __builtin_amdgcn_readfirstlane(tid >> 6), lane = tid & 63, wr = wid >> 2, wc = wid & 3, fr = lane & 15, fq = lane >> 4;
    const int K = g.K, nt = K / BK;
    unsigned voffA[2], voffB[2];
#pragma unroll
    for (int i = 0; i < 2; ++i) { int R, C; stage_rc(tid * 16 + i * 8192, R, C); const int Rb = Epi::PERM ? ((R & ~31) + perm32(R & 31)) : R;
        voffA[i] = (unsigned)(R * K + C) * 2u; voffB[i] = (unsigned)(Rb * K + C) * 2u; }
    const size_t kstep = (size_t)(BK * 2);
    const size_t hstep = (size_t)HALF * K * 2;
    const size_t tstep = 2 * hstep;
    const unsigned ldsw = (unsigned)wid * 1024u;
    const int aoff = lds_byte(wr * 64 + fr, fq * 8), boff = lds_byte(wc * 32 + fr, fq * 8);
#define PG8_SA(b, h) (((b) * 2 + (h)) * HTB)
#define PG8_SB(b, h) ((4 + (b) * 2 + (h)) * HTB)
#define PG8_STAGE(bufoff, gbase, voff) do { _Pragma("unroll") for (int _i = 0; _i < 2; ++_i) \
        __builtin_amdgcn_global_load_lds((const unsigned*)((const char*)(gbase) + (voff)[_i]), (PG8_LAS unsigned*)(lds + (bufoff) + ldsw + _i * 8192), 16, 0, 0); } while (0)
#define PG8_LDA(dst, b, h) do { _Pragma("unroll") for (int m = 0; m < 4; ++m) _Pragma("unroll") for (int k = 0; k < 2; ++k) dst[m][k] = *(const PG8_LAS bf16x8*)(lds + PG8_SA(b, h) + aoff + m * 2048 + k * 1024); } while (0)
#define PG8_LDB(dst, b, h) do { _Pragma("unroll") for (int n = 0; n < 2; ++n) _Pragma("unroll") for (int k = 0; k < 2; ++k) dst[n][k] = *(const PG8_LAS bf16x8*)(lds + PG8_SB(b, h) + boff + n * 2048 + k * 1024); } while (0)
#define PG8_MMA(ai, bj, At, Bt) do { __builtin_amdgcn_s_setprio(1); _Pragma("unroll") for (int m = 0; m < 4; ++m) _Pragma("unroll") for (int n = 0; n < 2; ++n) _Pragma("unroll") for (int k = 0; k < 2; ++k) \
        acc[ai][bj][m][n] = __builtin_amdgcn_mfma_f32_16x16x32_bf16(Bt[n][k], At[m][k], acc[ai][bj][m][n], 0, 0, 0); __builtin_amdgcn_s_setprio(0); } while (0)
#define PG8_WAIT_V(n) asm volatile("s_waitcnt vmcnt(" #n ")" ::: "memory")
#define PG8_WAIT_L(n) asm volatile("s_waitcnt lgkmcnt(" #n ")" ::: "memory")
#define PG8_BAR __builtin_amdgcn_s_barrier()
#define PG8_SCHED __builtin_amdgcn_sched_barrier(0)
    Unit cur, nxt; int ui = 0;
    if (!S.next(0, cur)) return;
    f32x4 acc[2][2][4][2];
#pragma unroll
    for (int a = 0; a < 2; ++a)
#pragma unroll
        for (int b = 0; b < 2; ++b)
#pragma unroll
            for (int m = 0; m < 4; ++m)
#pragma unroll
                for (int n = 0; n < 2; ++n) acc[a][b][m][n] = (f32x4){0.f, 0.f, 0.f, 0.f};
    bf16x8 At[4][2], B0[2][2], B1[2][2];
    const char* cA = (const char*)g.A + (size_t)cur.pm * tstep; const char* cB = (const char*)g.Bt + (size_t)cur.pn * tstep;
    S.a_ready(cur);
    if constexpr (SP2) {
        PG8_STAGE(PG8_SB(0, 0), cB, voffB); PG8_STAGE(PG8_SB(0, 1), cB + hstep, voffB); PG8_STAGE(PG8_SA(0, 0), cA, voffA); PG8_STAGE(PG8_SA(0, 1), cA + hstep, voffA);
        if (wr == 1) PG8_BAR;
        PG8_WAIT_V(2); PG8_BAR;
        PG8_STAGE(PG8_SB(1, 0), cB + kstep, voffB); PG8_STAGE(PG8_SA(1, 0), cA + kstep, voffA); PG8_STAGE(PG8_SB(1, 1), cB + hstep + kstep, voffB);
        PG8_WAIT_V(6); PG8_BAR;
    } else {
        PG8_STAGE(PG8_SB(0, 0), cB, voffB); PG8_STAGE(PG8_SA(0, 0), cA, voffA); PG8_STAGE(PG8_SB(0, 1), cB + hstep, voffB); PG8_STAGE(PG8_SA(0, 1), cA + hstep, voffA);
        if (wr == 1) PG8_BAR;
        PG8_WAIT_V(4); PG8_BAR;
        PG8_STAGE(PG8_SB(1, 0), cB + kstep, voffB); PG8_STAGE(PG8_SA(1, 0), cA + kstep, voffA); PG8_STAGE(PG8_SB(1, 1), cB + hstep + kstep, voffB);
        PG8_WAIT_V(6); PG8_BAR;
    }
    for (;;) {
        const bool has_next = S.next(ui + 1, nxt);
        const char* nA = has_next ? (const char*)g.A + (size_t)nxt.pm * tstep : cA; const char* nB = has_next ? (const char*)g.Bt + (size_t)nxt.pn * tstep : cB;
        for (int t = 0; t < nt; t += 2) {
            const bool last = (t == nt - 2);
            const char* a1 = cA + (size_t)(t + 1) * kstep;
            const char* a2 = last ? nA : cA + (size_t)(t + 2) * kstep; const char* b2 = last ? nB : cB + (size_t)(t + 2) * kstep;
            const char* a3 = a2 + kstep; const char* b3 = b2 + kstep;
            if (last && has_next) S.a_ready(nxt);
            if constexpr (SP2) {
            PG8_LDB(B0, 0, 0); PG8_LDB(B1, 0, 1); PG8_SCHED; PG8_LDA(At, 0, 0); PG8_STAGE(PG8_SA(1, 1), a1 + hstep, voffA);
            PG8_WAIT_V(8); PG8_WAIT_L(0); PG8_BAR; PG8_MMA(0, 0, At, B0); PG8_MMA(0, 1, At, B1); PG8_BAR; PG8_SCHED;
            PG8_LDA(At, 0, 1); PG8_STAGE(PG8_SB(0, 0), b2, voffB); PG8_STAGE(PG8_SB(0, 1), b2 + hstep, voffB); PG8_STAGE(PG8_SA(0, 0), a2, voffA);
            PG8_WAIT_V(8); PG8_WAIT_L(0); PG8_BAR; PG8_MMA(1, 0, At, B0); PG8_MMA(1, 1, At, B1); PG8_BAR; PG8_SCHED;
            PG8_LDB(B0, 1, 0); PG8_LDB(B1, 1, 1); PG8_SCHED; PG8_LDA(At, 1, 0); PG8_STAGE(PG8_SA(0, 1), a2 + hstep, voffA);
            PG8_WAIT_V(8); PG8_WAIT_L(0); PG8_BAR; PG8_MMA(0, 0, At, B0); PG8_MMA(0, 1, At, B1); PG8_BAR; PG8_SCHED;
            PG8_LDA(At, 1, 1); PG8_STAGE(PG8_SB(1, 0), b3, voffB); PG8_STAGE(PG8_SB(1, 1), b3 + hstep, voffB); PG8_STAGE(PG8_SA(1, 0), a3, voffA);
            PG8_WAIT_V(8); PG8_WAIT_L(0); PG8_BAR; PG8_MMA(1, 0, At, B0); PG8_MMA(1, 1, At, B1); PG8_BAR; PG8_SCHED;
            } else {
            PG8_LDB(B0, 0, 0); PG8_SCHED; PG8_LDA(At, 0, 0); PG8_STAGE(PG8_SA(1, 1), a1 + hstep, voffA);
            PG8_WAIT_L(8); PG8_BAR; PG8_WAIT_L(0); PG8_MMA(0, 0, At, B0); PG8_BAR; PG8_SCHED;
            PG8_LDB(B1, 0, 1); PG8_STAGE(PG8_SB(0, 0), b2, voffB);
            PG8_BAR; PG8_WAIT_L(0); PG8_MMA(0, 1, At, B1); PG8_BAR;
            PG8_LDA(At, 0, 1); PG8_STAGE(PG8_SA(0, 0), a2, voffA);
            PG8_BAR; PG8_WAIT_L(0); PG8_MMA(1, 0, At, B0); PG8_BAR; PG8_SCHED;
            PG8_STAGE(PG8_SB(0, 1), b2 + hstep, voffB);
            PG8_WAIT_V(6); PG8_BAR; PG8_MMA(1, 1, At, B1); PG8_BAR;
            PG8_LDB(B0, 1, 0); PG8_SCHED; PG8_LDA(At, 1, 0); PG8_STAGE(PG8_SA(0, 1), a2 + hstep, voffA);
            PG8_WAIT_L(8); PG8_BAR; PG8_WAIT_L(0); PG8_MMA(0, 0, At, B0); PG8_BAR; PG8_SCHED;
            PG8_LDB(B1, 1, 1); PG8_STAGE(PG8_SB(1, 0), b3, voffB);
            PG8_BAR; PG8_WAIT_L(0); PG8_MMA(0, 1, At, B1); PG8_BAR;
            PG8_LDA(At, 1, 1); PG8_STAGE(PG8_SA(1, 0), a3, voffA);
            PG8_BAR; PG8_WAIT_L(0); PG8_MMA(1, 0, At, B0); PG8_BAR; PG8_SCHED;
            PG8_STAGE(PG8_SB(1, 1), b3 + hstep, voffB);
            PG8_WAIT_V(6); PG8_BAR; PG8_MMA(1, 1, At, B1); PG8_BAR;
            }
        }
        if constexpr (ALIGN_EPI) { if (wr == 0) PG8_BAR; }
        if constexpr (!Epi::AFTER_DRAIN) { E(acc, cur, wr, wc, fr, fq); S.done(cur); }
        if (!has_next) break;
#pragma unroll
        for (int a = 0; a < 2; ++a)
#pragma unroll
            for (int b = 0; b < 2; ++b)
#pragma unroll
                for (int m = 0; m < 4; ++m)
#pragma unroll
                    for (int n = 0; n < 2; ++n) acc[a][b][m][n] = (f32x4){0.f, 0.f, 0.f, 0.f};
        cur = nxt; cA = nA; cB = nB; ++ui;
        if constexpr (ALIGN_EPI) { if (wr == 1) PG8_BAR; }
    }
    PG8_WAIT_V(0);
    if constexpr (!ALIGN_EPI) { if (wr == 0) PG8_BAR; }
    PG8_BAR;
    if constexpr (Epi::AFTER_DRAIN) { E.fused(acc, cur, wr, wc, fr, fq, lds, wid, lane); S.done(cur); }
#undef PG8_SA
#undef PG8_SB
#undef PG8_STAGE
#undef PG8_LDA
#undef PG8_LDB
#undef PG8_MMA
#undef PG8_WAIT_V
#undef PG8_WAIT_L
#undef PG8_BAR
#undef PG8_SCHED
}
}
constexpr int NB = 8, SEQ = 4096, DM = 1024, NT = NB * SEQ, DEPTH = 4, DFF = 4096;
constexpr int NZ = 3328;
constexpr int ZQ = 0, ZK = 512, ZV = 1024, ZR = 1536, ZKR = 2048, ZVR = 2560, ZXW = 3072, ZMV = 3232;
constexpr size_t MiB = 1u << 20;
constexpr size_t WS_WIN = 1 * MiB, WS_WOUT = 27 * MiB, WS_WUP = 35 * MiB, WS_WDN = 67 * MiB, WS_LT = 99 * MiB;
constexpr size_t WS_XN = 100 * MiB, WS_VF = 164 * MiB, WS_BON = 196 * MiB, WS_BIG = 198 * MiB;
constexpr size_t WS_Z = WS_BIG, WS_YS = 406 * MiB, WS_G = 438 * MiB, WS_VC = 470 * MiB, WS_H = WS_BIG, WS_Y1 = WS_BIG, WS_END = 502 * MiB;
constexpr int LDS_BYTES = 147456;

#define LAS __attribute__((address_space(3)))
typedef unsigned short bf16;
typedef float f32x4 __attribute__((ext_vector_type(4)));
typedef unsigned u32x4 __attribute__((ext_vector_type(4)));
typedef unsigned u32x2 __attribute__((ext_vector_type(2)));
typedef short bf16x8 __attribute__((ext_vector_type(8)));
typedef short s16x4 __attribute__((ext_vector_type(4)));

__device__ __forceinline__ float bf2f(unsigned u) { return __uint_as_float(u << 16); }
__device__ __forceinline__ float bflo(unsigned u) { return __uint_as_float(u << 16); }
__device__ __forceinline__ float bfhi(unsigned u) { return __uint_as_float(u & 0xffff0000u); }
__device__ __forceinline__ unsigned f2bf(float f) { unsigned u = __float_as_uint(f); return (u + 0x7fffu + ((u >> 16) & 1u)) >> 16; }
__device__ __forceinline__ unsigned pk2(float lo, float hi) { return f2bf(lo) | (f2bf(hi) << 16); }
__device__ __forceinline__ float wave_sum(float v) {
#pragma unroll
    for (int o = 1; o < 64; o <<= 1) v += __shfl_xor(v, o);
    return v;
}
__device__ __forceinline__ float dppf(float v, const int ctrl_sel) {
    int r;
    if (ctrl_sel == 0) r = __builtin_amdgcn_update_dpp(0, __float_as_int(v), 0xB1, 0xF, 0xF, false);
    else if (ctrl_sel == 1) r = __builtin_amdgcn_update_dpp(0, __float_as_int(v), 0x4E, 0xF, 0xF, false);
    else if (ctrl_sel == 2) r = __builtin_amdgcn_update_dpp(0, __float_as_int(v), 0x141, 0xF, 0xF, false);
    else r = __builtin_amdgcn_update_dpp(0, __float_as_int(v), 0x140, 0xF, 0xF, false);
    return __int_as_float(r);
}
__device__ __forceinline__ float rowsum16(float v) { v += dppf(v, 0); v += dppf(v, 1); v += dppf(v, 2); v += dppf(v, 3); return v; }
__device__ __forceinline__ float sigmoidf_(float x) { return 1.0f / (1.0f + __expf(-x)); }

struct Params { const float* in[25]; float* out; unsigned char* ws; int ph_lo, ph_hi; };
#define MK_IDS const int tid = pg8::mk_tid(wave_s), lane = tid & 63, wave = __builtin_amdgcn_readfirstlane(tid >> 6); const int gw = blockIdx.x * 8 + wave; (void)gw; (void)lane

__device__ __forceinline__ void transpose_item(const float* W, int K, int N, bf16* WT, LAS float* scr, int item, int lane) {
    const int nblk = N / 32, kb = item / nblk, nb = item % nblk, k0 = 64 * kb, n0 = 32 * nb;
#pragma unroll 8
    for (int i = 0; i < 32; ++i) { const int kk = 2 * i + (lane >> 5); scr[kk * 33 + (lane & 31)] = W[(size_t)(k0 + kk) * N + n0 + (lane & 31)]; }
    asm volatile("s_waitcnt lgkmcnt(0)" ::: "memory");
    const int c = lane & 7;
#pragma unroll
    for (int j = 0; j < 4; ++j) { const int n = (lane >> 3) + 8 * j; const LAS float* s = scr + (8 * c) * 33 + n;
        u32x4 o; o.x = pk2(s[0 * 33], s[1 * 33]); o.y = pk2(s[2 * 33], s[3 * 33]); o.z = pk2(s[4 * 33], s[5 * 33]); o.w = pk2(s[6 * 33], s[7 * 33]);
        *(u32x4*)(WT + (size_t)(n0 + n) * K + k0 + 8 * c) = o; }
    asm volatile("s_waitcnt lgkmcnt(0)" ::: "memory");
}

__device__ __forceinline__ void prologue(const Params& p, LAS unsigned char* lds, int gw, int NGW, int wave, int lane) {
    unsigned char* ws = p.ws;
    LAS float* scr = (LAS float*)(lds + wave * 16384);
    constexpr int I_IN0 = 16 * 101, I_INR = 16 * 102, I_OUT = 16 * 32, I_UP = 16 * 128, I_DN = 64 * 32;
    constexpr int NITEMS = I_IN0 + 3 * I_INR + 4 * I_OUT + 4 * I_UP + 4 * I_DN;
    for (int it = gw; it < NITEMS; it += NGW) {
        int r = it;
        if (r < I_IN0) { transpose_item(p.in[5], 1024, 3232, (bf16*)(ws + WS_WIN), scr, r, lane); continue; } r -= I_IN0;
        if (r < 3 * I_INR) { const int l = r / I_INR; transpose_item(p.in[6] + (size_t)l * 1024 * 3264, 1024, 3264, (bf16*)(ws + WS_WIN) + (size_t)(l + 1) * NZ * 1024, scr, r % I_INR, lane); continue; } r -= 3 * I_INR;
        if (r < 4 * I_OUT) { const int l = r / I_OUT; transpose_item(p.in[22] + (size_t)l * 1024 * 1024, 1024, 1024, (bf16*)(ws + WS_WOUT) + (size_t)l * 1024 * 1024, scr, r % I_OUT, lane); continue; } r -= 4 * I_OUT;
        if (r < 4 * I_UP) { const int l = r / I_UP; transpose_item(p.in[23] + (size_t)l * 1024 * 4096, 1024, 4096, (bf16*)(ws + WS_WUP) + (size_t)l * 4096 * 1024, scr, r % I_UP, lane); continue; } r -= 4 * I_UP;
        { const int l = r / I_DN; transpose_item(p.in[24] + (size_t)l * 4096 * 1024, 4096, 1024, (bf16*)(ws + WS_WDN) + (size_t)l * 1024 * 4096, scr, r % I_DN, lane); }
    }
    {
        const int gt = gw * 64 + lane, NG = NGW * 64;
        const u32x4 z4 = {0u, 0u, 0u, 0u};
        for (int l = 0; l < 4; ++l) { const int r0 = (l == 0) ? 3232 : 3264; const int nvec = (NZ - r0) * 1024 / 8;
            u32x4* base = (u32x4*)((bf16*)(ws + WS_WIN) + ((size_t)l * NZ + r0) * 1024);
            for (int i = gt; i < nvec; i += NG) base[i] = z4; }
        bf16* LT = (bf16*)(ws + WS_LT);
        for (int i = gt; i < 4 * 512 * 192; i += NG) { const int l = i / (512 * 192), rem = i % (512 * 192), c = rem / 192, m = rem % 192; float v;
            if (m < 32) v = p.in[11][((size_t)l * 32 + m) * 512 + c];
            else if (m < 64) v = p.in[13][((size_t)l * 32 + (m - 32)) * 512 + c];
            else if (m < 160) v = p.in[16][((size_t)l * 96 + (m - 64)) * 512 + c];
            else v = (l > 0) ? p.in[15][((size_t)(l - 1) * 32 + (m - 160)) * 512 + c] : 0.f;
            LT[i] = (bf16)f2bf(v); }
    }
    const float* x = p.in[0]; const float* g = p.in[1]; bf16* XN = (bf16*)(ws + WS_XN);
    for (int row = gw; row < NT; row += NGW) {
        const f32x4* xr = (const f32x4*)(x + (size_t)row * DM) + lane; f32x4* orow = (f32x4*)(p.out + (size_t)row * DM) + lane;
        f32x4 v[4]; float s = 0.f;
#pragma unroll
        for (int j = 0; j < 4; ++j) { v[j] = xr[64 * j]; orow[64 * j] = v[j]; s += (v[j].x * v[j].x + v[j].y * v[j].y) + (v[j].z * v[j].z + v[j].w * v[j].w); }
        const float rstd = 1.0f / sqrtf(wave_sum(s) * (1.0f / DM) + 1e-6f);
        u32x2* o8 = (u32x2*)(XN + (size_t)row * DM) + lane;
#pragma unroll
        for (int j = 0; j < 4; ++j) { const f32x4 gg = ((const f32x4*)g)[lane + 64 * j]; u32x2 w; w.x = pk2(v[j].x * rstd * gg.x, v[j].y * rstd * gg.y); w.y = pk2(v[j].z * rstd * gg.z, v[j].w * rstd * gg.w); o8[64 * j] = w; }
    }
}

__device__ __forceinline__ void norm_phase(const bf16* Y, float* X, bf16* XN, const float* gpost, const float* gnext, int gw, int NGW, int lane) {
    for (int row = gw; row < NT; row += NGW) {
        const u32x4* yr = (const u32x4*)(Y + (size_t)row * DM); f32x4* xr = (f32x4*)(X + (size_t)row * DM);
        float y[16]; float ss = 0.f;
#pragma unroll
        for (int k = 0; k < 2; ++k) { const u32x4 w = yr[k * 64 + lane];
            y[k * 8 + 0] = bflo(w.x); y[k * 8 + 1] = bfhi(w.x); y[k * 8 + 2] = bflo(w.y); y[k * 8 + 3] = bfhi(w.y); y[k * 8 + 4] = bflo(w.z); y[k * 8 + 5] = bfhi(w.z); y[k * 8 + 6] = bflo(w.w); y[k * 8 + 7] = bfhi(w.w); }
#pragma unroll
        for (int e = 0; e < 16; ++e) ss += y[e] * y[e];
        const float rstd = 1.0f / sqrtf(wave_sum(ss) * (1.0f / DM) + 1e-6f);
        float xn[16]; float s2 = 0.f;
#pragma unroll
        for (int k = 0; k < 2; ++k)
#pragma unroll
            for (int q = 0; q < 2; ++q) { const int vi = k * 128 + lane * 2 + q; f32x4 xv = xr[vi]; const f32x4 gg = ((const f32x4*)gpost)[vi];
#pragma unroll
                for (int e = 0; e < 4; ++e) { const float t = xv[e] + y[k * 8 + q * 4 + e] * rstd * gg[e]; xv[e] = t; xn[k * 8 + q * 4 + e] = t; s2 += t * t; }
                xr[vi] = xv; }
        if (gnext) {
            const float r2 = 1.0f / sqrtf(wave_sum(s2) * (1.0f / DM) + 1e-6f);
            u32x4* o = (u32x4*)(XN + (size_t)row * DM);
#pragma unroll
            for (int k = 0; k < 2; ++k) { const f32x4 g0 = ((const f32x4*)gnext)[k * 128 + lane * 2], g1 = ((const f32x4*)gnext)[k * 128 + lane * 2 + 1]; u32x4 w;
                w.x = pk2(xn[k * 8 + 0] * r2 * g0.x, xn[k * 8 + 1] * r2 * g0.y); w.y = pk2(xn[k * 8 + 2] * r2 * g0.z, xn[k * 8 + 3] * r2 * g0.w);
                w.z = pk2(xn[k * 8 + 4] * r2 * g1.x, xn[k * 8 + 5] * r2 * g1.y); w.w = pk2(xn[k * 8 + 6] * r2 * g1.z, xn[k * 8 + 7] * r2 * g1.w);
                o[k * 64 + lane] = w; }
        }
    }
}

__device__ __forceinline__ void post_phase(bf16* MIX, const bf16* YS, const bf16* GB, const bf16* VC, const float* BON, const float* again, const float* gnw, const float* gnb, int gw, int NGW, int lane) {
    for (int row = gw; row < NT; row += NGW) {
        u32x4* mrow = (u32x4*)(MIX + (size_t)row * DM);
        {
            const u32x4 w = mrow[lane]; float o[8] = {bflo(w.x), bfhi(w.x), bflo(w.y), bfhi(w.y), bflo(w.z), bfhi(w.z), bflo(w.w), bfhi(w.w)}; float ss = 0.f;
#pragma unroll
            for (int e = 0; e < 8; ++e) ss += o[e] * o[e];
            const float rstd = 1.0f / sqrtf(wave_sum(ss) * (1.0f / 512.0f) + 1e-6f);
            const f32x4 g0 = ((const f32x4*)again)[lane * 2], g1 = ((const f32x4*)again)[lane * 2 + 1]; u32x4 r;
            r.x = pk2(o[0] * rstd * g0.x, o[1] * rstd * g0.y); r.y = pk2(o[2] * rstd * g0.z, o[3] * rstd * g0.w); r.z = pk2(o[4] * rstd * g1.x, o[5] * rstd * g1.y); r.w = pk2(o[6] * rstd * g1.z, o[7] * rstd * g1.w);
            mrow[lane] = r;
        }
        {
            const u32x4 w = ((const u32x4*)(YS + (size_t)row * 512))[lane]; float y[8] = {bflo(w.x), bfhi(w.x), bflo(w.y), bfhi(w.y), bflo(w.z), bfhi(w.z), bflo(w.w), bfhi(w.w)};
            float s1 = 0.f;
#pragma unroll
            for (int e = 0; e < 8; ++e) s1 += y[e];
            s1 += __shfl_xor(s1, 1); s1 += __shfl_xor(s1, 2); s1 += __shfl_xor(s1, 4);
            const float mean = s1 * (1.0f / 64.0f); float s2 = 0.f;
#pragma unroll
            for (int e = 0; e < 8; ++e) { y[e] -= mean; s2 += y[e] * y[e]; }
            s2 += __shfl_xor(s2, 1); s2 += __shfl_xor(s2, 2); s2 += __shfl_xor(s2, 4);
            const float rs = 1.0f / sqrtf(s2 * (1.0f / 64.0f) + 64e-5f);
            const u32x4 vw = ((const u32x4*)(VC + (size_t)row * 512))[lane], gw4 = ((const u32x4*)(GB + (size_t)row * 512))[lane];
            const float v[8] = {bflo(vw.x), bfhi(vw.x), bflo(vw.y), bfhi(vw.y), bflo(vw.z), bfhi(vw.z), bflo(vw.w), bfhi(vw.w)};
            const float g[8] = {bflo(gw4.x), bfhi(gw4.x), bflo(gw4.y), bfhi(gw4.y), bflo(gw4.z), bfhi(gw4.z), bflo(gw4.w), bfhi(gw4.w)};
            const float bon = BON[(size_t)row * 8 + (lane >> 3)];
            const f32x4 w0 = ((const f32x4*)gnw)[lane * 2], w1 = ((const f32x4*)gnw)[lane * 2 + 1], b0 = ((const f32x4*)gnb)[lane * 2], b1 = ((const f32x4*)gnb)[lane * 2 + 1];
            const float gwv[8] = {w0.x, w0.y, w0.z, w0.w, w1.x, w1.y, w1.z, w1.w}, gbv[8] = {b0.x, b0.y, b0.z, b0.w, b1.x, b1.y, b1.z, b1.w};
            float o[8];
#pragma unroll
            for (int e = 0; e < 8; ++e) o[e] = (y[e] * rs * gwv[e] + gbv[e] + bon * v[e]) * g[e];
            u32x4 r; r.x = pk2(o[0], o[1]); r.y = pk2(o[2], o[3]); r.z = pk2(o[4], o[5]); r.w = pk2(o[6], o[7]);
            mrow[64 + lane] = r;
        }
    }
}

__device__ __forceinline__ void attn_unit(LAS unsigned char* lds, const bf16* Z, bf16* MIX, int unit, int wave, int lane) {
    const int b = unit >> 4, t0 = (unit & 15) * 256;
    LAS float* ACC = (LAS float*)lds;
    LAS float* ML = (LAS float*)(lds + 256 * 68 * 4);
    LAS unsigned char* VST = lds + 256 * 68 * 4 + 2048 + wave * 4096;
    const int li = lane & 15, quad = lane >> 4;
    const float C = 0.125f * 1.4426950408889634f;
    const size_t rowbase = (size_t)b * SEQ;
    for (int h = 0; h < 8; ++h) {
#pragma unroll 1
        for (int br = 0; br < 3; ++br) {
            const int lg = br * 2; const int L = SEQ >> lg;
#pragma unroll 1
            for (int u = 0; u < 2; ++u) {
                const int tu = wave * 2 + u;
                int r, i0;
                if (br == 0) { r = 0; i0 = t0 + tu * 16; } else if (br == 1) { r = tu & 3; i0 = (t0 >> 2) + (tu >> 2) * 16; } else { r = tu; i0 = t0 >> 4; }
                const int tq = ((i0 + li) << lg) + r;
                const bf16* qp = Z + (rowbase + tq) * NZ + ZQ + h * 64 + quad * 8;
                const bf16x8 q0 = *(const bf16x8*)qp, q1 = *(const bf16x8*)(qp + 32);
                f32x4 s[9];
#pragma unroll
                for (int kt = 0; kt < 9; ++kt) {
                    int ik = i0 - 128 + kt * 16 + li; ik = ik < 0 ? 0 : ik;
                    const bf16* kp = Z + (rowbase + (ik << lg) + r) * NZ + ZK + h * 64 + quad * 8;
                    const bf16x8 k0 = *(const bf16x8*)kp, k1 = *(const bf16x8*)(kp + 32);
                    f32x4 a = {0.f, 0.f, 0.f, 0.f};
                    a = __builtin_amdgcn_mfma_f32_16x16x32_bf16(k0, q0, a, 0, 0, 0);
                    a = __builtin_amdgcn_mfma_f32_16x16x32_bf16(k1, q1, a, 0, 0, 0);
                    s[kt] = a;
                }
                u32x4 vv[5][4];
#pragma unroll
                for (int cc = 0; cc < 5; ++cc)
#pragma unroll
                    for (int it = 0; it < 4; ++it) { const int idx = it * 64 + lane, rr = idx >> 3, c16 = idx & 7; int ik = i0 - 128 + cc * 32 + rr; ik = ik < 0 ? 0 : (ik > L - 1 ? L - 1 : ik);
                        vv[cc][it] = *(const u32x4*)(Z + (rowbase + (ik << lg) + r) * NZ + ZV + h * 64 + c16 * 8); }
                float mx = -1e30f;
#pragma unroll
                for (int kt = 0; kt < 9; ++kt)
#pragma unroll
                    for (int j = 0; j < 4; ++j) { const int key = kt * 16 + quad * 4 + j; const int dist = 128 + li - key; const int ik = i0 - 128 + key;
                        const bool valid = (dist >= 0) && (dist <= 128) && (ik >= 0);
                        const float sv = valid ? s[kt][j] : -1e30f; s[kt][j] = sv; mx = fmaxf(mx, sv); }
                mx = fmaxf(mx, __shfl_xor(mx, 16)); mx = fmaxf(mx, __shfl_xor(mx, 32));
                float lsum = 0.f;
#pragma unroll
                for (int kt = 0; kt < 9; ++kt)
#pragma unroll
                    for (int j = 0; j < 4; ++j) { const float pv = __builtin_amdgcn_exp2f((s[kt][j] - mx) * C); s[kt][j] = pv; lsum += pv; }
                lsum += __shfl_xor(lsum, 16); lsum += __shfl_xor(lsum, 32);
                f32x4 o[4];
#pragma unroll
                for (int dt = 0; dt < 4; ++dt) o[dt] = (f32x4){0.f, 0.f, 0.f, 0.f};
#pragma unroll
                for (int cc = 0; cc < 5; ++cc) {
                    asm volatile("s_waitcnt lgkmcnt(0)" ::: "memory");
#pragma unroll
                    for (int it = 0; it < 4; ++it) { const int idx = it * 64 + lane, rr = idx >> 3, c16 = idx & 7;
                        *(LAS u32x4*)(VST + rr * 128 + c16 * 16) = vv[cc][it]; }
                    asm volatile("s_waitcnt lgkmcnt(0)" ::: "memory");
                    bf16x8 pa;
                    { const f32x4 p0 = s[2 * cc]; const unsigned a0 = pk2(p0[0], p0[1]), a1 = pk2(p0[2], p0[3]); unsigned a2 = 0u, a3 = 0u;
                      if (cc < 4) { const f32x4 p1 = s[2 * cc + 1 < 9 ? 2 * cc + 1 : 8]; a2 = pk2(p1[0], p1[1]); a3 = pk2(p1[2], p1[3]); }
                      const u32x4 pw = {a0, a1, a2, a3}; pa = __builtin_bit_cast(bf16x8, pw); }
#pragma unroll
                    for (int dt = 0; dt < 4; ++dt) {
                        LAS unsigned char* ap = VST + (quad * 4 + (li >> 2)) * 128 + (dt * 16 + (li & 3) * 4) * 2;
                        const s16x4 b1 = __builtin_bit_cast(s16x4, __builtin_amdgcn_ds_read_tr16_b64_v4i16((LAS s16x4*)ap));
                        const s16x4 b2 = __builtin_bit_cast(s16x4, __builtin_amdgcn_ds_read_tr16_b64_v4i16((LAS s16x4*)(ap + 16 * 128)));
                        const bf16x8 vb = {b1[0], b1[1], b1[2], b1[3], b2[0], b2[1], b2[2], b2[3]};
                        o[dt] = __builtin_amdgcn_mfma_f32_16x16x32_bf16(pa, vb, o[dt], 0, 0, 0);
                    }
                }
#pragma unroll
                for (int j = 0; j < 4; ++j) {
                    const int qq = quad * 4 + j;
                    const float mr = __shfl(mx, qq), lr = __shfl(lsum, qq);
                    const int tl = (br == 0) ? tu * 16 + qq : (br == 1) ? ((((tu >> 2) * 16 + qq) << 2) + (tu & 3)) : qq * 16 + tu;
                    LAS float* arow = ACC + tl * 68;
                    if (br == 0) {
#pragma unroll
                        for (int dt = 0; dt < 4; ++dt) arow[dt * 16 + li] = o[dt][j];
                        if (li == 0) { ML[tl * 2] = mr; ML[tl * 2 + 1] = lr; }
                    } else {
                        const float m0 = ML[tl * 2], l0 = ML[tl * 2 + 1];
                        const float mn = fmaxf(m0, mr); const float a0 = __builtin_amdgcn_exp2f((m0 - mn) * C), a1 = __builtin_amdgcn_exp2f((mr - mn) * C);
                        const float ln = l0 * a0 + lr * a1;
                        float val[4];
#pragma unroll
                        for (int dt = 0; dt < 4; ++dt) val[dt] = arow[dt * 16 + li] * a0 + o[dt][j] * a1;
                        asm volatile("s_waitcnt lgkmcnt(0)" ::: "memory");
                        if (br == 1) {
#pragma unroll
                            for (int dt = 0; dt < 4; ++dt) arow[dt * 16 + li] = val[dt];
                            if (li == 0) { ML[tl * 2] = mn; ML[tl * 2 + 1] = ln; }
                        } else {
                            const float inv = 1.0f / ln; bf16* orow = MIX + (rowbase + t0 + tl) * DM + h * 64 + li;
#pragma unroll
                            for (int dt = 0; dt < 4; ++dt) orow[dt * 16] = (bf16)f2bf(val[dt] * inv);
                        }
                    }
                }
            }
            __syncthreads();
        }
    }
}

constexpr int TC = 32, NCH = SEQ / TC;
constexpr int SB_STRIDE = 49152, SC_RS = 0, SC_WW = 8192, SC_KS = 16384, SC_KK = 24576, SC_BV = 32768, SC_VS = 40960;
constexpr int ACT_PITCH = 400, SC_ACT = 2 * SB_STRIDE, SC_LTS = SC_ACT + 4 * 8 * ACT_PITCH, SC_MU = SC_LTS + 64 * ACT_PITCH, SC_INV = SC_MU + 1536, SC_CT = SC_INV + 128;
static_assert(SC_CT + 1536 <= LDS_BYTES, "scan LDS map");
__device__ __forceinline__ float rowsum8(float v) { v += dppf(v, 0); v += dppf(v, 1); v += dppf(v, 2); return v; }
struct ScanVec { f32x4 w0, w1, k0, k1, b0, b1, x0, x1, r0, r1; float v; };
__device__ __forceinline__ ScanVec scan_load(LAS const unsigned char* buf, int t, int j0, int irow) {
    ScanVec s; const LAS float* W = (const LAS float*)(buf + SC_WW) + t * 64 + j0; const LAS float* K = (const LAS float*)(buf + SC_KK) + t * 64 + j0; const LAS float* B = (const LAS float*)(buf + SC_BV) + t * 64 + j0;
    const LAS float* X = (const LAS float*)(buf + SC_KS) + t * 64 + j0; const LAS float* R = (const LAS float*)(buf + SC_RS) + t * 64 + j0;
    s.w0 = *(const LAS f32x4*)W; s.w1 = *(const LAS f32x4*)(W + 4); s.k0 = *(const LAS f32x4*)K; s.k1 = *(const LAS f32x4*)(K + 4); s.b0 = *(const LAS f32x4*)B; s.b1 = *(const LAS f32x4*)(B + 4);
    s.x0 = *(const LAS f32x4*)X; s.x1 = *(const LAS f32x4*)(X + 4); s.r0 = *(const LAS f32x4*)R; s.r1 = *(const LAS f32x4*)(R + 4); s.v = ((const LAS float*)(buf + SC_VS))[t * 64 + irow];
    return s;
}
__device__ __forceinline__ void scan_unit(LAS unsigned char* lds, const Params& p, int layer, int unit, int tid, int wave, int lane) {
    const int chain = unit >> 1, hf = unit & 1, b = chain >> 3, h = chain & 7;
    unsigned char* ws = p.ws;
    const bf16* Z = (const bf16*)(ws + WS_Z); bf16* VF = (bf16*)(ws + WS_VF); bf16* YS = (bf16*)(ws + WS_YS); bf16* GB = (bf16*)(ws + WS_G); bf16* VC = (bf16*)(ws + WS_VC); float* BON = (float*)(ws + WS_BON);
    const bf16* LT = (const bf16*)(ws + WS_LT) + (size_t)layer * 512 * 192;
    const float* mu = p.in[7] + (size_t)layer * 1696; const float* mumv = (layer > 0) ? p.in[8] + (size_t)(layer - 1) * 32 : nullptr;
    const size_t rowbase = (size_t)b * SEQ;
    LAS float* MU = (LAS float*)(lds + SC_MU); LAS unsigned char* LTS = lds + SC_LTS;
    if (tid < 96) { const int cgp = tid, cat = cgp >> 4; const int zc = (cat < 3) ? ZR + cat * 512 + h * 64 + (cgp & 15) * 4 : ZXW + (cgp - 48) * 4;
        const bool ismv = zc >= ZMV; const float* src = ismv ? (mumv ? mumv + (zc - ZMV) : mu) : mu + (zc - ZR);
        f32x4 m4 = *(const f32x4*)src; if (ismv && !mumv) m4 = (f32x4){0.f, 0.f, 0.f, 0.f};
        *(LAS f32x4*)(MU + cgp * 4) = m4; }
    if (tid < 384) { const int arr = tid >> 6, c = tid & 63, gi = layer * 512 + h * 64 + c; float v;
        if (arr == 0) v = p.in[10][gi]; else if (arr == 1) v = p.in[12][gi]; else if (arr == 2) v = (layer > 0) ? p.in[14][(layer - 1) * 512 + h * 64 + c] : 0.f; else if (arr == 3) v = p.in[17][gi]; else if (arr == 4) v = p.in[18][gi]; else v = p.in[19][gi];
        ((LAS float*)(lds + SC_CT))[tid] = v; }
    for (int i = tid; i < 64 * 24; i += 512) { const int c = i / 24, ch = i % 24; *(LAS u32x4*)(LTS + c * ACT_PITCH + ch * 16) = *(const u32x4*)(LT + (size_t)(h * 64 + c) * 192 + ch * 8); }
    __syncthreads();
    if (wave < 4) {
        const int rl = wave * 8 + (lane >> 3), irow = hf * 32 + rl, q = lane & 7, j0 = q * 8;
        float S[8] = {0.f, 0.f, 0.f, 0.f, 0.f, 0.f, 0.f, 0.f}; float ykeep = 0.f;
        __syncthreads();
#pragma unroll 1
        for (int c = 0; c < NCH; ++c) {
            LAS const unsigned char* buf = lds + (c & 1) * SB_STRIDE;
            const int tch = c * TC;
            ScanVec cur = scan_load(buf, 0, j0, irow);
#pragma unroll 8
            for (int t = 0; t < TC; ++t) {
                const ScanVec nx = scan_load(buf, (t + 1 < TC) ? t + 1 : t, j0, irow);
                float sa = ((S[0] * cur.k0.x + S[1] * cur.k0.y) + (S[2] * cur.k0.z + S[3] * cur.k0.w)) + ((S[4] * cur.k1.x + S[5] * cur.k1.y) + (S[6] * cur.k1.z + S[7] * cur.k1.w));
                sa = rowsum8(sa);
                const float v = cur.v;
                S[0] = S[0] * cur.w0.x + (v * cur.x0.x - sa * cur.b0.x); S[1] = S[1] * cur.w0.y + (v * cur.x0.y - sa * cur.b0.y); S[2] = S[2] * cur.w0.z + (v * cur.x0.z - sa * cur.b0.z); S[3] = S[3] * cur.w0.w + (v * cur.x0.w - sa * cur.b0.w);
                S[4] = S[4] * cur.w1.x + (v * cur.x1.x - sa * cur.b1.x); S[5] = S[5] * cur.w1.y + (v * cur.x1.y - sa * cur.b1.y); S[6] = S[6] * cur.w1.z + (v * cur.x1.z - sa * cur.b1.z); S[7] = S[7] * cur.w1.w + (v * cur.x1.w - sa * cur.b1.w);
                float y = ((S[0] * cur.r0.x + S[1] * cur.r0.y) + (S[2] * cur.r0.z + S[3] * cur.r0.w)) + ((S[4] * cur.r1.x + S[5] * cur.r1.y) + (S[6] * cur.r1.z + S[7] * cur.r1.w));
                y = rowsum8(y);
                ykeep = (q == (t & 7)) ? y : ykeep;
                if ((t & 7) == 7) YS[(rowbase + tch + (t & ~7) + q) * 512 + h * 64 + irow] = (bf16)f2bf(ykeep);
                cur = nx;
            }
            __syncthreads();
        }
    } else {
        const int pw = wave - 4, s = lane >> 3, q = lane & 7, li = lane & 15, quad = lane >> 4;
        LAS unsigned char* ACT = lds + SC_ACT + pw * 8 * ACT_PITCH; LAS float* INV = (LAS float*)(lds + SC_INV) + pw * 8;
        const LAS float* CT = (const LAS float*)(lds + SC_CT);
        u32x2 pc[12], pp[12]; u32x4 pvf[2];
        pvf[0] = (u32x4){0u, 0u, 0u, 0u}; pvf[1] = pvf[0];
#define PR_OFF(k) ((k) < 2 ? (ZR - ZKR) + (k) * 32 : (k) < 4 ? ((k) - 2) * 32 : (k) < 6 ? (ZVR - ZKR) + ((k) - 4) * 32 : ((k) - 6) * 32)
#define PR_ISSUE(tchv) do { const int tg = (tchv) + pw * 8 + s; const int tgp = tg > 0 ? tg - 1 : 0; \
        const bf16* c1 = Z + (rowbase + tg) * NZ + ZKR + h * 64 + q * 4; const bf16* c2 = Z + (rowbase + tg) * NZ + ZXW + q * 4; \
        const bf16* p1 = Z + (rowbase + tgp) * NZ + ZKR + h * 64 + q * 4; const bf16* p2 = Z + (rowbase + tgp) * NZ + ZXW + q * 4; \
        asm volatile("" : "+v"(c1), "+v"(c2), "+v"(p1), "+v"(p2)); \
        _Pragma("unroll") for (int k = 0; k < 12; ++k) { pc[k] = *(const u32x2*)((k < 6 ? c1 : c2) + PR_OFF(k)); pp[k] = *(const u32x2*)((k < 6 ? p1 : p2) + PR_OFF(k)); } \
        if (layer > 0) { const u32x4* vb = (const u32x4*)(VF + ((((rowbase + (tchv) + pw * 8 + (quad & 1) * 4) >> 2) * 8 + h) * 16 + li) * 16); pvf[0] = vb[0]; pvf[1] = vb[1]; } } while (0)
        PR_ISSUE(0);
#pragma unroll 1
        for (int c = 0; c <= NCH; ++c) {
            if (c < NCH) {
                const int tch = c * TC;
                LAS unsigned char* buf = lds + (c & 1) * SB_STRIDE;
                LAS float* RS = (LAS float*)(buf + SC_RS); LAS float* WW = (LAS float*)(buf + SC_WW); LAS float* KS = (LAS float*)(buf + SC_KS); LAS float* KK = (LAS float*)(buf + SC_KK);
                LAS float* BV = (LAS float*)(buf + SC_BV); LAS float* VS = (LAS float*)(buf + SC_VS);
                const u32x4 cvf0 = pvf[0], cvf1 = pvf[1];
                const float pz = (tch + pw * 8 + s > 0) ? 1.0f : 0.0f;
                const int trow = pw * 8 + s;
#pragma unroll
                for (int k = 0; k < 12; ++k) {
                    const u32x2 cw = pc[k], pw2 = pp[k];
                    const f32x4 m4 = *(const LAS f32x4*)(MU + (k * 8 + q) * 4);
                    const float c0 = bflo(cw.x), c1 = bfhi(cw.x), c2 = bflo(cw.y), c3 = bfhi(cw.y), p0 = bflo(pw2.x) * pz, p1 = bfhi(pw2.x) * pz, p2 = bflo(pw2.y) * pz, p3 = bfhi(pw2.y) * pz;
                    f32x4 v = {c0 + (p0 - c0) * m4.x, c1 + (p1 - c1) * m4.y, c2 + (p2 - c2) * m4.z, c3 + (p3 - c3) * m4.w};
                    if (k < 2) *(LAS f32x4*)(RS + trow * 64 + (k * 8 + q) * 4) = v;
                    else if (k < 4) *(LAS f32x4*)(KS + trow * 64 + ((k - 2) * 8 + q) * 4) = v;
                    else if (k < 6) *(LAS f32x4*)(VS + trow * 64 + ((k - 4) * 8 + q) * 4) = v;
                    else {
                        const int ac = ((k - 6) * 8 + q) * 4;
                        if (k == 6) {
#pragma unroll
                            for (int e = 0; e < 4; ++e) v[e] = 1.0f - 2.0f * __builtin_amdgcn_rcpf(1.0f + __expf(2.0f * v[e])); }
                        else if (k >= 8 && k <= 10) {
#pragma unroll
                            for (int e = 0; e < 4; ++e) v[e] = __builtin_amdgcn_rcpf(1.0f + __expf(-v[e])); }
                        u32x2 w; w.x = pk2(v.x, v.y); w.y = pk2(v.z, v.w); *(LAS u32x2*)(ACT + s * ACT_PITCH + ac * 2) = w; }
                }
                if (c + 1 < NCH) PR_ISSUE(tch + TC);
                asm volatile("s_waitcnt lgkmcnt(0)" ::: "memory");
                { const f32x4 ka = *(const LAS f32x4*)(KS + trow * 64 + q * 8), kb = *(const LAS f32x4*)(KS + trow * 64 + q * 8 + 4); const f32x4 kc0 = *(const LAS f32x4*)(CT + 3 * 64 + q * 8), kc1 = *(const LAS f32x4*)(CT + 3 * 64 + q * 8 + 4); const float kkl[8] = {kc0.x, kc0.y, kc0.z, kc0.w, kc1.x, kc1.y, kc1.z, kc1.w};
                  float ss = ((ka.x * kkl[0]) * (ka.x * kkl[0]) + (ka.y * kkl[1]) * (ka.y * kkl[1])) + ((ka.z * kkl[2]) * (ka.z * kkl[2]) + (ka.w * kkl[3]) * (ka.w * kkl[3]));
                  ss += ((kb.x * kkl[4]) * (kb.x * kkl[4]) + (kb.y * kkl[5]) * (kb.y * kkl[5])) + ((kb.z * kkl[6]) * (kb.z * kkl[6]) + (kb.w * kkl[7]) * (kb.w * kkl[7]));
                  ss = rowsum8(ss);
                  if (q == 0) INV[s] = 1.0f / fmaxf(sqrtf(ss), 1e-12f); }
                asm volatile("s_waitcnt lgkmcnt(0)" ::: "memory");
                bf16x8 Af[6];
#pragma unroll
                for (int ks = 0; ks < 6; ++ks) Af[ks] = *(const LAS bf16x8*)(ACT + (li & 7) * ACT_PITCH + ks * 64 + quad * 16);
                float bacc[4] = {0.f, 0.f, 0.f, 0.f};
                const int lbase = (pw * 8 + (quad & 1) * 4) * 64 + li;
                const size_t gbase = (rowbase + tch + pw * 8 + (quad & 1) * 4) * 512 + h * 64 + li;
                bf16* vfb = VF + ((((rowbase + tch + pw * 8 + (quad & 1) * 4) >> 2) * 8 + h) * 16 + li) * 16; bf16* gbb = GB + gbase; bf16* vcb = VC + gbase;
                asm volatile("" : "+v"(vfb), "+v"(gbb), "+v"(vcb));
#pragma unroll
                for (int ct = 0; ct < 4; ++ct) {
                    bf16x8 Bf[6];
#pragma unroll
                    for (int ks = 0; ks < 6; ++ks) Bf[ks] = *(const LAS bf16x8*)(LTS + (ct * 16 + li) * ACT_PITCH + ks * 64 + quad * 16);
                    const float cw0c = CT[ct * 16 + li], ca0c = CT[64 + ct * 16 + li], cv0c = CT[128 + ct * 16 + li], ckkc = CT[192 + ct * 16 + li], ckac = CT[256 + ct * 16 + li], crkc = CT[320 + ct * 16 + li];
                    unsigned vfw[2]; { const u32x4 cv = (ct < 2) ? cvf0 : cvf1; vfw[0] = (ct & 1) ? cv.z : cv.x; vfw[1] = (ct & 1) ? cv.w : cv.y; }
                    float vfl[4] = {0.f, 0.f, 0.f, 0.f};
                    const f32x4 z4 = {0.f, 0.f, 0.f, 0.f};
                    const f32x4 LW = __builtin_amdgcn_mfma_f32_16x16x32_bf16(Af[0], Bf[0], z4, 0, 0, 0);
                    const f32x4 AA = __builtin_amdgcn_mfma_f32_16x16x32_bf16(Af[1], Bf[1], z4, 0, 0, 0);
                    f32x4 G = __builtin_amdgcn_mfma_f32_16x16x32_bf16(Af[2], Bf[2], z4, 0, 0, 0);
                    G = __builtin_amdgcn_mfma_f32_16x16x32_bf16(Af[3], Bf[3], G, 0, 0, 0);
                    G = __builtin_amdgcn_mfma_f32_16x16x32_bf16(Af[4], Bf[4], G, 0, 0, 0);
                    const f32x4 VG = __builtin_amdgcn_mfma_f32_16x16x32_bf16(Af[5], Bf[5], z4, 0, 0, 0);
#pragma unroll
                    for (int j = 0; j < 4; ++j) {
                        const int lo = lbase + j * 64 + ct * 16; const int go = j * 512 + ct * 16; const bool valid = quad < 2;
                        const float r = RS[lo], k = KS[lo]; float v = VS[lo]; const float invn = INV[(quad & 1) * 4 + j];
                        const float xx = -(cw0c + LW[j]); const float sp = xx > 20.f ? xx : __logf(1.0f + __expf(xx));
                        const float w = __expf(-__expf(-sp - 0.5f));
                        const float a = __builtin_amdgcn_rcpf(1.0f + __expf(-(ca0c + AA[j])));
                        const float kkv = k * ckkc * invn; const float kmod = k * (1.0f + (a - 1.0f) * ckac); const float bv = kkv * a;
                        if (layer > 0) { const float vg = __builtin_amdgcn_rcpf(1.0f + __expf(-(cv0c + VG[j]))); const float vf = (j & 1) ? bfhi(vfw[j >> 1]) : bflo(vfw[j >> 1]); v = v + (vf - v) * vg; }
                        asm volatile("s_waitcnt lgkmcnt(0)" ::: "memory");
                        vfl[j] = v;
                        if (valid) {
                            WW[lo] = w; KS[lo] = kmod; KK[lo] = kkv; BV[lo] = bv; VS[lo] = v;
                            if (hf == 0) { gbb[go] = (bf16)f2bf(G[j]); vcb[go] = (bf16)f2bf(v); }
                        }
                        bacc[j] += rowsum16(r * kmod * crkc);
                    }
                    if (layer == 0 && hf == 0 && quad < 2) { u32x2 w2; w2.x = pk2(vfl[0], vfl[1]); w2.y = pk2(vfl[2], vfl[3]); *(u32x2*)(vfb + ct * 4) = w2; }
                }
                if (hf == 0 && li == 0 && quad < 2) {
#pragma unroll
                    for (int j = 0; j < 4; ++j) BON[(rowbase + tch + pw * 8 + quad * 4 + j) * 8 + h] = bacc[j]; }
            }
            __syncthreads();
        }
    }
}

#ifndef MK_NO_SCAN
#define SCAN_CALL scan_unit(lds, p, l, u, tid, wave, lane)
#else
#define SCAN_CALL
#endif
#ifndef MK_NO_ATTN
#define ATTN_CALL attn_unit(lds, Zb, XN, u - 128, wave, lane)
#else
#define ATTN_CALL
#endif
__global__ void __launch_bounds__(512, 2) mk_fwd(Params p) {
    extern __shared__ __attribute__((aligned(16))) unsigned char lds_raw[];
    LAS unsigned char* lds = (LAS unsigned char*)lds_raw;
    cg::grid_group grid = cg::this_grid();
    const int G = gridDim.x, NGW = G * 8;
    const int wave_s = __builtin_amdgcn_readfirstlane(threadIdx.x >> 6);
    unsigned char* ws = p.ws;
    bf16* XN = (bf16*)(ws + WS_XN); bf16* Zb = (bf16*)(ws + WS_Z); bf16* Hb = (bf16*)(ws + WS_H); bf16* Y1 = (bf16*)(ws + WS_Y1);
    int ph = 0;
#define PH_ON (ph >= p.ph_lo && ph < p.ph_hi)
#define PH_END do { if (ph + 1 < p.ph_hi) grid.sync(); } while (0)
    if (PH_ON) { MK_IDS; prologue(p, lds, gw, NGW, wave, lane); PH_END; } ++ph;
#pragma unroll 1
    for (int l = 0; l < DEPTH; ++l) {
        if (PH_ON) { pg8::Gemm g{XN, (const bf16*)(ws + WS_WIN) + (size_t)l * NZ * 1024, NT, NZ, 1024}; pg8::StaticOrder S; S.init(NT, NZ, G, (int)blockIdx.x);
            pg8::EpiAct<0> E{Zb, NZ}; pg8::gemm_phase<pg8::EpiAct<0>, pg8::StaticOrder, true, true>(lds, g, S, E, wave_s); PH_END; } ++ph;
        if (PH_ON) { MK_IDS;
            for (int u = blockIdx.x; u < 128; u += G) { SCAN_CALL; __syncthreads(); }
            for (int u = (blockIdx.x >= 128 ? blockIdx.x : blockIdx.x + ((127 - blockIdx.x) / G + 1) * G); u < 256; u += G) { ATTN_CALL; __syncthreads(); }
            PH_END; } ++ph;
        if (PH_ON) { MK_IDS; post_phase(XN, (const bf16*)(ws + WS_YS), (const bf16*)(ws + WS_G), (const bf16*)(ws + WS_VC), (const float*)(ws + WS_BON), p.in[9] + l * 512, p.in[20] + l * 512, p.in[21] + l * 512, gw, NGW, lane); PH_END; } ++ph;
        if (PH_ON) { pg8::Gemm g{XN, (const bf16*)(ws + WS_WOUT) + (size_t)l * 1024 * 1024, NT, 1024, 1024}; pg8::StaticOrder S; S.init(NT, 1024, G, (int)blockIdx.x);
            pg8::EpiAct<0> E{Y1, 1024}; pg8::gemm_phase<pg8::EpiAct<0>, pg8::StaticOrder, true, true>(lds, g, S, E, wave_s); PH_END; } ++ph;
        if (PH_ON) { MK_IDS; norm_phase(Y1, p.out, XN, p.in[2] + l * 1024, p.in[3] + l * 1024, gw, NGW, lane); PH_END; } ++ph;
        if (PH_ON) { pg8::Gemm g{XN, (const bf16*)(ws + WS_WUP) + (size_t)l * 4096 * 1024, NT, DFF, 1024}; pg8::StaticOrder S; S.init(NT, DFF, G, (int)blockIdx.x);
            pg8::EpiAct<1> E{Hb, DFF}; pg8::gemm_phase<pg8::EpiAct<1>, pg8::StaticOrder, true, true>(lds, g, S, E, wave_s); PH_END; } ++ph;
        if (PH_ON) { pg8::Gemm g{Hb, (const bf16*)(ws + WS_WDN) + (size_t)l * 1024 * 4096, NT, 1024, DFF}; pg8::StaticOrder S; S.init(NT, 1024, G, (int)blockIdx.x);
            pg8::EpiAct<0> E{XN, 1024}; pg8::gemm_phase<pg8::EpiAct<0>, pg8::StaticOrder, true, true>(lds, g, S, E, wave_s); PH_END; } ++ph;
        if (PH_ON) { MK_IDS; norm_phase(XN, p.out, XN, p.in[4] + l * 1024, (l + 1 < DEPTH) ? p.in[1] + (l + 1) * 1024 : nullptr, gw, NGW, lane); PH_END; } ++ph;
    }
}
constexpr int N_PHASES = 1 + 8 * DEPTH;

extern "C" void kernel_launch(void* const* d_in, const int* in_sizes, int n_in, void* d_out, int out_size, void* d_ws, size_t ws_size, hipStream_t stream) {
    static int grid = 0;
    if (grid == 0) {
        if (n_in != 25 || out_size != NT * DM || ws_size < WS_END) { fprintf(stderr, "kernel_launch: unexpected sizes n_in=%d out=%d ws=%zu\n", n_in, out_size, ws_size); grid = -1; return; }
        int dev = 0, cus = 0, per_cu = 0;
        hipGetDevice(&dev); hipDeviceGetAttribute(&cus, hipDeviceAttributeMultiprocessorCount, dev);
        if (hipFuncSetAttribute((const void*)mk_fwd, hipFuncAttributeMaxDynamicSharedMemorySize, LDS_BYTES) != hipSuccess) { fprintf(stderr, "kernel_launch: hipFuncSetAttribute failed\n"); grid = -1; return; }
        if (hipOccupancyMaxActiveBlocksPerMultiprocessor(&per_cu, (const void*)mk_fwd, 512, LDS_BYTES) != hipSuccess || per_cu < 1) { fprintf(stderr, "kernel_launch: occupancy query gave %d\n", per_cu); per_cu = 1; }
        (void)hipGetLastError();
        grid = cus * per_cu;
        fprintf(stderr, "kernel_launch: grid %d (cus %d x %d)\n", grid, cus, per_cu);
    }
    if (grid < 0) return;
    Params p{};
    for (int i = 0; i < 25; ++i) p.in[i] = (const float*)d_in[i];
    p.out = (float*)d_out; p.ws = (unsigned char*)d_ws;
#if MK_MULTI
    for (int ph = 0; ph < N_PHASES; ++ph) { p.ph_lo = ph; p.ph_hi = ph + 1; hipLaunchKernelGGL(mk_fwd, dim3(grid), dim3(512), LDS_BYTES, stream, p); }
#else
    p.ph_lo = 0; p.ph_hi = N_PHASES;
    void* args[] = {&p};
    hipError_t e = hipLaunchCooperativeKernel((const void*)mk_fwd, dim3(grid), dim3(512), args, LDS_BYTES, stream);
    if (e != hipSuccess) fprintf(stderr, "kernel_launch: cooperative launch failed: %s (grid %d)\n", hipGetErrorString(e), grid);
#endif
}
```

```cpp
#include <hip/hip_runtime.h>
#include <hip/hip_cooperative_groups.h>
#include <cstdio>
#include <cstdint>
namespace cg = cooperative_groups;
#ifndef MK_MULTI
#define MK_MULTI 0
#endif
namespace pg8 {
#define PG8_LAS __attribute__((address_space(3)))
typedef unsigned short bf16_t;
typedef short bf16x8 __attribute__((ext_vector_type(8)));
typedef float f32x4 __attribute__((ext_vector_type(4)));
typedef unsigned u32x4 __attribute__((ext_vector_type(4)));
constexpr int BM = 256, BK = 64, HALF = 128, HTB = HALF * BK * 2  , STAGE_BYTES = 8 * HTB, NXCD = 8, WGM = 8;

__host__ __device__ __forceinline__ int lds_byte(int r, int c) { const int st = (r >> 4) * 2 + (c >> 5), rr = r & 15, cc = c & 31, ob = rr * 64 + cc * 2; return st * 1024 + (ob ^ (((ob >> 9) & 1) << 5)); }
__host__ __device__ __forceinline__ void stage_rc(int b, int& R, int& C) { const int st = b / 1024, sb = b % 1024, swz = sb ^ (((sb >> 9) & 1) << 5); R = (st >> 1) * 16 + swz / 64; C = (st & 1) * 32 + (swz % 64) / 2; }
__host__ __device__ __forceinline__ int perm32(int rho) { const int n = rho >> 4, i = rho & 15; return 8 * (i >> 2) + 4 * n + (i & 3); }

struct Unit { int pm, pn; };
struct Gemm { const bf16_t* A; const bf16_t* Bt; int M, N, K; };
struct StaticOrder {
    int nM, nN, nwg, G, c;
    __host__ __device__ void init(int M, int N, int G_, int c_) { nM = M / BM; nN = N / BM; nwg = nM * nN; G = G_; c = c_; }
    __host__ __device__ bool next(int i, Unit& u) const {
        const long L = (long)i * G + c; if (L >= nwg) return false;
        int wgid = (int)L; { const int q = nwg / NXCD, r = nwg % NXCD, xcd = wgid % NXCD, off = wgid / NXCD; wgid = (xcd < r ? xcd * (q + 1) : r * (q + 1) + (xcd - r) * q) + off; }
        const int nig = WGM * nN, gid = wgid / nig, fm = gid * WGM, gsz = (nM - fm) < WGM ? (nM - fm) : WGM;
        u.pm = fm + ((wgid % nig) % gsz); u.pn = (wgid % nig) / gsz; return true;
    }
    __device__ __forceinline__ void a_ready(const Unit&) const {}
    __device__ __forceinline__ void done(const Unit&) const {}
};
__device__ __forceinline__ unsigned cvt_pk_bf16(float lo, float hi) { unsigned r; asm volatile("v_cvt_pk_bf16_f32 %0, %1, %2" : "=v"(r) : "v"(lo), "v"(hi)); return r; }
typedef float f32x2 __attribute__((ext_vector_type(2)));
__device__ __forceinline__ int mk_tid(const int w) { unsigned m = ~0u; asm volatile("" : "+s"(m)); const int l = __builtin_amdgcn_mbcnt_hi(m, __builtin_amdgcn_mbcnt_lo(m, 0u)); int t = w * 64 + l; asm volatile("" : "+v"(t)); return t; }
template <int ACT> struct EpiAct {
    static constexpr bool PERM = true, AFTER_DRAIN = false;
    bf16_t* O; int ldc;
    __device__ __forceinline__ void operator()(const f32x4 (&acc)[2][2][4][2], const Unit& u, int wr, int wc, int fr, int fq) const {
        const int row0 = u.pm * BM + wr * 64 + fr; const int col0 = u.pn * BM + wc * 32 + 8 * fq;
#pragma unroll
        for (int ai = 0; ai < 2; ++ai)
#pragma unroll
            for (int m = 0; m < 4; ++m) { bf16_t* rowp = O + (size_t)(row0 + ai * HALF + m * 16) * ldc + col0;
#pragma unroll
                for (int bj = 0; bj < 2; ++bj) { f32x4 v0 = acc[ai][bj][m][0], v1 = acc[ai][bj][m][1];
                    if (ACT == 1) {
#pragma unroll
                        for (int e = 0; e < 4; ++e) { float a = v0[e] > 0.f ? v0[e] : 0.f, b = v1[e] > 0.f ? v1[e] : 0.f; v0[e] = a * a; v1[e] = b * b; } }
                    u32x4 w; w.x = cvt_pk_bf16(v0[0], v0[1]); w.y = cvt_pk_bf16(v0[2], v0[3]); w.z = cvt_pk_bf16(v1[0], v1[1]); w.w = cvt_pk_bf16(v1[2], v1[3]);
                    *(u32x4*)(rowp + bj * HALF) = w; } }
    }
};
template <class Epi, class Sched, bool ALIGN_EPI = false, bool SP2 = false>
__device__ __forceinline__ void gemm_phase(PG8_LAS unsigned char* lds, const Gemm g, const Sched& S, const Epi& E, const int wave_s) {
    const int tid = mk_tid(wave_s), wid = __builtin_amdgcn_readfirstlane(tid >> 6), lane = tid & 63, wr = wid >> 2, wc = wid & 3, fr = lane & 15, fq = lane >> 4;
    const int K = g.K, nt = K / BK;
    unsigned voffA[2], voffB[2];
#pragma unroll
    for (int i = 0; i < 2; ++i) { int R, C; stage_rc(tid * 16 + i * 8192, R, C); const int Rb = Epi::PERM ? ((R & ~31) + perm32(R & 31)) : R;
        voffA[i] = (unsigned)(R * K + C) * 2u; voffB[i] = (unsigned)(Rb * K + C) * 2u; }
    const size_t kstep = (size_t)(BK * 2);
    const size_t hstep = (size_t)HALF * K * 2;
    const size_t tstep = 2 * hstep;
    const unsigned ldsw = (unsigned)wid * 1024u;
    const int aoff = lds_byte(wr * 64 + fr, fq * 8), boff = lds_byte(wc * 32 + fr, fq * 8);
#define PG8_SA(b, h) (((b) * 2 + (h)) * HTB)
#define PG8_SB(b, h) ((4 + (b) * 2 + (h)) * HTB)
#define PG8_STAGE(bufoff, gbase, voff) do { _Pragma("unroll") for (int _i = 0; _i < 2; ++_i) \
        __builtin_amdgcn_global_load_lds((const unsigned*)((const char*)(gbase) + (voff)[_i]), (PG8_LAS unsigned*)(lds + (bufoff) + ldsw + _i * 8192), 16, 0, 0); } while (0)
#define PG8_LDA(dst, b, h) do { _Pragma("unroll") for (int m = 0; m < 4; ++m) _Pragma("unroll") for (int k = 0; k < 2; ++k) dst[m][k] = *(const PG8_LAS bf16x8*)(lds + PG8_SA(b, h) + aoff + m * 2048 + k * 1024); } while (0)
#define PG8_LDB(dst, b, h) do { _Pragma("unroll") for (int n = 0; n < 2; ++n) _Pragma("unroll") for (int k = 0; k < 2; ++k) dst[n][k] = *(const PG8_LAS bf16x8*)(lds + PG8_SB(b, h) + boff + n * 2048 + k * 1024); } while (0)
#define PG8_MMA(ai, bj, At, Bt) do { __builtin_amdgcn_s_setprio(1); _Pragma("unroll") for (int m = 0; m < 4; ++m) _Pragma("unroll") for (int n = 0; n < 2; ++n) _Pragma("unroll") for (int k = 0; k < 2; ++k) \
        acc[ai][bj][m][n] = __builtin_amdgcn_mfma_f32_16x16x32_bf16(Bt[n][k], At[m][k], acc[ai][bj][m][n], 0, 0, 0); __builtin_amdgcn_s_setprio(0); } while (0)
#define PG8_WAIT_V(n) asm volatile("s_waitcnt vmcnt(" #n ")" ::: "memory")
#define PG8_WAIT_L(n) asm volatile("s_waitcnt lgkmcnt(" #n ")" ::: "memory")
#define PG8_BAR __builtin_amdgcn_s_barrier()
#define PG8_SCHED __builtin_amdgcn_sched_barrier(0)
    Unit cur, nxt; int ui = 0;
    if (!S.next(0, cur)) return;
    f32x4 acc[2][2][4][2];
#pragma unroll
    for (int a = 0; a < 2; ++a)
#pragma unroll
        for (int b = 0; b < 2; ++b)
#pragma unroll
            for (int m = 0; m < 4; ++m)
#pragma unroll
                for (int n = 0; n < 2; ++n) acc[a][b][m][n] = (f32x4){0.f, 0.f, 0.f, 0.f};
    bf16x8 At[4][2], B0[2][2], B1[2][2];
    const char* cA = (const char*)g.A + (size_t)cur.pm * tstep; const char* cB = (const char*)g.Bt + (size_t)cur.pn * tstep;
    S.a_ready(cur);
    if constexpr (SP2) {
        PG8_STAGE(PG8_SB(0, 0), cB, voffB); PG8_STAGE(PG8_SB(0, 1), cB + hstep, voffB); PG8_STAGE(PG8_SA(0, 0), cA, voffA); PG8_STAGE(PG8_SA(0, 1), cA + hstep, voffA);
        if (wr == 1) PG8_BAR;
        PG8_WAIT_V(2); PG8_BAR;
        PG8_STAGE(PG8_SB(1, 0), cB + kstep, voffB); PG8_STAGE(PG8_SA(1, 0), cA + kstep, voffA); PG8_STAGE(PG8_SB(1, 1), cB + hstep + kstep, voffB);
        PG8_WAIT_V(6); PG8_BAR;
    } else {
        PG8_STAGE(PG8_SB(0, 0), cB, voffB); PG8_STAGE(PG8_SA(0, 0), cA, voffA); PG8_STAGE(PG8_SB(0, 1), cB + hstep, voffB); PG8_STAGE(PG8_SA(0, 1), cA + hstep, voffA);
        if (wr == 1) PG8_BAR;
        PG8_WAIT_V(4); PG8_BAR;
        PG8_STAGE(PG8_SB(1, 0), cB + kstep, voffB); PG8_STAGE(PG8_SA(1, 0), cA + kstep, voffA); PG8_STAGE(PG8_SB(1, 1), cB + hstep + kstep, voffB);
        PG8_WAIT_V(6); PG8_BAR;
    }
    for (;;) {
        const bool has_next = S.next(ui + 1, nxt);
        const char* nA = has_next ? (const char*)g.A + (size_t)nxt.pm * tstep : cA; const char* nB = has_next ? (const char*)g.Bt + (size_t)nxt.pn * tstep : cB;
        for (int t = 0; t < nt; t += 2) {
            const bool last = (t == nt - 2);
            const char* a1 = cA + (size_t)(t + 1) * kstep;
            const char* a2 = last ? nA : cA + (size_t)(t + 2) * kstep; const char* b2 = last ? nB : cB + (size_t)(t + 2) * kstep;
            const char* a3 = a2 + kstep; const char* b3 = b2 + kstep;
            if (last && has_next) S.a_ready(nxt);
            if constexpr (SP2) {
            PG8_LDB(B0, 0, 0); PG8_LDB(B1, 0, 1); PG8_SCHED; PG8_LDA(At, 0, 0); PG8_STAGE(PG8_SA(1, 1), a1 + hstep, voffA);
            PG8_WAIT_V(8); PG8_WAIT_L(0); PG8_BAR; PG8_MMA(0, 0, At, B0); PG8_MMA(0, 1, At, B1); PG8_BAR; PG8_SCHED;
            PG8_LDA(At, 0, 1); PG8_STAGE(PG8_SB(0, 0), b2, voffB); PG8_STAGE(PG8_SB(0, 1), b2 + hstep, voffB); PG8_STAGE(PG8_SA(0, 0), a2, voffA);
            PG8_WAIT_V(8); PG8_WAIT_L(0); PG8_BAR; PG8_MMA(1, 0, At, B0); PG8_MMA(1, 1, At, B1); PG8_BAR; PG8_SCHED;
            PG8_LDB(B0, 1, 0); PG8_LDB(B1, 1, 1); PG8_SCHED; PG8_LDA(At, 1, 0); PG8_STAGE(PG8_SA(0, 1), a2 + hstep, voffA);
            PG8_WAIT_V(8); PG8_WAIT_L(0); PG8_BAR; PG8_MMA(0, 0, At, B0); PG8_MMA(0, 1, At, B1); PG8_BAR; PG8_SCHED;
            PG8_LDA(At, 1, 1); PG8_STAGE(PG8_SB(1, 0), b3, voffB); PG8_STAGE(PG8_SB(1, 1), b3 + hstep, voffB); PG8_STAGE(PG8_SA(1, 0), a3, voffA);
            PG8_WAIT_V(8); PG8_WAIT_L(0); PG8_BAR; PG8_MMA(1, 0, At, B0); PG8_MMA(1, 1, At, B1); PG8_BAR; PG8_SCHED;
            } else {
            PG8_LDB(B0, 0, 0); PG8_SCHED; PG8_LDA(At, 0, 0); PG8_STAGE(PG8_SA(1, 1), a1 + hstep, voffA);
            PG8_WAIT_L(8); PG8_BAR; PG8_WAIT_L(0); PG8_MMA(0, 0, At, B0); PG8_BAR; PG8_SCHED;
            PG8_LDB(B1, 0, 1); PG8_STAGE(PG8_SB(0, 0), b2, voffB);
            PG8_BAR; PG8_WAIT_L(0); PG8_MMA(0, 1, At, B1); PG8_BAR;
            PG8_LDA(At, 0, 1); PG8_STAGE(PG8_SA(0, 0), a2, voffA);
            PG8_BAR; PG8_WAIT_L(0); PG8_MMA(1, 0, At, B0); PG8_BAR; PG8_SCHED;
            PG8_STAGE(PG8_SB(0, 1), b2 + hstep, voffB);
            PG8_WAIT_V(6); PG8_BAR; PG8_MMA(1, 1, At, B1); PG8_BAR;
            PG8_LDB(B0, 1, 0); PG8_SCHED; PG8_LDA(At, 1, 0); PG8_STAGE(PG8_SA(0, 1), a2 + hstep, voffA);
            PG8_WAIT_L(8); PG8_BAR; PG8_WAIT_L(0); PG8_MMA(0, 0, At, B0); PG8_BAR; PG8_SCHED;
            PG8_LDB(B1, 1, 1); PG8_STAGE(PG8_SB(1, 0), b3, voffB);
            PG8_BAR; PG8_WAIT_L(0); PG8_MMA(0, 1, At, B1); PG8_BAR;
            PG8_LDA(At, 1, 1); PG8_STAGE(PG8_SA(1, 0), a3, voffA);
            PG8_BAR; PG8_WAIT_L(0); PG8_MMA(1, 0, At, B0); PG8_BAR; PG8_SCHED;
            PG8_STAGE(PG8_SB(1, 1), b3 + hstep, voffB);
            PG8_WAIT_V(6); PG8_BAR; PG8_MMA(1, 1, At, B1); PG8_BAR;
            }
        }
        if constexpr (ALIGN_EPI) { if (wr == 0) PG8_BAR; }
        if constexpr (!Epi::AFTER_DRAIN) { E(acc, cur, wr, wc, fr, fq); S.done(cur); }
        if (!has_next) break;
#pragma unroll
        for (int a = 0; a < 2; ++a)
#pragma unroll
            for (int b = 0; b < 2; ++b)
#pragma unroll
                for (int m = 0; m < 4; ++m)
#pragma unroll
                    for (int n = 0; n < 2; ++n) acc[a][b][m][n] = (f32x4){0.f, 0.f, 0.f, 0.f};
        cur = nxt; cA = nA; cB = nB; ++ui;
        if constexpr (ALIGN_EPI) { if (wr == 1) PG8_BAR; }
    }
    PG8_WAIT_V(0);
    if constexpr (!ALIGN_EPI) { if (wr == 0) PG8_BAR; }
    PG8_BAR;
    if constexpr (Epi::AFTER_DRAIN) { E.fused(acc, cur, wr, wc, fr, fq, lds, wid, lane); S.done(cur); }
#undef PG8_SA
#undef PG8_SB
#undef PG8_STAGE
#undef PG8_LDA
#undef PG8_LDB
#undef PG8_MMA
#undef PG8_WAIT_V
#undef PG8_WAIT_L
#undef PG8_BAR
#undef PG8_SCHED
}
}
constexpr int NB = 8, SEQ = 4096, DM = 1024, NT = NB * SEQ, DEPTH = 4, DFF = 4096;
constexpr int NZ = 3328;
constexpr int ZQ = 0, ZK = 512, ZV = 1024, ZR = 1536, ZKR = 2048, ZVR = 2560, ZXW = 3072, ZMV = 3232;
constexpr size_t MiB = 1u << 20;
constexpr size_t WS_WIN = 1 * MiB, WS_WOUT = 27 * MiB, WS_WUP = 35 * MiB, WS_WDN = 67 * MiB, WS_LT = 99 * MiB;
constexpr size_t WS_XN = 100 * MiB, WS_VF = 164 * MiB, WS_BON = 196 * MiB, WS_BIG = 198 * MiB;
constexpr size_t WS_Z = WS_BIG, WS_YS = 406 * MiB, WS_G = 438 * MiB, WS_VC = 470 * MiB, WS_H = WS_BIG, WS_Y1 = WS_BIG, WS_END = 502 * MiB;
constexpr int LDS_BYTES = 147456;

#define LAS __attribute__((address_space(3)))
typedef unsigned short bf16;
typedef float f32x4 __attribute__((ext_vector_type(4)));
typedef unsigned u32x4 __attribute__((ext_vector_type(4)));
typedef unsigned u32x2 __attribute__((ext_vector_type(2)));
typedef short bf16x8 __attribute__((ext_vector_type(8)));
typedef short s16x4 __attribute__((ext_vector_type(4)));

__device__ __forceinline__ float bf2f(unsigned u) { return __uint_as_float(u << 16); }
__device__ __forceinline__ float bflo(unsigned u) { return __uint_as_float(u << 16); }
__device__ __forceinline__ float bfhi(unsigned u) { return __uint_as_float(u & 0xffff0000u); }
__device__ __forceinline__ unsigned f2bf(float f) { unsigned u = __float_as_uint(f); return (u + 0x7fffu + ((u >> 16) & 1u)) >> 16; }
__device__ __forceinline__ unsigned pk2(float lo, float hi) { return f2bf(lo) | (f2bf(hi) << 16); }
__device__ __forceinline__ float wave_sum(float v) {
#pragma unroll
    for (int o = 1; o < 64; o <<= 1) v += __shfl_xor(v, o);
    return v;
}
__device__ __forceinline__ float dppf(float v, const int ctrl_sel) {
    int r;
    if (ctrl_sel == 0) r = __builtin_amdgcn_update_dpp(0, __float_as_int(v), 0xB1, 0xF, 0xF, false);
    else if (ctrl_sel == 1) r = __builtin_amdgcn_update_dpp(0, __float_as_int(v), 0x4E, 0xF, 0xF, false);
    else if (ctrl_sel == 2) r = __builtin_amdgcn_update_dpp(0, __float_as_int(v), 0x141, 0xF, 0xF, false);
    else r = __builtin_amdgcn_update_dpp(0, __float_as_int(v), 0x140, 0xF, 0xF, false);
    return __int_as_float(r);
}
__device__ __forceinline__ float rowsum16(float v) { v += dppf(v, 0); v += dppf(v, 1); v += dppf(v, 2); v += dppf(v, 3); return v; }
__device__ __forceinline__ float sigmoidf_(float x) { return 1.0f / (1.0f + __expf(-x)); }

struct Params { const float* in[25]; float* out; unsigned char* ws; int ph_lo, ph_hi; };
#define MK_IDS const int tid = pg8::mk_tid(wave_s), lane = tid & 63, wave = __builtin_amdgcn_readfirstlane(tid >> 6); const int gw = blockIdx.x * 8 + wave; (void)gw; (void)lane

__device__ __forceinline__ void transpose_item(const float* W, int K, int N, bf16* WT, LAS float* scr, int item, int lane) {
    const int nblk = N / 32, kb = item / nblk, nb = item % nblk, k0 = 64 * kb, n0 = 32 * nb;
#pragma unroll 8
    for (int i = 0; i < 32; ++i) { const int kk = 2 * i + (lane >> 5); scr[kk * 33 + (lane & 31)] = W[(size_t)(k0 + kk) * N + n0 + (lane & 31)]; }
    asm volatile("s_waitcnt lgkmcnt(0)" ::: "memory");
    const int c = lane & 7;
#pragma unroll
    for (int j = 0; j < 4; ++j) { const int n = (lane >> 3) + 8 * j; const LAS float* s = scr + (8 * c) * 33 + n;
        u32x4 o; o.x = pk2(s[0 * 33], s[1 * 33]); o.y = pk2(s[2 * 33], s[3 * 33]); o.z = pk2(s[4 * 33], s[5 * 33]); o.w = pk2(s[6 * 33], s[7 * 33]);
        *(u32x4*)(WT + (size_t)(n0 + n) * K + k0 + 8 * c) = o; }
    asm volatile("s_waitcnt lgkmcnt(0)" ::: "memory");
}

__device__ __forceinline__ void prologue(const Params& p, LAS unsigned char* lds, int gw, int NGW, int wave, int lane) {
    unsigned char* ws = p.ws;
    LAS float* scr = (LAS float*)(lds + wave * 16384);
    constexpr int I_IN0 = 16 * 101, I_INR = 16 * 102, I_OUT = 16 * 32, I_UP = 16 * 128, I_DN = 64 * 32;
    constexpr int NITEMS = I_IN0 + 3 * I_INR + 4 * I_OUT + 4 * I_UP + 4 * I_DN;
    for (int it = gw; it < NITEMS; it += NGW) {
        int r = it;
        if (r < I_IN0) { transpose_item(p.in[5], 1024, 3232, (bf16*)(ws + WS_WIN), scr, r, lane); continue; } r -= I_IN0;
        if (r < 3 * I_INR) { const int l = r / I_INR; transpose_item(p.in[6] + (size_t)l * 1024 * 3264, 1024, 3264, (bf16*)(ws + WS_WIN) + (size_t)(l + 1) * NZ * 1024, scr, r % I_INR, lane); continue; } r -= 3 * I_INR;
        if (r < 4 * I_OUT) { const int l = r / I_OUT; transpose_item(p.in[22] + (size_t)l * 1024 * 1024, 1024, 1024, (bf16*)(ws + WS_WOUT) + (size_t)l * 1024 * 1024, scr, r % I_OUT, lane); continue; } r -= 4 * I_OUT;
        if (r < 4 * I_UP) { const int l = r / I_UP; transpose_item(p.in[23] + (size_t)l * 1024 * 4096, 1024, 4096, (bf16*)(ws + WS_WUP) + (size_t)l * 4096 * 1024, scr, r % I_UP, lane); continue; } r -= 4 * I_UP;
        { const int l = r / I_DN; transpose_item(p.in[24] + (size_t)l * 4096 * 1024, 4096, 1024, (bf16*)(ws + WS_WDN) + (size_t)l * 1024 * 4096, scr, r % I_DN, lane); }
    }
    {
        const int gt = gw * 64 + lane, NG = NGW * 64;
        const u32x4 z4 = {0u, 0u, 0u, 0u};
        for (int l = 0; l < 4; ++l) { const int r0 = (l == 0) ? 3232 : 3264; const int nvec = (NZ - r0) * 1024 / 8;
            u32x4* base = (u32x4*)((bf16*)(ws + WS_WIN) + ((size_t)l * NZ + r0) * 1024);
            for (int i = gt; i < nvec; i += NG) base[i] = z4; }
        bf16* LT = (bf16*)(ws + WS_LT);
        for (int i = gt; i < 4 * 512 * 192; i += NG) { const int l = i / (512 * 192), rem = i % (512 * 192), c = rem / 192, m = rem % 192; float v;
            if (m < 32) v = p.in[11][((size_t)l * 32 + m) * 512 + c];
            else if (m < 64) v = p.in[13][((size_t)l * 32 + (m - 32)) * 512 + c];
            else if (m < 160) v = p.in[16][((size_t)l * 96 + (m - 64)) * 512 + c];
            else v = (l > 0) ? p.in[15][((size_t)(l - 1) * 32 + (m - 160)) * 512 + c] : 0.f;
            LT[i] = (bf16)f2bf(v); }
    }
    const float* x = p.in[0]; const float* g = p.in[1]; bf16* XN = (bf16*)(ws + WS_XN);
    for (int row = gw; row < NT; row += NGW) {
        const f32x4* xr = (const f32x4*)(x + (size_t)row * DM) + lane; f32x4* orow = (f32x4*)(p.out + (size_t)row * DM) + lane;
        f32x4 v[4]; float s = 0.f;
#pragma unroll
        for (int j = 0; j < 4; ++j) { v[j] = xr[64 * j]; orow[64 * j] = v[j]; s += (v[j].x * v[j].x + v[j].y * v[j].y) + (v[j].z * v[j].z + v[j].w * v[j].w); }
        const float rstd = 1.0f / sqrtf(wave_sum(s) * (1.0f / DM) + 1e-6f);
        u32x2* o8 = (u32x2*)(XN + (size_t)row * DM) + lane;
#pragma unroll
        for (int j = 0; j < 4; ++j) { const f32x4 gg = ((const f32x4*)g)[lane + 64 * j]; u32x2 w; w.x = pk2(v[j].x * rstd * gg.x, v[j].y * rstd * gg.y); w.y = pk2(v[j].z * rstd * gg.z, v[j].w * rstd * gg.w); o8[64 * j] = w; }
    }
}

__device__ __forceinline__ void norm_phase(const bf16* Y, float* X, bf16* XN, const float* gpost, const float* gnext, int gw, int NGW, int lane) {
    for (int row = gw; row < NT; row += NGW) {
        const u32x4* yr = (const u32x4*)(Y + (size_t)row * DM); f32x4* xr = (f32x4*)(X + (size_t)row * DM);
        float y[16]; float ss = 0.f;
#pragma unroll
        for (int k = 0; k < 2; ++k) { const u32x4 w = yr[k * 64 + lane];
            y[k * 8 + 0] = bflo(w.x); y[k * 8 + 1] = bfhi(w.x); y[k * 8 + 2] = bflo(w.y); y[k * 8 + 3] = bfhi(w.y); y[k * 8 + 4] = bflo(w.z); y[k * 8 + 5] = bfhi(w.z); y[k * 8 + 6] = bflo(w.w); y[k * 8 + 7] = bfhi(w.w); }
#pragma unroll
        for (int e = 0; e < 16; ++e) ss += y[e] * y[e];
        const float rstd = 1.0f / sqrtf(wave_sum(ss) * (1.0f / DM) + 1e-6f);
        float xn[16]; float s2 = 0.f;
#pragma unroll
        for (int k = 0; k < 2; ++k)
#pragma unroll
            for (int q = 0; q < 2; ++q) { const int vi = k * 128 + lane * 2 + q; f32x4 xv = xr[vi]; const f32x4 gg = ((const f32x4*)gpost)[vi];
#pragma unroll
                for (int e = 0; e < 4; ++e) { const float t = xv[e] + y[k * 8 + q * 4 + e] * rstd * gg[e]; xv[e] = t; xn[k * 8 + q * 4 + e] = t; s2 += t * t; }
                xr[vi] = xv; }
        if (gnext) {
            const float r2 = 1.0f / sqrtf(wave_sum(s2) * (1.0f / DM) + 1e-6f);
            u32x4* o = (u32x4*)(XN + (size_t)row * DM);
#pragma unroll
            for (int k = 0; k < 2; ++k) { const f32x4 g0 = ((const f32x4*)gnext)[k * 128 + lane * 2], g1 = ((const f32x4*)gnext)[k * 128 + lane * 2 + 1]; u32x4 w;
                w.x = pk2(xn[k * 8 + 0] * r2 * g0.x, xn[k * 8 + 1] * r2 * g0.y); w.y = pk2(xn[k * 8 + 2] * r2 * g0.z, xn[k * 8 + 3] * r2 * g0.w);
                w.z = pk2(xn[k * 8 + 4] * r2 * g1.x, xn[k * 8 + 5] * r2 * g1.y); w.w = pk2(xn[k * 8 + 6] * r2 * g1.z, xn[k * 8 + 7] * r2 * g1.w);
                o[k * 64 + lane] = w; }
        }
    }
}

__device__ __forceinline__ void post_phase(bf16* MIX, const bf16* YS, const bf16* GB, const bf16* VC, const float* BON, const float* again, const float* gnw, const float* gnb, int gw, int NGW, int lane) {
    for (int row = gw; row < NT; row += NGW) {
        u32x4* mrow = (u32x4*)(MIX + (size_t)row * DM);
        {
            const u32x4 w = mrow[lane]; float o[8] = {bflo(w.x), bfhi(w.x), bflo(w.y), bfhi(w.y), bflo(w.z), bfhi(w.z), bflo(w.w), bfhi(w.w)}; float ss = 0.f;
#pragma unroll
            for (int e = 0; e < 8; ++e) ss += o[e] * o[e];
            const float rstd = 1.0f / sqrtf(wave_sum(ss) * (1.0f / 512.0f) + 1e-6f);
            const f32x4 g0 = ((const f32x4*)again)[lane * 2], g1 = ((const f32x4*)again)[lane * 2 + 1]; u32x4 r;
            r.x = pk2(o[0] * rstd * g0.x, o[1] * rstd * g0.y); r.y = pk2(o[2] * rstd * g0.z, o[3] * rstd * g0.w); r.z = pk2(o[4] * rstd * g1.x, o[5] * rstd * g1.y); r.w = pk2(o[6] * rstd * g1.z, o[7] * rstd * g1.w);
            mrow[lane] = r;
        }
        {
            const u32x4 w = ((const u32x4*)(YS + (size_t)row * 512))[lane]; float y[8] = {bflo(w.x), bfhi(w.x), bflo(w.y), bfhi(w.y), bflo(w.z), bfhi(w.z), bflo(w.w), bfhi(w.w)};
            float s1 = 0.f;
#pragma unroll
            for (int e = 0; e < 8; ++e) s1 += y[e];
            s1 += __shfl_xor(s1, 1); s1 += __shfl_xor(s1, 2); s1 += __shfl_xor(s1, 4);
            const float mean = s1 * (1.0f / 64.0f); float s2 = 0.f;
#pragma unroll
            for (int e = 0; e < 8; ++e) { y[e] -= mean; s2 += y[e] * y[e]; }
            s2 += __shfl_xor(s2, 1); s2 += __shfl_xor(s2, 2); s2 += __shfl_xor(s2, 4);
            const float rs = 1.0f / sqrtf(s2 * (1.0f / 64.0f) + 64e-5f);
            const u32x4 vw = ((const u32x4*)(VC + (size_t)row * 512))[lane], gw4 = ((const u32x4*)(GB + (size_t)row * 512))[lane];
            const float v[8] = {bflo(vw.x), bfhi(vw.x), bflo(vw.y), bfhi(vw.y), bflo(vw.z), bfhi(vw.z), bflo(vw.w), bfhi(vw.w)};
            const float g[8] = {bflo(gw4.x), bfhi(gw4.x), bflo(gw4.y), bfhi(gw4.y), bflo(gw4.z), bfhi(gw4.z), bflo(gw4.w), bfhi(gw4.w)};
            const float bon = BON[(size_t)row * 8 + (lane >> 3)];
            const f32x4 w0 = ((const f32x4*)gnw)[lane * 2], w1 = ((const f32x4*)gnw)[lane * 2 + 1], b0 = ((const f32x4*)gnb)[lane * 2], b1 = ((const f32x4*)gnb)[lane * 2 + 1];
            const float gwv[8] = {w0.x, w0.y, w0.z, w0.w, w1.x, w1.y, w1.z, w1.w}, gbv[8] = {b0.x, b0.y, b0.z, b0.w, b1.x, b1.y, b1.z, b1.w};
            float o[8];
#pragma unroll
            for (int e = 0; e < 8; ++e) o[e] = (y[e] * rs * gwv[e] + gbv[e] + bon * v[e]) * g[e];
            u32x4 r; r.x = pk2(o[0], o[1]); r.y = pk2(o[2], o[3]); r.z = pk2(o[4], o[5]); r.w = pk2(o[6], o[7]);
            mrow[64 + lane] = r;
        }
    }
}

__device__ __forceinline__ void attn_unit(LAS unsigned char* lds, const bf16* Z, bf16* MIX, int unit, int wave, int lane) {
    const int b = unit >> 4, t0 = (unit & 15) * 256;
    LAS float* ACC = (LAS float*)lds;
    LAS float* ML = (LAS float*)(lds + 256 * 68 * 4);
    LAS unsigned char* VST = lds + 256 * 68 * 4 + 2048 + wave * 4096;
    const int li = lane & 15, quad = lane >> 4;
    const float C = 0.125f * 1.4426950408889634f;
    const size_t rowbase = (size_t)b * SEQ;
    for (int h = 0; h < 8; ++h) {
#pragma unroll 1
        for (int br = 0; br < 3; ++br) {
            const int lg = br * 2; const int L = SEQ >> lg;
#pragma unroll 1
            for (int u = 0; u < 2; ++u) {
                const int tu = wave * 2 + u;
                int r, i0;
                if (br == 0) { r = 0; i0 = t0 + tu * 16; } else if (br == 1) { r = tu & 3; i0 = (t0 >> 2) + (tu >> 2) * 16; } else { r = tu; i0 = t0 >> 4; }
                const int tq = ((i0 + li) << lg) + r;
                const bf16* qp = Z + (rowbase + tq) * NZ + ZQ + h * 64 + quad * 8;
                const bf16x8 q0 = *(const bf16x8*)qp, q1 = *(const bf16x8*)(qp + 32);
                f32x4 s[9];
#pragma unroll
                for (int kt = 0; kt < 9; ++kt) {
                    int ik = i0 - 128 + kt * 16 + li; ik = ik < 0 ? 0 : ik;
                    const bf16* kp = Z + (rowbase + (ik << lg) + r) * NZ + ZK + h * 64 + quad * 8;
                    const bf16x8 k0 = *(const bf16x8*)kp, k1 = *(const bf16x8*)(kp + 32);
                    f32x4 a = {0.f, 0.f, 0.f, 0.f};
                    a = __builtin_amdgcn_mfma_f32_16x16x32_bf16(k0, q0, a, 0, 0, 0);
                    a = __builtin_amdgcn_mfma_f32_16x16x32_bf16(k1, q1, a, 0, 0, 0);
                    s[kt] = a;
                }
                u32x4 vv[5][4];
#pragma unroll
                for (int cc = 0; cc < 5; ++cc)
#pragma unroll
                    for (int it = 0; it < 4; ++it) { const int idx = it * 64 + lane, rr = idx >> 3, c16 = idx & 7; int ik = i0 - 128 + cc * 32 + rr; ik = ik < 0 ? 0 : (ik > L - 1 ? L - 1 : ik);
                        vv[cc][it] = *(const u32x4*)(Z + (rowbase + (ik << lg) + r) * NZ + ZV + h * 64 + c16 * 8); }
                float mx = -1e30f;
#pragma unroll
                for (int kt = 0; kt < 9; ++kt)
#pragma unroll
                    for (int j = 0; j < 4; ++j) { const int key = kt * 16 + quad * 4 + j; const int dist = 128 + li - key; const int ik = i0 - 128 + key;
                        const bool valid = (dist >= 0) && (dist <= 128) && (ik >= 0);
                        const float sv = valid ? s[kt][j] : -1e30f; s[kt][j] = sv; mx = fmaxf(mx, sv); }
                mx = fmaxf(mx, __shfl_xor(mx, 16)); mx = fmaxf(mx, __shfl_xor(mx, 32));
                float lsum = 0.f;
#pragma unroll
                for (int kt = 0; kt < 9; ++kt)
#pragma unroll
                    for (int j = 0; j < 4; ++j) { const float pv = __builtin_amdgcn_exp2f((s[kt][j] - mx) * C); s[kt][j] = pv; lsum += pv; }
                lsum += __shfl_xor(lsum, 16); lsum += __shfl_xor(lsum, 32);
                f32x4 o[4];
#pragma unroll
                for (int dt = 0; dt < 4; ++dt) o[dt] = (f32x4){0.f, 0.f, 0.f, 0.f};
#pragma unroll
                for (int cc = 0; cc < 5; ++cc) {
                    asm volatile("s_waitcnt lgkmcnt(0)" ::: "memory");
#pragma unroll
                    for (int it = 0; it < 4; ++it) { const int idx = it * 64 + lane, rr = idx >> 3, c16 = idx & 7;
                        *(LAS u32x4*)(VST + rr * 128 + c16 * 16) = vv[cc][it]; }
                    asm volatile("s_waitcnt lgkmcnt(0)" ::: "memory");
                    bf16x8 pa;
                    { const f32x4 p0 = s[2 * cc]; const unsigned a0 = pk2(p0[0], p0[1]), a1 = pk2(p0[2], p0[3]); unsigned a2 = 0u, a3 = 0u;
                      if (cc < 4) { const f32x4 p1 = s[2 * cc + 1 < 9 ? 2 * cc + 1 : 8]; a2 = pk2(p1[0], p1[1]); a3 = pk2(p1[2], p1[3]); }
                      const u32x4 pw = {a0, a1, a2, a3}; pa = __builtin_bit_cast(bf16x8, pw); }
#pragma unroll
                    for (int dt = 0; dt < 4; ++dt) {
                        LAS unsigned char* ap = VST + (quad * 4 + (li >> 2)) * 128 + (dt * 16 + (li & 3) * 4) * 2;
                        const s16x4 b1 = __builtin_bit_cast(s16x4, __builtin_amdgcn_ds_read_tr16_b64_v4i16((LAS s16x4*)ap));
                        const s16x4 b2 = __builtin_bit_cast(s16x4, __builtin_amdgcn_ds_read_tr16_b64_v4i16((LAS s16x4*)(ap + 16 * 128)));
                        const bf16x8 vb = {b1[0], b1[1], b1[2], b1[3], b2[0], b2[1], b2[2], b2[3]};
                        o[dt] = __builtin_amdgcn_mfma_f32_16x16x32_bf16(pa, vb, o[dt], 0, 0, 0);
                    }
                }
#pragma unroll
                for (int j = 0; j < 4; ++j) {
                    const int qq = quad * 4 + j;
                    const float mr = __shfl(mx, qq), lr = __shfl(lsum, qq);
                    const int tl = (br == 0) ? tu * 16 + qq : (br == 1) ? ((((tu >> 2) * 16 + qq) << 2) + (tu & 3)) : qq * 16 + tu;
                    LAS float* arow = ACC + tl * 68;
                    if (br == 0) {
#pragma unroll
                        for (int dt = 0; dt < 4; ++dt) arow[dt * 16 + li] = o[dt][j];
                        if (li == 0) { ML[tl * 2] = mr; ML[tl * 2 + 1] = lr; }
                    } else {
                        const float m0 = ML[tl * 2], l0 = ML[tl * 2 + 1];
                        const float mn = fmaxf(m0, mr); const float a0 = __builtin_amdgcn_exp2f((m0 - mn) * C), a1 = __builtin_amdgcn_exp2f((mr - mn) * C);
                        const float ln = l0 * a0 + lr * a1;
                        float val[4];
#pragma unroll
                        for (int dt = 0; dt < 4; ++dt) val[dt] = arow[dt * 16 + li] * a0 + o[dt][j] * a1;
                        asm volatile("s_waitcnt lgkmcnt(0)" ::: "memory");
                        if (br == 1) {
#pragma unroll
                            for (int dt = 0; dt < 4; ++dt) arow[dt * 16 + li] = val[dt];
                            if (li == 0) { ML[tl * 2] = mn; ML[tl * 2 + 1] = ln; }
                        } else {
                            const float inv = 1.0f / ln; bf16* orow = MIX + (rowbase + t0 + tl) * DM + h * 64 + li;
#pragma unroll
                            for (int dt = 0; dt < 4; ++dt) orow[dt * 16] = (bf16)f2bf(val[dt] * inv);
                        }
                    }
                }
            }
            __syncthreads();
        }
    }
}

constexpr int TC = 32, NCH = SEQ / TC;
constexpr int SB_STRIDE = 49152, SC_RS = 0, SC_WW = 8192, SC_KS = 16384, SC_KK = 24576, SC_BV = 32768, SC_VS = 40960;
constexpr int ACT_PITCH = 400, SC_ACT = 2 * SB_STRIDE, SC_LTS = SC_ACT + 4 * 8 * ACT_PITCH, SC_MU = SC_LTS + 64 * ACT_PITCH, SC_INV = SC_MU + 1536, SC_CT = SC_INV + 128;
static_assert(SC_CT + 1536 <= LDS_BYTES, "scan LDS map");
__device__ __forceinline__ float rowsum8(float v) { v += dppf(v, 0); v += dppf(v, 1); v += dppf(v, 2); return v; }
struct ScanVec { f32x4 w0, w1, k0, k1, b0, b1, x0, x1, r0, r1; float v; };
__device__ __forceinline__ ScanVec scan_load(LAS const unsigned char* buf, int t, int j0, int irow) {
    ScanVec s; const LAS float* W = (const LAS float*)(buf + SC_WW) + t * 64 + j0; const LAS float* K = (const LAS float*)(buf + SC_KK) + t * 64 + j0; const LAS float* B = (const LAS float*)(buf + SC_BV) + t * 64 + j0;
    const LAS float* X = (const LAS float*)(buf + SC_KS) + t * 64 + j0; const LAS float* R = (const LAS float*)(buf + SC_RS) + t * 64 + j0;
    s.w0 = *(const LAS f32x4*)W; s.w1 = *(const LAS f32x4*)(W + 4); s.k0 = *(const LAS f32x4*)K; s.k1 = *(const LAS f32x4*)(K + 4); s.b0 = *(const LAS f32x4*)B; s.b1 = *(const LAS f32x4*)(B + 4);
    s.x0 = *(const LAS f32x4*)X; s.x1 = *(const LAS f32x4*)(X + 4); s.r0 = *(const LAS f32x4*)R; s.r1 = *(const LAS f32x4*)(R + 4); s.v = ((const LAS float*)(buf + SC_VS))[t * 64 + irow];
    return s;
}
__device__ __forceinline__ void scan_unit(LAS unsigned char* lds, const Params& p, int layer, int unit, int tid, int wave, int lane) {
    const int chain = unit >> 1, hf = unit & 1, b = chain >> 3, h = chain & 7;
    unsigned char* ws = p.ws;
    const bf16* Z = (const bf16*)(ws + WS_Z); bf16* VF = (bf16*)(ws + WS_VF); bf16* YS = (bf16*)(ws + WS_YS); bf16* GB = (bf16*)(ws + WS_G); bf16* VC = (bf16*)(ws + WS_VC); float* BON = (float*)(ws + WS_BON);
    const bf16* LT = (const bf16*)(ws + WS_LT) + (size_t)layer * 512 * 192;
    const float* mu = p.in[7] + (size_t)layer * 1696; const float* mumv = (layer > 0) ? p.in[8] + (size_t)(layer - 1) * 32 : nullptr;
    const size_t rowbase = (size_t)b * SEQ;
    LAS float* MU = (LAS float*)(lds + SC_MU); LAS unsigned char* LTS = lds + SC_LTS;
    if (tid < 96) { const int cgp = tid, cat = cgp >> 4; const int zc = (cat < 3) ? ZR + cat * 512 + h * 64 + (cgp & 15) * 4 : ZXW + (cgp - 48) * 4;
        const bool ismv = zc >= ZMV; const float* src = ismv ? (mumv ? mumv + (zc - ZMV) : mu) : mu + (zc - ZR);
        f32x4 m4 = *(const f32x4*)src; if (ismv && !mumv) m4 = (f32x4){0.f, 0.f, 0.f, 0.f};
        *(LAS f32x4*)(MU + cgp * 4) = m4; }
    if (tid < 384) { const int arr = tid >> 6, c = tid & 63, gi = layer * 512 + h * 64 + c; float v;
        if (arr == 0) v = p.in[10][gi]; else if (arr == 1) v = p.in[12][gi]; else if (arr == 2) v = (layer > 0) ? p.in[14][(layer - 1) * 512 + h * 64 + c] : 0.f; else if (arr == 3) v = p.in[17][gi]; else if (arr == 4) v = p.in[18][gi]; else v = p.in[19][gi];
        ((LAS float*)(lds + SC_CT))[tid] = v; }
    for (int i = tid; i < 64 * 24; i += 512) { const int c = i / 24, ch = i % 24; *(LAS u32x4*)(LTS + c * ACT_PITCH + ch * 16) = *(const u32x4*)(LT + (size_t)(h * 64 + c) * 192 + ch * 8); }
    __syncthreads();
    if (wave < 4) {
        const int rl = wave * 8 + (lane >> 3), irow = hf * 32 + rl, q = lane & 7, j0 = q * 8;
        float S[8] = {0.f, 0.f, 0.f, 0.f, 0.f, 0.f, 0.f, 0.f}; float ykeep = 0.f;
        __syncthreads();
#pragma unroll 1
        for (int c = 0; c < NCH; ++c) {
            LAS const unsigned char* buf = lds + (c & 1) * SB_STRIDE;
            const int tch = c * TC;
            ScanVec cur = scan_load(buf, 0, j0, irow);
#pragma unroll 8
            for (int t = 0; t < TC; ++t) {
                const ScanVec nx = scan_load(buf, (t + 1 < TC) ? t + 1 : t, j0, irow);
                float sa = ((S[0] * cur.k0.x + S[1] * cur.k0.y) + (S[2] * cur.k0.z + S[3] * cur.k0.w)) + ((S[4] * cur.k1.x + S[5] * cur.k1.y) + (S[6] * cur.k1.z + S[7] * cur.k1.w));
                sa = rowsum8(sa);
                const float v = cur.v;
                S[0] = S[0] * cur.w0.x + (v * cur.x0.x - sa * cur.b0.x); S[1] = S[1] * cur.w0.y + (v * cur.x0.y - sa * cur.b0.y); S[2] = S[2] * cur.w0.z + (v * cur.x0.z - sa * cur.b0.z); S[3] = S[3] * cur.w0.w + (v * cur.x0.w - sa * cur.b0.w);
                S[4] = S[4] * cur.w1.x + (v * cur.x1.x - sa * cur.b1.x); S[5] = S[5] * cur.w1.y + (v * cur.x1.y - sa * cur.b1.y); S[6] = S[6] * cur.w1.z + (v * cur.x1.z - sa * cur.b1.z); S[7] = S[7] * cur.w1.w + (v * cur.x1.w - sa * cur.b1.w);
                float y = ((S[0] * cur.r0.x + S[1] * cur.r0.y) + (S[2] * cur.r0.z + S[3] * cur.r0.w)) + ((S[4] * cur.r1.x + S[5] * cur.r1.y) + (S[6] * cur.r1.z + S[7] * cur.r1.w));
                y = rowsum8(y);
                ykeep = (q == (t & 7)) ? y : ykeep;
                if ((t & 7) == 7) YS[(rowbase + tch + (t & ~7) + q) * 512 + h * 64 + irow] = (bf16)f2bf(ykeep);
                cur = nx;
            }
            __syncthreads();
        }
    } else {
        const int pw = wave - 4, s = lane >> 3, q = lane & 7, li = lane & 15, quad = lane >> 4;
        LAS unsigned char* ACT = lds + SC_ACT + pw * 8 * ACT_PITCH; LAS float* INV = (LAS float*)(lds + SC_INV) + pw * 8;
        const LAS float* CT = (const LAS float*)(lds + SC_CT);
        u32x2 pc[12], pp[12]; u32x4 pvf[2];
        pvf[0] = (u32x4){0u, 0u, 0u, 0u}; pvf[1] = pvf[0];
#define PR_OFF(k) ((k) < 2 ? (ZR - ZKR) + (k) * 32 : (k) < 4 ? ((k) - 2) * 32 : (k) < 6 ? (ZVR - ZKR) + ((k) - 4) * 32 : ((k) - 6) * 32)
#define PR_ISSUE(tchv) do { const int tg = (tchv) + pw * 8 + s; const int tgp = tg > 0 ? tg - 1 : 0; \
        const bf16* c1 = Z + (rowbase + tg) * NZ + ZKR + h * 64 + q * 4; const bf16* c2 = Z + (rowbase + tg) * NZ + ZXW + q * 4; \
        const bf16* p1 = Z + (rowbase + tgp) * NZ + ZKR + h * 64 + q * 4; const bf16* p2 = Z + (rowbase + tgp) * NZ + ZXW + q * 4; \
        asm volatile("" : "+v"(c1), "+v"(c2), "+v"(p1), "+v"(p2)); \
        _Pragma("unroll") for (int k = 0; k < 12; ++k) { pc[k] = *(const u32x2*)((k < 6 ? c1 : c2) + PR_OFF(k)); pp[k] = *(const u32x2*)((k < 6 ? p1 : p2) + PR_OFF(k)); } \
        if (layer > 0) { pvf[0] = *(const u32x4*)(VF + (rowbase + (tchv) + pw * 8 + s) * 512 + h * 64 + q * 8); } } while (0)
        PR_ISSUE(0);
#pragma unroll 1
        for (int c = 0; c <= NCH; ++c) {
            if (c < NCH) {
                const int tch = c * TC;
                LAS unsigned char* buf = lds + (c & 1) * SB_STRIDE;
                LAS float* RS = (LAS float*)(buf + SC_RS); LAS float* WW = (LAS float*)(buf + SC_WW); LAS float* KS = (LAS float*)(buf + SC_KS); LAS float* KK = (LAS float*)(buf + SC_KK);
                LAS float* BV = (LAS float*)(buf + SC_BV); LAS float* VS = (LAS float*)(buf + SC_VS);
                const u32x4 cvf0 = pvf[0];
                const float pz = (tch + pw * 8 + s > 0) ? 1.0f : 0.0f;
                const int trow = pw * 8 + s;
#pragma unroll
                for (int k = 0; k < 12; ++k) {
                    const u32x2 cw = pc[k], pw2 = pp[k];
                    const f32x4 m4 = *(const LAS f32x4*)(MU + (k * 8 + q) * 4);
                    const float c0 = bflo(cw.x), c1 = bfhi(cw.x), c2 = bflo(cw.y), c3 = bfhi(cw.y), p0 = bflo(pw2.x) * pz, p1 = bfhi(pw2.x) * pz, p2 = bflo(pw2.y) * pz, p3 = bfhi(pw2.y) * pz;
                    f32x4 v = {c0 + (p0 - c0) * m4.x, c1 + (p1 - c1) * m4.y, c2 + (p2 - c2) * m4.z, c3 + (p3 - c3) * m4.w};
                    if (k < 2) *(LAS f32x4*)(RS + trow * 64 + (k * 8 + q) * 4) = v;
                    else if (k < 4) *(LAS f32x4*)(KS + trow * 64 + ((k - 2) * 8 + q) * 4) = v;
                    else if (k < 6) *(LAS f32x4*)(VS + trow * 64 + ((k - 4) * 8 + q) * 4) = v;
                    else {
                        const int ac = ((k - 6) * 8 + q) * 4;
                        if (k == 6) {
#pragma unroll
                            for (int e = 0; e < 4; ++e) v[e] = 1.0f - 2.0f * __builtin_amdgcn_rcpf(1.0f + __expf(2.0f * v[e])); }
                        else if (k >= 8 && k <= 10) {
#pragma unroll
                            for (int e = 0; e < 4; ++e) v[e] = __builtin_amdgcn_rcpf(1.0f + __expf(-v[e])); }
                        u32x2 w; w.x = pk2(v.x, v.y); w.y = pk2(v.z, v.w); *(LAS u32x2*)(ACT + s * ACT_PITCH + ac * 2) = w; }
                }
                if (c + 1 < NCH) PR_ISSUE(tch + TC);
                asm volatile("s_waitcnt lgkmcnt(0)" ::: "memory");
                { const f32x4 ka = *(const LAS f32x4*)(KS + trow * 64 + q * 8), kb = *(const LAS f32x4*)(KS + trow * 64 + q * 8 + 4); const f32x4 kc0 = *(const LAS f32x4*)(CT + 3 * 64 + q * 8), kc1 = *(const LAS f32x4*)(CT + 3 * 64 + q * 8 + 4); const float kkl[8] = {kc0.x, kc0.y, kc0.z, kc0.w, kc1.x, kc1.y, kc1.z, kc1.w};
                  float ss = ((ka.x * kkl[0]) * (ka.x * kkl[0]) + (ka.y * kkl[1]) * (ka.y * kkl[1])) + ((ka.z * kkl[2]) * (ka.z * kkl[2]) + (ka.w * kkl[3]) * (ka.w * kkl[3]));
                  ss += ((kb.x * kkl[4]) * (kb.x * kkl[4]) + (kb.y * kkl[5]) * (kb.y * kkl[5])) + ((kb.z * kkl[6]) * (kb.z * kkl[6]) + (kb.w * kkl[7]) * (kb.w * kkl[7]));
                  ss = rowsum8(ss);
                  if (q == 0) INV[s] = 1.0f / fmaxf(sqrtf(ss), 1e-12f); }
                asm volatile("s_waitcnt lgkmcnt(0)" ::: "memory");
                {
                    bf16x8 Af[6];
#pragma unroll
                    for (int ks = 0; ks < 6; ++ks) Af[ks] = *(const LAS bf16x8*)(ACT + (li & 7) * ACT_PITCH + ks * 64 + quad * 16);
                    asm volatile("s_waitcnt lgkmcnt(0)" ::: "memory");
                    LAS float* GT = (LAS float*)ACT;
                    const int lbase = (pw * 8 + (quad & 1) * 4) * 64 + li;
#pragma unroll
                    for (int ct = 0; ct < 4; ++ct) {
                        bf16x8 Bf[6];
#pragma unroll
                        for (int ks = 0; ks < 6; ++ks) Bf[ks] = *(const LAS bf16x8*)(LTS + (ct * 16 + li) * ACT_PITCH + ks * 64 + quad * 16);
                        const f32x4 z4 = {0.f, 0.f, 0.f, 0.f};
                        const f32x4 LW = __builtin_amdgcn_mfma_f32_16x16x32_bf16(Af[0], Bf[0], z4, 0, 0, 0);
                        const f32x4 AA = __builtin_amdgcn_mfma_f32_16x16x32_bf16(Af[1], Bf[1], z4, 0, 0, 0);
                        f32x4 G = __builtin_amdgcn_mfma_f32_16x16x32_bf16(Af[2], Bf[2], z4, 0, 0, 0);
                        G = __builtin_amdgcn_mfma_f32_16x16x32_bf16(Af[3], Bf[3], G, 0, 0, 0);
                        G = __builtin_amdgcn_mfma_f32_16x16x32_bf16(Af[4], Bf[4], G, 0, 0, 0);
                        const f32x4 VG = __builtin_amdgcn_mfma_f32_16x16x32_bf16(Af[5], Bf[5], z4, 0, 0, 0);
                        if (quad < 2) {
#pragma unroll
                            for (int j = 0; j < 4; ++j) { const int lo = lbase + j * 64 + ct * 16; WW[lo] = LW[j]; KK[lo] = AA[j]; BV[lo] = VG[j]; GT[((quad & 1) * 4 + j) * 64 + ct * 16 + li] = G[j]; }
                        }
                    }
                }
                asm volatile("s_waitcnt lgkmcnt(0)" ::: "memory");
                {
                    const LAS float* GT = (const LAS float*)ACT;
                    const int lo8 = trow * 64 + q * 8; const size_t go8 = (rowbase + tch + trow) * 512 + h * 64 + q * 8;
                    float r[8], k[8], v[8], lw[8], aa[8], vg[8], g[8], c_w0[8], c_a0[8], c_v0[8], c_kk[8], c_ka[8], c_rk[8];
#define LD8(dst, ptr) do { const f32x4 _a = *(const LAS f32x4*)(ptr), _b = *(const LAS f32x4*)((ptr) + 4); dst[0] = _a.x; dst[1] = _a.y; dst[2] = _a.z; dst[3] = _a.w; dst[4] = _b.x; dst[5] = _b.y; dst[6] = _b.z; dst[7] = _b.w; } while (0)
                    LD8(r, RS + lo8); LD8(k, KS + lo8); LD8(v, VS + lo8); LD8(lw, WW + lo8); LD8(aa, KK + lo8); LD8(vg, BV + lo8); LD8(g, GT + s * 64 + q * 8);
                    LD8(c_w0, CT + q * 8); LD8(c_a0, CT + 64 + q * 8); LD8(c_v0, CT + 128 + q * 8); LD8(c_kk, CT + 192 + q * 8); LD8(c_ka, CT + 256 + q * 8); LD8(c_rk, CT + 320 + q * 8);
                    const float invn = INV[s];
                    float vf[8];
                    { const u32x4 cv = cvf0; vf[0] = bflo(cv.x); vf[1] = bfhi(cv.x); vf[2] = bflo(cv.y); vf[3] = bfhi(cv.y); vf[4] = bflo(cv.z); vf[5] = bfhi(cv.z); vf[6] = bflo(cv.w); vf[7] = bfhi(cv.w); }
                    float ow[8], okm[8], okk[8], obv[8]; float bp = 0.f;
#pragma unroll
                    for (int e = 0; e < 8; ++e) {
                        const float sg = __builtin_amdgcn_rcpf(1.0f + __expf(-(c_w0[e] + lw[e])));
                        ow[e] = __expf(-0.6065306597126334f * sg);
                        const float a = __builtin_amdgcn_rcpf(1.0f + __expf(-(c_a0[e] + aa[e])));
                        okk[e] = k[e] * c_kk[e] * invn; okm[e] = k[e] * (1.0f + (a - 1.0f) * c_ka[e]); obv[e] = okk[e] * a;
                        if (layer > 0) { const float vgs = __builtin_amdgcn_rcpf(1.0f + __expf(-(c_v0[e] + vg[e]))); v[e] = v[e] + (vf[e] - v[e]) * vgs; }
                        bp += r[e] * okm[e] * c_rk[e];
                    }
#define ST8(ptr, src) do { *(LAS f32x4*)(ptr) = (f32x4){src[0], src[1], src[2], src[3]}; *(LAS f32x4*)((ptr) + 4) = (f32x4){src[4], src[5], src[6], src[7]}; } while (0)
                    ST8(WW + lo8, ow); ST8(KS + lo8, okm); ST8(KK + lo8, okk); ST8(BV + lo8, obv); ST8(VS + lo8, v);
                    bp = rowsum8(bp);
                    if (hf == 0) {
                        u32x4 gv, vv; gv.x = pk2(g[0], g[1]); gv.y = pk2(g[2], g[3]); gv.z = pk2(g[4], g[5]); gv.w = pk2(g[6], g[7]);
                        vv.x = pk2(v[0], v[1]); vv.y = pk2(v[2], v[3]); vv.z = pk2(v[4], v[5]); vv.w = pk2(v[6], v[7]);
                        *(u32x4*)(GB + go8) = gv; *(u32x4*)(VC + go8) = vv; if (layer == 0) *(u32x4*)(VF + go8) = vv;
                        if (q == 0) BON[(rowbase + tch + trow) * 8 + h] = bp;
                    }
                }
            }
            __syncthreads();
        }
    }
}

#ifdef MK_ATTN_TWICE
#define ATTN_CALL2 attn_unit(lds, Zb, XN, u - 128, wave, lane)
#else
#define ATTN_CALL2
#endif
#ifndef MK_NO_SCAN
#define SCAN_CALL scan_unit(lds, p, l, u, tid, wave, lane)
#else
#define SCAN_CALL
#endif
#ifndef MK_NO_ATTN
#define ATTN_CALL attn_unit(lds, Zb, XN, u - 128, wave, lane)
#else
#define ATTN_CALL
#endif
__global__ void __launch_bounds__(512, 2) mk_fwd(Params p) {
    extern __shared__ __attribute__((aligned(16))) unsigned char lds_raw[];
    LAS unsigned char* lds = (LAS unsigned char*)lds_raw;
    cg::grid_group grid = cg::this_grid();
    const int G = gridDim.x, NGW = G * 8;
    const int wave_s = __builtin_amdgcn_readfirstlane(threadIdx.x >> 6);
    unsigned char* ws = p.ws;
    bf16* XN = (bf16*)(ws + WS_XN); bf16* Zb = (bf16*)(ws + WS_Z); bf16* Hb = (bf16*)(ws + WS_H); bf16* Y1 = (bf16*)(ws + WS_Y1);
    int ph = 0;
#define PH_ON (ph >= p.ph_lo && ph < p.ph_hi)
#define PH_END do { if (ph + 1 < p.ph_hi) grid.sync(); } while (0)
    if (PH_ON) { MK_IDS; prologue(p, lds, gw, NGW, wave, lane); PH_END; } ++ph;
#pragma unroll 1
    for (int l = 0; l < DEPTH; ++l) {
        if (PH_ON) { pg8::Gemm g{XN, (const bf16*)(ws + WS_WIN) + (size_t)l * NZ * 1024, NT, NZ, 1024}; pg8::StaticOrder S; S.init(NT, NZ, G, (int)blockIdx.x);
            pg8::EpiAct<0> E{Zb, NZ}; pg8::gemm_phase<pg8::EpiAct<0>, pg8::StaticOrder, true, true>(lds, g, S, E, wave_s); PH_END; } ++ph;
        if (PH_ON) { MK_IDS;
            for (int u = blockIdx.x; u < 128; u += G) { SCAN_CALL; __syncthreads(); }
            for (int u = (blockIdx.x >= 128 ? blockIdx.x : blockIdx.x + ((127 - blockIdx.x) / G + 1) * G); u < 256; u += G) { ATTN_CALL; __syncthreads(); ATTN_CALL2; __syncthreads(); }
            PH_END; } ++ph;
        if (PH_ON) { MK_IDS; post_phase(XN, (const bf16*)(ws + WS_YS), (const bf16*)(ws + WS_G), (const bf16*)(ws + WS_VC), (const float*)(ws + WS_BON), p.in[9] + l * 512, p.in[20] + l * 512, p.in[21] + l * 512, gw, NGW, lane); PH_END; } ++ph;
        if (PH_ON) { pg8::Gemm g{XN, (const bf16*)(ws + WS_WOUT) + (size_t)l * 1024 * 1024, NT, 1024, 1024}; pg8::StaticOrder S; S.init(NT, 1024, G, (int)blockIdx.x);
            pg8::EpiAct<0> E{Y1, 1024}; pg8::gemm_phase<pg8::EpiAct<0>, pg8::StaticOrder, true, true>(lds, g, S, E, wave_s); PH_END; } ++ph;
        if (PH_ON) { MK_IDS; norm_phase(Y1, p.out, XN, p.in[2] + l * 1024, p.in[3] + l * 1024, gw, NGW, lane); PH_END; } ++ph;
        if (PH_ON) { pg8::Gemm g{XN, (const bf16*)(ws + WS_WUP) + (size_t)l * 4096 * 1024, NT, DFF, 1024}; pg8::StaticOrder S; S.init(NT, DFF, G, (int)blockIdx.x);
            pg8::EpiAct<1> E{Hb, DFF}; pg8::gemm_phase<pg8::EpiAct<1>, pg8::StaticOrder, true, true>(lds, g, S, E, wave_s); PH_END; } ++ph;
        if (PH_ON) { pg8::Gemm g{Hb, (const bf16*)(ws + WS_WDN) + (size_t)l * 1024 * 4096, NT, 1024, DFF}; pg8::StaticOrder S; S.init(NT, 1024, G, (int)blockIdx.x);
            pg8::EpiAct<0> E{XN, 1024}; pg8::gemm_phase<pg8::EpiAct<0>, pg8::StaticOrder, true, true>(lds, g, S, E, wave_s); PH_END; } ++ph;
        if (PH_ON) { MK_IDS; norm_phase(XN, p.out, XN, p.in[4] + l * 1024, (l + 1 < DEPTH) ? p.in[1] + (l + 1) * 1024 : nullptr, gw, NGW, lane); PH_END; } ++ph;
    }
}
constexpr int N_PHASES = 1 + 8 * DEPTH;

extern "C" void kernel_launch(void* const* d_in, const int* in_sizes, int n_in, void* d_out, int out_size, void* d_ws, size_t ws_size, hipStream_t stream) {
    static int grid = 0;
    if (grid == 0) {
        if (n_in != 25 || out_size != NT * DM || ws_size < WS_END) { fprintf(stderr, "kernel_launch: unexpected sizes n_in=%d out=%d ws=%zu\n", n_in, out_size, ws_size); grid = -1; return; }
        int dev = 0, cus = 0, per_cu = 0;
        hipGetDevice(&dev); hipDeviceGetAttribute(&cus, hipDeviceAttributeMultiprocessorCount, dev);
        if (hipFuncSetAttribute((const void*)mk_fwd, hipFuncAttributeMaxDynamicSharedMemorySize, LDS_BYTES) != hipSuccess) { fprintf(stderr, "kernel_launch: hipFuncSetAttribute failed\n"); grid = -1; return; }
        if (hipOccupancyMaxActiveBlocksPerMultiprocessor(&per_cu, (const void*)mk_fwd, 512, LDS_BYTES) != hipSuccess || per_cu < 1) { fprintf(stderr, "kernel_launch: occupancy query gave %d\n", per_cu); per_cu = 1; }
        (void)hipGetLastError();
        grid = cus * per_cu;
        fprintf(stderr, "kernel_launch: grid %d (cus %d x %d)\n", grid, cus, per_cu);
    }
    if (grid < 0) return;
    Params p{};
    for (int i = 0; i < 25; ++i) p.in[i] = (const float*)d_in[i];
    p.out = (float*)d_out; p.ws = (unsigned char*)d_ws;
#if MK_MULTI
    for (int ph = 0; ph < N_PHASES; ++ph) { p.ph_lo = ph; p.ph_hi = ph + 1; hipLaunchKernelGGL(mk_fwd, dim3(grid), dim3(512), LDS_BYTES, stream, p); }
#else
    p.ph_lo = 0; p.ph_hi = N_PHASES;
    void* args[] = {&p};
    hipError_t e = hipLaunchCooperativeKernel((const void*)mk_fwd, dim3(grid), dim3(512), args, LDS_BYTES, stream);
    if (e != hipSuccess) fprintf(stderr, "kernel_launch: cooperative launch failed: %s (grid %d)\n", hipGetErrorString(e), grid);
#endif
}
```

```cpp
#include <hip/hip_runtime.h>
#include <hip/hip_cooperative_groups.h>
#include <cstdio>
#include <cstdint>
namespace cg = cooperative_groups;
#ifndef MK_MULTI
#define MK_MULTI 0
#endif
namespace pg8 {
#define PG8_LAS __attribute__((address_space(3)))
typedef unsigned short bf16_t;
typedef short bf16x8 __attribute__((ext_vector_type(8)));
typedef float f32x4 __attribute__((ext_vector_type(4)));
typedef unsigned u32x4 __attribute__((ext_vector_type(4)));
constexpr int BM = 256, BK = 64, HALF = 128, HTB = HALF * BK * 2  , STAGE_BYTES = 8 * HTB, NXCD = 8, WGM = 8;

__host__ __device__ __forceinline__ int lds_byte(int r, int c) { const int st = (r >> 4) * 2 + (c >> 5), rr = r & 15, cc = c & 31, ob = rr * 64 + cc * 2; return st * 1024 + (ob ^ (((ob >> 9) & 1) << 5)); }
__host__ __device__ __forceinline__ void stage_rc(int b, int& R, int& C) { const int st = b / 1024, sb = b % 1024, swz = sb ^ (((sb >> 9) & 1) << 5); R = (st >> 1) * 16 + swz / 64; C = (st & 1) * 32 + (swz % 64) / 2; }
__host__ __device__ __forceinline__ int perm32(int rho) { const int n = rho >> 4, i = rho & 15; return 8 * (i >> 2) + 4 * n + (i & 3); }

struct Unit { int pm, pn; };
struct Gemm { const bf16_t* A; const bf16_t* Bt; int M, N, K; };
struct StaticOrder {
    int nM, nN, nwg, G, c;
    __host__ __device__ void init(int M, int N, int G_, int c_) { nM = M / BM; nN = N / BM; nwg = nM * nN; G = G_; c = c_; }
    __host__ __device__ bool next(int i, Unit& u) const {
        const long L = (long)i * G + c; if (L >= nwg) return false;
        int wgid = (int)L; { const int q = nwg / NXCD, r = nwg % NXCD, xcd = wgid % NXCD, off = wgid / NXCD; wgid = (xcd < r ? xcd * (q + 1) : r * (q + 1) + (xcd - r) * q) + off; }
        const int nig = WGM * nN, gid = wgid / nig, fm = gid * WGM, gsz = (nM - fm) < WGM ? (nM - fm) : WGM;
        u.pm = fm + ((wgid % nig) % gsz); u.pn = (wgid % nig) / gsz; return true;
    }
    __device__ __forceinline__ void a_ready(const Unit&) const {}
    __device__ __forceinline__ void done(const Unit&) const {}
};
__device__ __forceinline__ unsigned cvt_pk_bf16(float lo, float hi) { unsigned r; asm volatile("v_cvt_pk_bf16_f32 %0, %1, %2" : "=v"(r) : "v"(lo), "v"(hi)); return r; }
typedef float f32x2 __attribute__((ext_vector_type(2)));
__device__ __forceinline__ int mk_tid(const int w) { unsigned m = ~0u; asm volatile("" : "+s"(m)); const int l = __builtin_amdgcn_mbcnt_hi(m, __builtin_amdgcn_mbcnt_lo(m, 0u)); int t = w * 64 + l; asm volatile("" : "+v"(t)); return t; }
template <int ACT> struct EpiAct {
    static constexpr bool PERM = true, AFTER_DRAIN = false;
    bf16_t* O; int ldc;
    __device__ __forceinline__ void operator()(const f32x4 (&acc)[2][2][4][2], const Unit& u, int wr, int wc, int fr, int fq) const {
        const int row0 = u.pm * BM + wr * 64 + fr; const int col0 = u.pn * BM + wc * 32 + 8 * fq;
#pragma unroll
        for (int ai = 0; ai < 2; ++ai)
#pragma unroll
            for (int m = 0; m < 4; ++m) { bf16_t* rowp = O + (size_t)(row0 + ai * HALF + m * 16) * ldc + col0;
#pragma unroll
                for (int bj = 0; bj < 2; ++bj) { f32x4 v0 = acc[ai][bj][m][0], v1 = acc[ai][bj][m][1];
                    if (ACT == 1) {
#pragma unroll
                        for (int e = 0; e < 4; ++e) { float a = v0[e] > 0.f ? v0[e] : 0.f, b = v1[e] > 0.f ? v1[e] : 0.f; v0[e] = a * a; v1[e] = b * b; } }
                    u32x4 w; w.x = cvt_pk_bf16(v0[0], v0[1]); w.y = cvt_pk_bf16(v0[2], v0[3]); w.z = cvt_pk_bf16(v1[0], v1[1]); w.w = cvt_pk_bf16(v1[2], v1[3]);
                    *(u32x4*)(rowp + bj * HALF) = w; } }
    }
};
template <class Epi, class Sched, bool ALIGN_EPI = false, bool SP2 = false>
__device__ __forceinline__ void gemm_phase(PG8_LAS unsigned char* lds, const Gemm g, const Sched& S, const Epi& E, const int wave_s) {
    const int tid = mk_tid(wave_s), wid = __builtin_amdgcn_readfirstlane(tid >> 6), lane = tid & 63, wr = wid >> 2, wc = wid & 3, fr = lane & 15, fq = lane >> 4;
    const int K = g.K, nt = K / BK;
    unsigned voffA[2], voffB[2];
#pragma unroll
    for (int i = 0; i < 2; ++i) { int R, C; stage_rc(tid * 16 + i * 8192, R, C); const int Rb = Epi::PERM ? ((R & ~31) + perm32(R & 31)) : R;
        voffA[i] = (unsigned)(R * K + C) * 2u; voffB[i] = (unsigned)(Rb * K + C) * 2u; }
    const size_t kstep = (size_t)(BK * 2);
    const size_t hstep = (size_t)HALF * K * 2;
    const size_t tstep = 2 * hstep;
    const unsigned ldsw = (unsigned)wid * 1024u;
    const int aoff = lds_byte(wr * 64 + fr, fq * 8), boff = lds_byte(wc * 32 + fr, fq * 8);
#define PG8_SA(b, h) (((b) * 2 + (h)) * HTB)
#define PG8_SB(b, h) ((4 + (b) * 2 + (h)) * HTB)
#define PG8_STAGE(bufoff, gbase, voff) do { _Pragma("unroll") for (int _i = 0; _i < 2; ++_i) \
        __builtin_amdgcn_global_load_lds((const unsigned*)((const char*)(gbase) + (voff)[_i]), (PG8_LAS unsigned*)(lds + (bufoff) + ldsw + _i * 8192), 16, 0, 0); } while (0)
#define PG8_LDA(dst, b, h) do { _Pragma("unroll") for (int m = 0; m < 4; ++m) _Pragma("unroll") for (int k = 0; k < 2; ++k) dst[m][k] = *(const PG8_LAS bf16x8*)(lds + PG8_SA(b, h) + aoff + m * 2048 + k * 1024); } while (0)
#define PG8_LDB(dst, b, h) do { _Pragma("unroll") for (int n = 0; n < 2; ++n) _Pragma("unroll") for (int k = 0; k < 2; ++k) dst[n][k] = *(const PG8_LAS bf16x8*)(lds + PG8_SB(b, h) + boff + n * 2048 + k * 1024); } while (0)
#define PG8_MMA(ai, bj, At, Bt) do { __builtin_amdgcn_s_setprio(1); _Pragma("unroll") for (int m = 0; m < 4; ++m) _Pragma("unroll") for (int n = 0; n < 2; ++n) _Pragma("unroll") for (int k = 0; k < 2; ++k) \
        acc[ai][bj][m][n] = __builtin_amdgcn_mfma_f32_16x16x32_bf16(Bt[n][k], At[m][k], acc[ai][bj][m][n], 0, 0, 0); __builtin_amdgcn_s_setprio(0); } while (0)
#define PG8_WAIT_V(n) asm volatile("s_waitcnt vmcnt(" #n ")" ::: "memory")
#define PG8_WAIT_L(n) asm volatile("s_waitcnt lgkmcnt(" #n ")" ::: "memory")
#define PG8_BAR __builtin_amdgcn_s_barrier()
#define PG8_SCHED __builtin_amdgcn_sched_barrier(0)
    Unit cur, nxt; int ui = 0;
    if (!S.next(0, cur)) return;
    f32x4 acc[2][2][4][2];
#pragma unroll
    for (int a = 0; a < 2; ++a)
#pragma unroll
        for (int b = 0; b < 2; ++b)
#pragma unroll
            for (int m = 0; m < 4; ++m)
#pragma unroll
                for (int n = 0; n < 2; ++n) acc[a][b][m][n] = (f32x4){0.f, 0.f, 0.f, 0.f};
    bf16x8 At[4][2], B0[2][2], B1[2][2];
    const char* cA = (const char*)g.A + (size_t)cur.pm * tstep; const char* cB = (const char*)g.Bt + (size_t)cur.pn * tstep;
    S.a_ready(cur);
    if constexpr (SP2) {
        PG8_STAGE(PG8_SB(0, 0), cB, voffB); PG8_STAGE(PG8_SB(0, 1), cB + hstep, voffB); PG8_STAGE(PG8_SA(0, 0), cA, voffA); PG8_STAGE(PG8_SA(0, 1), cA + hstep, voffA);
        if (wr == 1) PG8_BAR;
        PG8_WAIT_V(2); PG8_BAR;
        PG8_STAGE(PG8_SB(1, 0), cB + kstep, voffB); PG8_STAGE(PG8_SA(1, 0), cA + kstep, voffA); PG8_STAGE(PG8_SB(1, 1), cB + hstep + kstep, voffB);
        PG8_WAIT_V(6); PG8_BAR;
    } else {
        PG8_STAGE(PG8_SB(0, 0), cB, voffB); PG8_STAGE(PG8_SA(0, 0), cA, voffA); PG8_STAGE(PG8_SB(0, 1), cB + hstep, voffB); PG8_STAGE(PG8_SA(0, 1), cA + hstep, voffA);
        if (wr == 1) PG8_BAR;
        PG8_WAIT_V(4); PG8_BAR;
        PG8_STAGE(PG8_SB(1, 0), cB + kstep, voffB); PG8_STAGE(PG8_SA(1, 0), cA + kstep, voffA); PG8_STAGE(PG8_SB(1, 1), cB + hstep + kstep, voffB);
        PG8_WAIT_V(6); PG8_BAR;
    }
    for (;;) {
        const bool has_next = S.next(ui + 1, nxt);
        const char* nA = has_next ? (const char*)g.A + (size_t)nxt.pm * tstep : cA; const char* nB = has_next ? (const char*)g.Bt + (size_t)nxt.pn * tstep : cB;
        for (int t = 0; t < nt; t += 2) {
            const bool last = (t == nt - 2);
            const char* a1 = cA + (size_t)(t + 1) * kstep;
            const char* a2 = last ? nA : cA + (size_t)(t + 2) * kstep; const char* b2 = last ? nB : cB + (size_t)(t + 2) * kstep;
            const char* a3 = a2 + kstep; const char* b3 = b2 + kstep;
            if (last && has_next) S.a_ready(nxt);
            if constexpr (SP2) {
            PG8_LDB(B0, 0, 0); PG8_LDB(B1, 0, 1); PG8_SCHED; PG8_LDA(At, 0, 0); PG8_STAGE(PG8_SA(1, 1), a1 + hstep, voffA);
            PG8_WAIT_V(8); PG8_WAIT_L(0); PG8_BAR; PG8_MMA(0, 0, At, B0); PG8_MMA(0, 1, At, B1); PG8_BAR; PG8_SCHED;
            PG8_LDA(At, 0, 1); PG8_STAGE(PG8_SB(0, 0), b2, voffB); PG8_STAGE(PG8_SB(0, 1), b2 + hstep, voffB); PG8_STAGE(PG8_SA(0, 0), a2, voffA);
            PG8_WAIT_V(8); PG8_WAIT_L(0); PG8_BAR; PG8_MMA(1, 0, At, B0); PG8_MMA(1, 1, At, B1); PG8_BAR; PG8_SCHED;
            PG8_LDB(B0, 1, 0); PG8_LDB(B1, 1, 1); PG8_SCHED; PG8_LDA(At, 1, 0); PG8_STAGE(PG8_SA(0, 1), a2 + hstep, voffA);
            PG8_WAIT_V(8); PG8_WAIT_L(0); PG8_BAR; PG8_MMA(0, 0, At, B0); PG8_MMA(0, 1, At, B1); PG8_BAR; PG8_SCHED;
            PG8_LDA(At, 1, 1); PG8_STAGE(PG8_SB(1, 0), b3, voffB); PG8_STAGE(PG8_SB(1, 1), b3 + hstep, voffB); PG8_STAGE(PG8_SA(1, 0), a3, voffA);
            PG8_WAIT_V(8); PG8_WAIT_L(0); PG8_BAR; PG8_MMA(1, 0, At, B0); PG8_MMA(1, 1, At, B1); PG8_BAR; PG8_SCHED;
            } else {
            PG8_LDB(B0, 0, 0); PG8_SCHED; PG8_LDA(At, 0, 0); PG8_STAGE(PG8_SA(1, 1), a1 + hstep, voffA);
            PG8_WAIT_L(8); PG8_BAR; PG8_WAIT_L(0); PG8_MMA(0, 0, At, B0); PG8_BAR; PG8_SCHED;
            PG8_LDB(B1, 0, 1); PG8_STAGE(PG8_SB(0, 0), b2, voffB);
            PG8_BAR; PG8_WAIT_L(0); PG8_MMA(0, 1, At, B1); PG8_BAR;
            PG8_LDA(At, 0, 1); PG8_STAGE(PG8_SA(0, 0), a2, voffA);
            PG8_BAR; PG8_WAIT_L(0); PG8_MMA(1, 0, At, B0); PG8_BAR; PG8_SCHED;
            PG8_STAGE(PG8_SB(0, 1), b2 + hstep, voffB);
            PG8_WAIT_V(6); PG8_BAR; PG8_MMA(1, 1, At, B1); PG8_BAR;
            PG8_LDB(B0, 1, 0); PG8_SCHED; PG8_LDA(At, 1, 0); PG8_STAGE(PG8_SA(0, 1), a2 + hstep, voffA);
            PG8_WAIT_L(8); PG8_BAR; PG8_WAIT_L(0); PG8_MMA(0, 0, At, B0); PG8_BAR; PG8_SCHED;
            PG8_LDB(B1, 1, 1); PG8_STAGE(PG8_SB(1, 0), b3, voffB);
            PG8_BAR; PG8_WAIT_L(0); PG8_MMA(0, 1, At, B1); PG8_BAR;
            PG8_LDA(At, 1, 1); PG8_STAGE(PG8_SA(1, 0), a3, voffA);
            PG8_BAR; PG8_WAIT_L(0); PG8_MMA(1, 0, At, B0); PG8_BAR; PG8_SCHED;
            PG8_STAGE(PG8_SB(1, 1), b3 + hstep, voffB);
            PG8_WAIT_V(6); PG8_BAR; PG8_MMA(1, 1, At, B1); PG8_BAR;
            }
        }
        if constexpr (ALIGN_EPI) { if (wr == 0) PG8_BAR; }
        if constexpr (!Epi::AFTER_DRAIN) { E(acc, cur, wr, wc, fr, fq); S.done(cur); }
        if (!has_next) break;
#pragma unroll
        for (int a = 0; a < 2; ++a)
#pragma unroll
            for (int b = 0; b < 2; ++b)
#pragma unroll
                for (int m = 0; m < 4; ++m)
#pragma unroll
                    for (int n = 0; n < 2; ++n) acc[a][b][m][n] = (f32x4){0.f, 0.f, 0.f, 0.f};
        cur = nxt; cA = nA; cB = nB; ++ui;
        if constexpr (ALIGN_EPI) { if (wr == 1) PG8_BAR; }
    }
    PG8_WAIT_V(0);
    if constexpr (!ALIGN_EPI) { if (wr == 0) PG8_BAR; }
    PG8_BAR;
    if constexpr (Epi::AFTER_DRAIN) { E.fused(acc, cur, wr, wc, fr, fq, lds, wid, lane); S.done(cur); }
#undef PG8_SA
#undef PG8_SB
#undef PG8_STAGE
#undef PG8_LDA
#undef PG8_LDB
#undef PG8_MMA
#undef PG8_WAIT_V
#undef PG8_WAIT_L
#undef PG8_BAR
#undef PG8_SCHED
}
}
constexpr int NB = 8, SEQ = 4096, DM = 1024, NT = NB * SEQ, DEPTH = 4, DFF = 4096;
constexpr int NZ = 3328;
constexpr int ZQ = 0, ZK = 512, ZV = 1024, ZR = 1536, ZKR = 2048, ZVR = 2560, ZXW = 3072, ZMV = 3232;
constexpr size_t MiB = 1u << 20;
constexpr size_t WS_WIN = 1 * MiB, WS_WOUT = 27 * MiB, WS_WUP = 35 * MiB, WS_WDN = 67 * MiB, WS_LT = 99 * MiB;
constexpr size_t WS_XN = 100 * MiB, WS_VF = 164 * MiB, WS_BON = 196 * MiB, WS_BIG = 198 * MiB;
constexpr size_t WS_Z = WS_BIG, WS_YS = 406 * MiB, WS_G = 438 * MiB, WS_VC = 470 * MiB, WS_H = WS_BIG, WS_Y1 = WS_BIG, WS_END = 502 * MiB;
constexpr int LDS_BYTES = 147456;

#define LAS __attribute__((address_space(3)))
typedef unsigned short bf16;
typedef float f32x4 __attribute__((ext_vector_type(4)));
typedef unsigned u32x4 __attribute__((ext_vector_type(4)));
typedef unsigned u32x2 __attribute__((ext_vector_type(2)));
typedef short bf16x8 __attribute__((ext_vector_type(8)));
typedef short s16x4 __attribute__((ext_vector_type(4)));

__device__ __forceinline__ float bf2f(unsigned u) { return __uint_as_float(u << 16); }
__device__ __forceinline__ float bflo(unsigned u) { return __uint_as_float(u << 16); }
__device__ __forceinline__ float bfhi(unsigned u) { return __uint_as_float(u & 0xffff0000u); }
__device__ __forceinline__ unsigned f2bf(float f) { unsigned u = __float_as_uint(f); return (u + 0x7fffu + ((u >> 16) & 1u)) >> 16; }
__device__ __forceinline__ unsigned pk2(float lo, float hi) { return f2bf(lo) | (f2bf(hi) << 16); }
__device__ __forceinline__ float wave_sum(float v) {
#pragma unroll
    for (int o = 1; o < 64; o <<= 1) v += __shfl_xor(v, o);
    return v;
}
__device__ __forceinline__ float dppf(float v, const int ctrl_sel) {
    int r;
    if (ctrl_sel == 0) r = __builtin_amdgcn_update_dpp(0, __float_as_int(v), 0xB1, 0xF, 0xF, false);
    else if (ctrl_sel == 1) r = __builtin_amdgcn_update_dpp(0, __float_as_int(v), 0x4E, 0xF, 0xF, false);
    else if (ctrl_sel == 2) r = __builtin_amdgcn_update_dpp(0, __float_as_int(v), 0x141, 0xF, 0xF, false);
    else r = __builtin_amdgcn_update_dpp(0, __float_as_int(v), 0x140, 0xF, 0xF, false);
    return __int_as_float(r);
}
__device__ __forceinline__ float rowsum16(float v) { v += dppf(v, 0); v += dppf(v, 1); v += dppf(v, 2); v += dppf(v, 3); return v; }
__device__ __forceinline__ float sigmoidf_(float x) { return 1.0f / (1.0f + __expf(-x)); }

struct Params { const float* in[25]; float* out; unsigned char* ws; int ph_lo, ph_hi; };
#define MK_IDS const int tid = pg8::mk_tid(wave_s), lane = tid & 63, wave = __builtin_amdgcn_readfirstlane(tid >> 6); const int gw = blockIdx.x * 8 + wave; (void)gw; (void)lane

__device__ __forceinline__ void transpose_item(const float* W, int K, int N, bf16* WT, LAS float* scr, int item, int lane) {
    const int nblk = N / 32, kb = item / nblk, nb = item % nblk, k0 = 64 * kb, n0 = 32 * nb;
#pragma unroll 8
    for (int i = 0; i < 32; ++i) { const int kk = 2 * i + (lane >> 5); scr[kk * 33 + (lane & 31)] = W[(size_t)(k0 + kk) * N + n0 + (lane & 31)]; }
    asm volatile("s_waitcnt lgkmcnt(0)" ::: "memory");
    const int c = lane & 7;
#pragma unroll
    for (int j = 0; j < 4; ++j) { const int n = (lane >> 3) + 8 * j; const LAS float* s = scr + (8 * c) * 33 + n;
        u32x4 o; o.x = pk2(s[0 * 33], s[1 * 33]); o.y = pk2(s[2 * 33], s[3 * 33]); o.z = pk2(s[4 * 33], s[5 * 33]); o.w = pk2(s[6 * 33], s[7 * 33]);
        *(u32x4*)(WT + (size_t)(n0 + n) * K + k0 + 8 * c) = o; }
    asm volatile("s_waitcnt lgkmcnt(0)" ::: "memory");
}

__device__ __forceinline__ void prologue(const Params& p, LAS unsigned char* lds, int gw, int NGW, int wave, int lane) {
    unsigned char* ws = p.ws;
    LAS float* scr = (LAS float*)(lds + wave * 16384);
    constexpr int I_IN0 = 16 * 101, I_INR = 16 * 102, I_OUT = 16 * 32, I_UP = 16 * 128, I_DN = 64 * 32;
    constexpr int NITEMS = I_IN0 + 3 * I_INR + 4 * I_OUT + 4 * I_UP + 4 * I_DN;
    for (int it = gw; it < NITEMS; it += NGW) {
        int r = it;
        if (r < I_IN0) { transpose_item(p.in[5], 1024, 3232, (bf16*)(ws + WS_WIN), scr, r, lane); continue; } r -= I_IN0;
        if (r < 3 * I_INR) { const int l = r / I_INR; transpose_item(p.in[6] + (size_t)l * 1024 * 3264, 1024, 3264, (bf16*)(ws + WS_WIN) + (size_t)(l + 1) * NZ * 1024, scr, r % I_INR, lane); continue; } r -= 3 * I_INR;
        if (r < 4 * I_OUT) { const int l = r / I_OUT; transpose_item(p.in[22] + (size_t)l * 1024 * 1024, 1024, 1024, (bf16*)(ws + WS_WOUT) + (size_t)l * 1024 * 1024, scr, r % I_OUT, lane); continue; } r -= 4 * I_OUT;
        if (r < 4 * I_UP) { const int l = r / I_UP; transpose_item(p.in[23] + (size_t)l * 1024 * 4096, 1024, 4096, (bf16*)(ws + WS_WUP) + (size_t)l * 4096 * 1024, scr, r % I_UP, lane); continue; } r -= 4 * I_UP;
        { const int l = r / I_DN; transpose_item(p.in[24] + (size_t)l * 4096 * 1024, 4096, 1024, (bf16*)(ws + WS_WDN) + (size_t)l * 1024 * 4096, scr, r % I_DN, lane); }
    }
    {
        const int gt = gw * 64 + lane, NG = NGW * 64;
        const u32x4 z4 = {0u, 0u, 0u, 0u};
        for (int l = 0; l < 4; ++l) { const int r0 = (l == 0) ? 3232 : 3264; const int nvec = (NZ - r0) * 1024 / 8;
            u32x4* base = (u32x4*)((bf16*)(ws + WS_WIN) + ((size_t)l * NZ + r0) * 1024);
            for (int i = gt; i < nvec; i += NG) base[i] = z4; }
        bf16* LT = (bf16*)(ws + WS_LT);
        for (int i = gt; i < 4 * 512 * 192; i += NG) { const int l = i / (512 * 192), rem = i % (512 * 192), c = rem / 192, m = rem % 192; float v;
            if (m < 32) v = p.in[11][((size_t)l * 32 + m) * 512 + c];
            else if (m < 64) v = p.in[13][((size_t)l * 32 + (m - 32)) * 512 + c];
            else if (m < 160) v = p.in[16][((size_t)l * 96 + (m - 64)) * 512 + c];
            else v = (l > 0) ? p.in[15][((size_t)(l - 1) * 32 + (m - 160)) * 512 + c] : 0.f;
            LT[i] = (bf16)f2bf(v); }
    }
    const float* x = p.in[0]; const float* g = p.in[1]; bf16* XN = (bf16*)(ws + WS_XN);
    for (int row = gw; row < NT; row += NGW) {
        const f32x4* xr = (const f32x4*)(x + (size_t)row * DM) + lane; f32x4* orow = (f32x4*)(p.out + (size_t)row * DM) + lane;
        f32x4 v[4]; float s = 0.f;
#pragma unroll
        for (int j = 0; j < 4; ++j) { v[j] = xr[64 * j]; orow[64 * j] = v[j]; s += (v[j].x * v[j].x + v[j].y * v[j].y) + (v[j].z * v[j].z + v[j].w * v[j].w); }
        const float rstd = 1.0f / sqrtf(wave_sum(s) * (1.0f / DM) + 1e-6f);
        u32x2* o8 = (u32x2*)(XN + (size_t)row * DM) + lane;
#pragma unroll
        for (int j = 0; j < 4; ++j) { const f32x4 gg = ((const f32x4*)g)[lane + 64 * j]; u32x2 w; w.x = pk2(v[j].x * rstd * gg.x, v[j].y * rstd * gg.y); w.y = pk2(v[j].z * rstd * gg.z, v[j].w * rstd * gg.w); o8[64 * j] = w; }
    }
}

__device__ __forceinline__ void norm_phase(const bf16* Y, float* X, bf16* XN, const float* gpost, const float* gnext, int gw, int NGW, int lane) {
    for (int row = gw; row < NT; row += NGW) {
        const u32x4* yr = (const u32x4*)(Y + (size_t)row * DM); f32x4* xr = (f32x4*)(X + (size_t)row * DM);
        float y[16]; float ss = 0.f;
#pragma unroll
        for (int k = 0; k < 2; ++k) { const u32x4 w = yr[k * 64 + lane];
            y[k * 8 + 0] = bflo(w.x); y[k * 8 + 1] = bfhi(w.x); y[k * 8 + 2] = bflo(w.y); y[k * 8 + 3] = bfhi(w.y); y[k * 8 + 4] = bflo(w.z); y[k * 8 + 5] = bfhi(w.z); y[k * 8 + 6] = bflo(w.w); y[k * 8 + 7] = bfhi(w.w); }
#pragma unroll
        for (int e = 0; e < 16; ++e) ss += y[e] * y[e];
        const float rstd = 1.0f / sqrtf(wave_sum(ss) * (1.0f / DM) + 1e-6f);
        float xn[16]; float s2 = 0.f;
#pragma unroll
        for (int k = 0; k < 2; ++k)
#pragma unroll
            for (int q = 0; q < 2; ++q) { const int vi = k * 128 + lane * 2 + q; f32x4 xv = xr[vi]; const f32x4 gg = ((const f32x4*)gpost)[vi];
#pragma unroll
                for (int e = 0; e < 4; ++e) { const float t = xv[e] + y[k * 8 + q * 4 + e] * rstd * gg[e]; xv[e] = t; xn[k * 8 + q * 4 + e] = t; s2 += t * t; }
                xr[vi] = xv; }
        if (gnext) {
            const float r2 = 1.0f / sqrtf(wave_sum(s2) * (1.0f / DM) + 1e-6f);
            u32x4* o = (u32x4*)(XN + (size_t)row * DM);
#pragma unroll
            for (int k = 0; k < 2; ++k) { const f32x4 g0 = ((const f32x4*)gnext)[k * 128 + lane * 2], g1 = ((const f32x4*)gnext)[k * 128 + lane * 2 + 1]; u32x4 w;
                w.x = pk2(xn[k * 8 + 0] * r2 * g0.x, xn[k * 8 + 1] * r2 * g0.y); w.y = pk2(xn[k * 8 + 2] * r2 * g0.z, xn[k * 8 + 3] * r2 * g0.w);
                w.z = pk2(xn[k * 8 + 4] * r2 * g1.x, xn[k * 8 + 5] * r2 * g1.y); w.w = pk2(xn[k * 8 + 6] * r2 * g1.z, xn[k * 8 + 7] * r2 * g1.w);
                o[k * 64 + lane] = w; }
        }
    }
}

__device__ __forceinline__ void post_phase(bf16* MIX, const bf16* YS, const bf16* GB, const bf16* VC, const float* BON, const float* again, const float* gnw, const float* gnb, int gw, int NGW, int lane) {
    for (int row = gw; row < NT; row += NGW) {
        u32x4* mrow = (u32x4*)(MIX + (size_t)row * DM);
        {
            const u32x4 w = mrow[lane]; float o[8] = {bflo(w.x), bfhi(w.x), bflo(w.y), bfhi(w.y), bflo(w.z), bfhi(w.z), bflo(w.w), bfhi(w.w)}; float ss = 0.f;
#pragma unroll
            for (int e = 0; e < 8; ++e) ss += o[e] * o[e];
            const float rstd = 1.0f / sqrtf(wave_sum(ss) * (1.0f / 512.0f) + 1e-6f);
            const f32x4 g0 = ((const f32x4*)again)[lane * 2], g1 = ((const f32x4*)again)[lane * 2 + 1]; u32x4 r;
            r.x = pk2(o[0] * rstd * g0.x, o[1] * rstd * g0.y); r.y = pk2(o[2] * rstd * g0.z, o[3] * rstd * g0.w); r.z = pk2(o[4] * rstd * g1.x, o[5] * rstd * g1.y); r.w = pk2(o[6] * rstd * g1.z, o[7] * rstd * g1.w);
            mrow[lane] = r;
        }
        {
            const u32x4 w = ((const u32x4*)(YS + (size_t)row * 512))[lane]; float y[8] = {bflo(w.x), bfhi(w.x), bflo(w.y), bfhi(w.y), bflo(w.z), bfhi(w.z), bflo(w.w), bfhi(w.w)};
            float s1 = 0.f;
#pragma unroll
            for (int e = 0; e < 8; ++e) s1 += y[e];
            s1 += __shfl_xor(s1, 1); s1 += __shfl_xor(s1, 2); s1 += __shfl_xor(s1, 4);
            const float mean = s1 * (1.0f / 64.0f); float s2 = 0.f;
#pragma unroll
            for (int e = 0; e < 8; ++e) { y[e] -= mean; s2 += y[e] * y[e]; }
            s2 += __shfl_xor(s2, 1); s2 += __shfl_xor(s2, 2); s2 += __shfl_xor(s2, 4);
            const float rs = 1.0f / sqrtf(s2 * (1.0f / 64.0f) + 64e-5f);
            const u32x4 vw = ((const u32x4*)(VC + (size_t)row * 512))[lane], gw4 = ((const u32x4*)(GB + (size_t)row * 512))[lane];
            const float v[8] = {bflo(vw.x), bfhi(vw.x), bflo(vw.y), bfhi(vw.y), bflo(vw.z), bfhi(vw.z), bflo(vw.w), bfhi(vw.w)};
            const float g[8] = {bflo(gw4.x), bfhi(gw4.x), bflo(gw4.y), bfhi(gw4.y), bflo(gw4.z), bfhi(gw4.z), bflo(gw4.w), bfhi(gw4.w)};
            const float bon = BON[(size_t)row * 8 + (lane >> 3)];
            const f32x4 w0 = ((const f32x4*)gnw)[lane * 2], w1 = ((const f32x4*)gnw)[lane * 2 + 1], b0 = ((const f32x4*)gnb)[lane * 2], b1 = ((const f32x4*)gnb)[lane * 2 + 1];
            const float gwv[8] = {w0.x, w0.y, w0.z, w0.w, w1.x, w1.y, w1.z, w1.w}, gbv[8] = {b0.x, b0.y, b0.z, b0.w, b1.x, b1.y, b1.z, b1.w};
            float o[8];
#pragma unroll
            for (int e = 0; e < 8; ++e) o[e] = (y[e] * rs * gwv[e] + gbv[e] + bon * v[e]) * g[e];
            u32x4 r; r.x = pk2(o[0], o[1]); r.y = pk2(o[2], o[3]); r.z = pk2(o[4], o[5]); r.w = pk2(o[6], o[7]);
            mrow[64 + lane] = r;
        }
    }
}

__device__ __forceinline__ void attn_unit(LAS unsigned char* lds, const bf16* Z, bf16* MIX, int unit, int wave, int lane) {
    const int b = unit >> 4, t0 = (unit & 15) * 256;
    LAS float* ACC = (LAS float*)lds;
    LAS float* ML = (LAS float*)(lds + 256 * 68 * 4);
    LAS unsigned char* VST = lds + 256 * 68 * 4 + 2048 + wave * 4096;
    const int li = lane & 15, quad = lane >> 4;
    const float C = 0.125f * 1.4426950408889634f;
    const size_t rowbase = (size_t)b * SEQ;
    for (int h = 0; h < 8; ++h) {
#pragma unroll 1
        for (int br = 0; br < 3; ++br) {
            const int lg = br * 2; const int L = SEQ >> lg;
#pragma unroll 1
            for (int u = 0; u < 2; ++u) {
                const int tu = wave * 2 + u;
                int r, i0;
                if (br == 0) { r = 0; i0 = t0 + tu * 16; } else if (br == 1) { r = tu & 3; i0 = (t0 >> 2) + (tu >> 2) * 16; } else { r = tu; i0 = t0 >> 4; }
                const int tq = ((i0 + li) << lg) + r;
                const bf16* qp = Z + (rowbase + tq) * NZ + ZQ + h * 64 + quad * 8;
                const bf16x8 q0 = *(const bf16x8*)qp, q1 = *(const bf16x8*)(qp + 32);
                f32x4 s[9];
#pragma unroll
                for (int kt = 0; kt < 9; ++kt) {
                    int ik = i0 - 128 + kt * 16 + li; ik = ik < 0 ? 0 : ik;
                    const bf16* kp = Z + (rowbase + (ik << lg) + r) * NZ + ZK + h * 64 + quad * 8;
                    const bf16x8 k0 = *(const bf16x8*)kp, k1 = *(const bf16x8*)(kp + 32);
                    f32x4 a = {0.f, 0.f, 0.f, 0.f};
                    a = __builtin_amdgcn_mfma_f32_16x16x32_bf16(k0, q0, a, 0, 0, 0);
                    a = __builtin_amdgcn_mfma_f32_16x16x32_bf16(k1, q1, a, 0, 0, 0);
                    s[kt] = a;
                }
                u32x4 vv[5][4];
#pragma unroll
                for (int cc = 0; cc < 5; ++cc)
#pragma unroll
                    for (int it = 0; it < 4; ++it) { const int idx = it * 64 + lane, rr = idx >> 3, c16 = idx & 7; int ik = i0 - 128 + cc * 32 + rr; ik = ik < 0 ? 0 : (ik > L - 1 ? L - 1 : ik);
                        vv[cc][it] = *(const u32x4*)(Z + (rowbase + (ik << lg) + r) * NZ + ZV + h * 64 + c16 * 8); }
                float mx = -1e30f;
#pragma unroll
                for (int kt = 0; kt < 9; ++kt)
#pragma unroll
                    for (int j = 0; j < 4; ++j) { const int key = kt * 16 + quad * 4 + j; const int dist = 128 + li - key; const int ik = i0 - 128 + key;
                        const bool valid = (dist >= 0) && (dist <= 128) && (ik >= 0);
                        const float sv = valid ? s[kt][j] : -1e30f; s[kt][j] = sv; mx = fmaxf(mx, sv); }
                mx = fmaxf(mx, __shfl_xor(mx, 16)); mx = fmaxf(mx, __shfl_xor(mx, 32));
                float lsum = 0.f;
#pragma unroll
                for (int kt = 0; kt < 9; ++kt)
#pragma unroll
                    for (int j = 0; j < 4; ++j) { const float pv = __builtin_amdgcn_exp2f((s[kt][j] - mx) * C); s[kt][j] = pv; lsum += pv; }
                lsum += __shfl_xor(lsum, 16); lsum += __shfl_xor(lsum, 32);
                f32x4 o[4];
#pragma unroll
                for (int dt = 0; dt < 4; ++dt) o[dt] = (f32x4){0.f, 0.f, 0.f, 0.f};
#pragma unroll
                for (int cc = 0; cc < 5; ++cc) {
                    asm volatile("s_waitcnt lgkmcnt(0)" ::: "memory");
#pragma unroll
                    for (int it = 0; it < 4; ++it) { const int idx = it * 64 + lane, rr = idx >> 3, c16 = idx & 7;
                        *(LAS u32x4*)(VST + rr * 128 + c16 * 16) = vv[cc][it]; }
                    asm volatile("s_waitcnt lgkmcnt(0)" ::: "memory");
                    bf16x8 pa;
                    { const f32x4 p0 = s[2 * cc]; const unsigned a0 = pk2(p0[0], p0[1]), a1 = pk2(p0[2], p0[3]); unsigned a2 = 0u, a3 = 0u;
                      if (cc < 4) { const f32x4 p1 = s[2 * cc + 1 < 9 ? 2 * cc + 1 : 8]; a2 = pk2(p1[0], p1[1]); a3 = pk2(p1[2], p1[3]); }
                      const u32x4 pw = {a0, a1, a2, a3}; pa = __builtin_bit_cast(bf16x8, pw); }
#pragma unroll
                    for (int dt = 0; dt < 4; ++dt) {
                        LAS unsigned char* ap = VST + (quad * 4 + (li >> 2)) * 128 + (dt * 16 + (li & 3) * 4) * 2;
                        const s16x4 b1 = __builtin_bit_cast(s16x4, __builtin_amdgcn_ds_read_tr16_b64_v4i16((LAS s16x4*)ap));
                        const s16x4 b2 = __builtin_bit_cast(s16x4, __builtin_amdgcn_ds_read_tr16_b64_v4i16((LAS s16x4*)(ap + 16 * 128)));
                        const bf16x8 vb = {b1[0], b1[1], b1[2], b1[3], b2[0], b2[1], b2[2], b2[3]};
                        o[dt] = __builtin_amdgcn_mfma_f32_16x16x32_bf16(pa, vb, o[dt], 0, 0, 0);
                    }
                }
#pragma unroll
                for (int j = 0; j < 4; ++j) {
                    const int qq = quad * 4 + j;
                    const float mr = __shfl(mx, qq), lr = __shfl(lsum, qq);
                    const int tl = (br == 0) ? tu * 16 + qq : (br == 1) ? ((((tu >> 2) * 16 + qq) << 2) + (tu & 3)) : qq * 16 + tu;
                    LAS float* arow = ACC + tl * 68;
                    if (br == 0) {
#pragma unroll
                        for (int dt = 0; dt < 4; ++dt) arow[dt * 16 + li] = o[dt][j];
                        if (li == 0) { ML[tl * 2] = mr; ML[tl * 2 + 1] = lr; }
                    } else {
                        const float m0 = ML[tl * 2], l0 = ML[tl * 2 + 1];
                        const float mn = fmaxf(m0, mr); const float a0 = __builtin_amdgcn_exp2f((m0 - mn) * C), a1 = __builtin_amdgcn_exp2f((mr - mn) * C);
                        const float ln = l0 * a0 + lr * a1;
                        float val[4];
#pragma unroll
                        for (int dt = 0; dt < 4; ++dt) val[dt] = arow[dt * 16 + li] * a0 + o[dt][j] * a1;
                        asm volatile("s_waitcnt lgkmcnt(0)" ::: "memory");
                        if (br == 1) {
#pragma unroll
                            for (int dt = 0; dt < 4; ++dt) arow[dt * 16 + li] = val[dt];
                            if (li == 0) { ML[tl * 2] = mn; ML[tl * 2 + 1] = ln; }
                        } else {
                            const float inv = 1.0f / ln; bf16* orow = MIX + (rowbase + t0 + tl) * DM + h * 64 + li;
#pragma unroll
                            for (int dt = 0; dt < 4; ++dt) orow[dt * 16] = (bf16)f2bf(val[dt] * inv);
                        }
                    }
                }
            }
            __syncthreads();
        }
    }
}

constexpr int TC = 32, NCH = SEQ / TC;
constexpr int SB_STRIDE = 49152, SC_RS = 0, SC_WW = 8192, SC_KS = 16384, SC_KK = 24576, SC_BV = 32768, SC_VS = 40960;
constexpr int ACT_PITCH = 400, SC_ACT = 2 * SB_STRIDE, SC_LTS = SC_ACT + 4 * 8 * ACT_PITCH, SC_MU = SC_LTS + 64 * ACT_PITCH, SC_INV = SC_MU + 1536, SC_CT = SC_INV + 128;
static_assert(SC_CT + 1536 <= LDS_BYTES, "scan LDS map");
__device__ __forceinline__ float rowsum8(float v) { v += dppf(v, 0); v += dppf(v, 1); v += dppf(v, 2); return v; }
typedef float f32x2 __attribute__((ext_vector_type(2)));
struct ScanVec { f32x4 w0, w1, k0, k1, b0, b1, x0, x1, r0, r1; float v; };
__device__ __forceinline__ ScanVec scan_load(LAS const unsigned char* buf, int t, int j0, int irow) {
    ScanVec s; const LAS float* W = (const LAS float*)(buf + SC_WW) + t * 64 + j0; const LAS float* K = (const LAS float*)(buf + SC_KK) + t * 64 + j0; const LAS float* B = (const LAS float*)(buf + SC_BV) + t * 64 + j0;
    const LAS float* X = (const LAS float*)(buf + SC_KS) + t * 64 + j0; const LAS float* R = (const LAS float*)(buf + SC_RS) + t * 64 + j0;
    s.w0 = *(const LAS f32x4*)W; s.w1 = *(const LAS f32x4*)(W + 4); s.k0 = *(const LAS f32x4*)K; s.k1 = *(const LAS f32x4*)(K + 4); s.b0 = *(const LAS f32x4*)B; s.b1 = *(const LAS f32x4*)(B + 4);
    s.x0 = *(const LAS f32x4*)X; s.x1 = *(const LAS f32x4*)(X + 4); s.r0 = *(const LAS f32x4*)R; s.r1 = *(const LAS f32x4*)(R + 4); s.v = ((const LAS float*)(buf + SC_VS))[t * 64 + irow];
    return s;
}
#define LO2(a) ((f32x2){(a).x, (a).y})
#define HI2(a) ((f32x2){(a).z, (a).w})
__device__ __forceinline__ void scan_unit(LAS unsigned char* lds, const Params& p, int layer, int unit, int tid, int wave, int lane) {
    const int chain = unit >> 1, hf = unit & 1, b = chain >> 3, h = chain & 7;
    unsigned char* ws = p.ws;
    const bf16* Z = (const bf16*)(ws + WS_Z); bf16* VF = (bf16*)(ws + WS_VF); bf16* YS = (bf16*)(ws + WS_YS); bf16* GB = (bf16*)(ws + WS_G); bf16* VC = (bf16*)(ws + WS_VC); float* BON = (float*)(ws + WS_BON);
    const bf16* LT = (const bf16*)(ws + WS_LT) + (size_t)layer * 512 * 192;
    const float* mu = p.in[7] + (size_t)layer * 1696; const float* mumv = (layer > 0) ? p.in[8] + (size_t)(layer - 1) * 32 : nullptr;
    const size_t rowbase = (size_t)b * SEQ;
    LAS float* MU = (LAS float*)(lds + SC_MU); LAS unsigned char* LTS = lds + SC_LTS;
    if (tid < 96) { const int cgp = tid, cat = cgp >> 4; const int zc = (cat < 3) ? ZR + cat * 512 + h * 64 + (cgp & 15) * 4 : ZXW + (cgp - 48) * 4;
        const bool ismv = zc >= ZMV; const float* src = ismv ? (mumv ? mumv + (zc - ZMV) : mu) : mu + (zc - ZR);
        f32x4 m4 = *(const f32x4*)src; if (ismv && !mumv) m4 = (f32x4){0.f, 0.f, 0.f, 0.f};
        *(LAS f32x4*)(MU + cgp * 4) = m4; }
    if (tid < 384) { const int arr = tid >> 6, c = tid & 63, gi = layer * 512 + h * 64 + c; float v;
        if (arr == 0) v = p.in[10][gi]; else if (arr == 1) v = p.in[12][gi]; else if (arr == 2) v = (layer > 0) ? p.in[14][(layer - 1) * 512 + h * 64 + c] : 0.f; else if (arr == 3) v = p.in[17][gi]; else if (arr == 4) v = p.in[18][gi]; else v = p.in[19][gi];
        ((LAS float*)(lds + SC_CT))[tid] = v; }
    for (int i = tid; i < 64 * 24; i += 512) { const int c = i / 24, ch = i % 24; *(LAS u32x4*)(LTS + c * ACT_PITCH + ch * 16) = *(const u32x4*)(LT + (size_t)(h * 64 + c) * 192 + ch * 8); }
    __syncthreads();
    if (wave < 4) {
        const int rl = wave * 8 + (lane >> 3), irow = hf * 32 + rl, q = lane & 7, j0 = q * 8;
        f32x2 S0 = {0.f, 0.f}, S1 = {0.f, 0.f}, S2 = {0.f, 0.f}, S3 = {0.f, 0.f}; float ykeep = 0.f;
        __syncthreads();
#pragma unroll 1
        for (int c = 0; c < NCH; ++c) {
            LAS const unsigned char* buf = lds + (c & 1) * SB_STRIDE;
            const int tch = c * TC;
            ScanVec cur = scan_load(buf, 0, j0, irow);
#pragma unroll
            for (int t = 0; t < TC; ++t) {
                ScanVec nx; if (t + 1 < TC) nx = scan_load(buf, t + 1, j0, irow); else nx = cur;
                f32x2 d = S0 * LO2(cur.k0); d = S1 * HI2(cur.k0) + d; d = S2 * LO2(cur.k1) + d; d = S3 * HI2(cur.k1) + d;
                float sa = rowsum8(d.x + d.y);
                const f32x2 v2 = {cur.v, cur.v}, sa2 = {sa, sa};
                S0 = S0 * LO2(cur.w0) + (v2 * LO2(cur.x0) - sa2 * LO2(cur.b0)); S1 = S1 * HI2(cur.w0) + (v2 * HI2(cur.x0) - sa2 * HI2(cur.b0));
                S2 = S2 * LO2(cur.w1) + (v2 * LO2(cur.x1) - sa2 * LO2(cur.b1)); S3 = S3 * HI2(cur.w1) + (v2 * HI2(cur.x1) - sa2 * HI2(cur.b1));
                f32x2 e = S0 * LO2(cur.r0); e = S1 * HI2(cur.r0) + e; e = S2 * LO2(cur.r1) + e; e = S3 * HI2(cur.r1) + e;
                const float y = rowsum8(e.x + e.y);
                ykeep = (q == (t & 7)) ? y : ykeep;
                if ((t & 7) == 7) YS[(rowbase + tch + (t & ~7) + q) * 512 + h * 64 + irow] = (bf16)f2bf(ykeep);
                cur = nx;
            }
            __syncthreads();
        }
    } else {
        const int pw = wave - 4, s = lane >> 3, q = lane & 7, li = lane & 15, quad = lane >> 4;
        LAS unsigned char* ACT = lds + SC_ACT + pw * 8 * ACT_PITCH; LAS float* INV = (LAS float*)(lds + SC_INV) + pw * 8;
        const LAS float* CT = (const LAS float*)(lds + SC_CT);
        u32x2 pc[12], pp[12]; u32x4 pvf[2];
        pvf[0] = (u32x4){0u, 0u, 0u, 0u}; pvf[1] = pvf[0];
#define PR_OFF(k) ((k) < 2 ? (ZR - ZKR) + (k) * 32 : (k) < 4 ? ((k) - 2) * 32 : (k) < 6 ? (ZVR - ZKR) + ((k) - 4) * 32 : ((k) - 6) * 32)
#define PR_ISSUE(tchv) do { const int tg = (tchv) + pw * 8 + s; const int tgp = tg > 0 ? tg - 1 : 0; \
        const bf16* c1 = Z + (rowbase + tg) * NZ + ZKR + h * 64 + q * 4; const bf16* c2 = Z + (rowbase + tg) * NZ + ZXW + q * 4; \
        const bf16* p1 = Z + (rowbase + tgp) * NZ + ZKR + h * 64 + q * 4; const bf16* p2 = Z + (rowbase + tgp) * NZ + ZXW + q * 4; \
        asm volatile("" : "+v"(c1), "+v"(c2), "+v"(p1), "+v"(p2)); \
        _Pragma("unroll") for (int k = 0; k < 12; ++k) { pc[k] = *(const u32x2*)((k < 6 ? c1 : c2) + PR_OFF(k)); pp[k] = *(const u32x2*)((k < 6 ? p1 : p2) + PR_OFF(k)); } \
        if (layer > 0) { pvf[0] = *(const u32x4*)(VF + (rowbase + (tchv) + pw * 8 + s) * 512 + h * 64 + q * 8); } } while (0)
        PR_ISSUE(0);
#pragma unroll 1
        for (int c = 0; c <= NCH; ++c) {
            if (c < NCH) {
                const int tch = c * TC;
                LAS unsigned char* buf = lds + (c & 1) * SB_STRIDE;
                LAS float* RS = (LAS float*)(buf + SC_RS); LAS float* WW = (LAS float*)(buf + SC_WW); LAS float* KS = (LAS float*)(buf + SC_KS); LAS float* KK = (LAS float*)(buf + SC_KK);
                LAS float* BV = (LAS float*)(buf + SC_BV); LAS float* VS = (LAS float*)(buf + SC_VS);
                const u32x4 cvf0 = pvf[0];
                const float pz = (tch + pw * 8 + s > 0) ? 1.0f : 0.0f;
                const int trow = pw * 8 + s;
#pragma unroll
                for (int k = 0; k < 12; ++k) {
                    const u32x2 cw = pc[k], pw2 = pp[k];
                    const f32x4 m4 = *(const LAS f32x4*)(MU + (k * 8 + q) * 4);
                    const float c0 = bflo(cw.x), c1 = bfhi(cw.x), c2 = bflo(cw.y), c3 = bfhi(cw.y), p0 = bflo(pw2.x) * pz, p1 = bfhi(pw2.x) * pz, p2 = bflo(pw2.y) * pz, p3 = bfhi(pw2.y) * pz;
                    f32x4 v = {c0 + (p0 - c0) * m4.x, c1 + (p1 - c1) * m4.y, c2 + (p2 - c2) * m4.z, c3 + (p3 - c3) * m4.w};
                    if (k < 2) *(LAS f32x4*)(RS + trow * 64 + (k * 8 + q) * 4) = v;
                    else if (k < 4) *(LAS f32x4*)(KS + trow * 64 + ((k - 2) * 8 + q) * 4) = v;
                    else if (k < 6) *(LAS f32x4*)(VS + trow * 64 + ((k - 4) * 8 + q) * 4) = v;
                    else {
                        const int ac = ((k - 6) * 8 + q) * 4;
                        if (k == 6) {
#pragma unroll
                            for (int e = 0; e < 4; ++e) v[e] = 1.0f - 2.0f * __builtin_amdgcn_rcpf(1.0f + __expf(2.0f * v[e])); }
                        else if (k >= 8 && k <= 10) {
#pragma unroll
                            for (int e = 0; e < 4; ++e) v[e] = __builtin_amdgcn_rcpf(1.0f + __expf(-v[e])); }
                        u32x2 w; w.x = pk2(v.x, v.y); w.y = pk2(v.z, v.w); *(LAS u32x2*)(ACT + s * ACT_PITCH + ac * 2) = w; }
                }
                if (c + 1 < NCH) PR_ISSUE(tch + TC);
                asm volatile("s_waitcnt lgkmcnt(0)" ::: "memory");
                { const f32x4 ka = *(const LAS f32x4*)(KS + trow * 64 + q * 8), kb = *(const LAS f32x4*)(KS + trow * 64 + q * 8 + 4); const f32x4 kc0 = *(const LAS f32x4*)(CT + 3 * 64 + q * 8), kc1 = *(const LAS f32x4*)(CT + 3 * 64 + q * 8 + 4); const float kkl[8] = {kc0.x, kc0.y, kc0.z, kc0.w, kc1.x, kc1.y, kc1.z, kc1.w};
                  float ss = ((ka.x * kkl[0]) * (ka.x * kkl[0]) + (ka.y * kkl[1]) * (ka.y * kkl[1])) + ((ka.z * kkl[2]) * (ka.z * kkl[2]) + (ka.w * kkl[3]) * (ka.w * kkl[3]));
                  ss += ((kb.x * kkl[4]) * (kb.x * kkl[4]) + (kb.y * kkl[5]) * (kb.y * kkl[5])) + ((kb.z * kkl[6]) * (kb.z * kkl[6]) + (kb.w * kkl[7]) * (kb.w * kkl[7]));
                  ss = rowsum8(ss);
                  if (q == 0) INV[s] = 1.0f / fmaxf(sqrtf(ss), 1e-12f); }
                asm volatile("s_waitcnt lgkmcnt(0)" ::: "memory");
                {
                    bf16x8 Af[6];
#pragma unroll
                    for (int ks = 0; ks < 6; ++ks) Af[ks] = *(const LAS bf16x8*)(ACT + (li & 7) * ACT_PITCH + ks * 64 + quad * 16);
                    asm volatile("s_waitcnt lgkmcnt(0)" ::: "memory");
                    LAS float* GT = (LAS float*)ACT;
                    const int lbase = (pw * 8 + (quad & 1) * 4) * 64 + li;
#pragma unroll
                    for (int ct = 0; ct < 4; ++ct) {
                        bf16x8 Bf[6];
#pragma unroll
                        for (int ks = 0; ks < 6; ++ks) Bf[ks] = *(const LAS bf16x8*)(LTS + (ct * 16 + li) * ACT_PITCH + ks * 64 + quad * 16);
                        const f32x4 z4 = {0.f, 0.f, 0.f, 0.f};
                        const f32x4 LW = __builtin_amdgcn_mfma_f32_16x16x32_bf16(Af[0], Bf[0], z4, 0, 0, 0);
                        const f32x4 AA = __builtin_amdgcn_mfma_f32_16x16x32_bf16(Af[1], Bf[1], z4, 0, 0, 0);
                        f32x4 G = __builtin_amdgcn_mfma_f32_16x16x32_bf16(Af[2], Bf[2], z4, 0, 0, 0);
                        G = __builtin_amdgcn_mfma_f32_16x16x32_bf16(Af[3], Bf[3], G, 0, 0, 0);
                        G = __builtin_amdgcn_mfma_f32_16x16x32_bf16(Af[4], Bf[4], G, 0, 0, 0);
                        const f32x4 VG = __builtin_amdgcn_mfma_f32_16x16x32_bf16(Af[5], Bf[5], z4, 0, 0, 0);
                        if (quad < 2) {
#pragma unroll
                            for (int j = 0; j < 4; ++j) { const int lo = lbase + j * 64 + ct * 16; WW[lo] = LW[j]; KK[lo] = AA[j]; BV[lo] = VG[j]; GT[((quad & 1) * 4 + j) * 64 + ct * 16 + li] = G[j]; }
                        }
                    }
                }
                asm volatile("s_waitcnt lgkmcnt(0)" ::: "memory");
                {
                    const LAS float* GT = (const LAS float*)ACT;
                    const int lo8 = trow * 64 + q * 8; const size_t go8 = (rowbase + tch + trow) * 512 + h * 64 + q * 8;
                    float r[8], k[8], v[8], lw[8], aa[8], vg[8], g[8], c_w0[8], c_a0[8], c_v0[8], c_kk[8], c_ka[8], c_rk[8];
#define LD8(dst, ptr) do { const f32x4 _a = *(const LAS f32x4*)(ptr), _b = *(const LAS f32x4*)((ptr) + 4); dst[0] = _a.x; dst[1] = _a.y; dst[2] = _a.z; dst[3] = _a.w; dst[4] = _b.x; dst[5] = _b.y; dst[6] = _b.z; dst[7] = _b.w; } while (0)
                    LD8(r, RS + lo8); LD8(k, KS + lo8); LD8(v, VS + lo8); LD8(lw, WW + lo8); LD8(aa, KK + lo8); LD8(vg, BV + lo8); LD8(g, GT + s * 64 + q * 8);
                    LD8(c_w0, CT + q * 8); LD8(c_a0, CT + 64 + q * 8); LD8(c_v0, CT + 128 + q * 8); LD8(c_kk, CT + 192 + q * 8); LD8(c_ka, CT + 256 + q * 8); LD8(c_rk, CT + 320 + q * 8);
                    const float invn = INV[s];
                    float vf[8];
                    { const u32x4 cv = cvf0; vf[0] = bflo(cv.x); vf[1] = bfhi(cv.x); vf[2] = bflo(cv.y); vf[3] = bfhi(cv.y); vf[4] = bflo(cv.z); vf[5] = bfhi(cv.z); vf[6] = bflo(cv.w); vf[7] = bfhi(cv.w); }
                    float ow[8], okm[8], okk[8], obv[8]; float bp = 0.f;
#pragma unroll
                    for (int e = 0; e < 8; ++e) {
                        const float sg = __builtin_amdgcn_rcpf(1.0f + __expf(-(c_w0[e] + lw[e])));
                        ow[e] = __expf(-0.6065306597126334f * sg);
                        const float a = __builtin_amdgcn_rcpf(1.0f + __expf(-(c_a0[e] + aa[e])));
                        okk[e] = k[e] * c_kk[e] * invn; okm[e] = k[e] * (1.0f + (a - 1.0f) * c_ka[e]); obv[e] = okk[e] * a;
                        if (layer > 0) { const float vgs = __builtin_amdgcn_rcpf(1.0f + __expf(-(c_v0[e] + vg[e]))); v[e] = v[e] + (vf[e] - v[e]) * vgs; }
                        bp += r[e] * okm[e] * c_rk[e];
                    }
#define ST8(ptr, src) do { *(LAS f32x4*)(ptr) = (f32x4){src[0], src[1], src[2], src[3]}; *(LAS f32x4*)((ptr) + 4) = (f32x4){src[4], src[5], src[6], src[7]}; } while (0)
                    ST8(WW + lo8, ow); ST8(KS + lo8, okm); ST8(KK + lo8, okk); ST8(BV + lo8, obv); ST8(VS + lo8, v);
                    bp = rowsum8(bp);
                    if (hf == 0) {
                        u32x4 gv, vv; gv.x = pk2(g[0], g[1]); gv.y = pk2(g[2], g[3]); gv.z = pk2(g[4], g[5]); gv.w = pk2(g[6], g[7]);
                        vv.x = pk2(v[0], v[1]); vv.y = pk2(v[2], v[3]); vv.z = pk2(v[4], v[5]); vv.w = pk2(v[6], v[7]);
                        *(u32x4*)(GB + go8) = gv; *(u32x4*)(VC + go8) = vv; if (layer == 0) *(u32x4*)(VF + go8) = vv;
                        if (q == 0) BON[(rowbase + tch + trow) * 8 + h] = bp;
                    }
                }
            }
            __syncthreads();
        }
    }
}

#ifdef MK_GEMM_TWICE
#define GEMM_AGAIN __syncthreads(); pg8::gemm_phase<decltype(E), pg8::StaticOrder, true, true>(lds, g, S, E, wave_s)
#else
#define GEMM_AGAIN
#endif
#ifdef MK_ATTN_TWICE
#define ATTN_CALL2 attn_unit(lds, Zb, XN, u - 128, wave, lane)
#else
#define ATTN_CALL2
#endif
#ifndef MK_NO_SCAN
#define SCAN_CALL scan_unit(lds, p, l, u, tid, wave, lane)
#else
#define SCAN_CALL
#endif
#ifndef MK_NO_ATTN
#define ATTN_CALL attn_unit(lds, Zb, XN, u - 128, wave, lane)
#else
#define ATTN_CALL
#endif
__global__ void __launch_bounds__(512, 2) mk_fwd(Params p) {
    extern __shared__ __attribute__((aligned(16))) unsigned char lds_raw[];
    LAS unsigned char* lds = (LAS unsigned char*)lds_raw;
    cg::grid_group grid = cg::this_grid();
    const int G = gridDim.x, NGW = G * 8;
    const int wave_s = __builtin_amdgcn_readfirstlane(threadIdx.x >> 6);
    unsigned char* ws = p.ws;
    bf16* XN = (bf16*)(ws + WS_XN); bf16* Zb = (bf16*)(ws + WS_Z); bf16* Hb = (bf16*)(ws + WS_H); bf16* Y1 = (bf16*)(ws + WS_Y1);
    int ph = 0;
#define PH_ON (ph >= p.ph_lo && ph < p.ph_hi)
#define PH_END do { if (ph + 1 < p.ph_hi) grid.sync(); } while (0)
    if (PH_ON) { MK_IDS; prologue(p, lds, gw, NGW, wave, lane); PH_END; } ++ph;
#pragma unroll 1
    for (int l = 0; l < DEPTH; ++l) {
        if (PH_ON) { pg8::Gemm g{XN, (const bf16*)(ws + WS_WIN) + (size_t)l * NZ * 1024, NT, NZ, 1024}; pg8::StaticOrder S; S.init(NT, NZ, G, (int)blockIdx.x);
            pg8::EpiAct<0> E{Zb, NZ}; pg8::gemm_phase<pg8::EpiAct<0>, pg8::StaticOrder, true, true>(lds, g, S, E, wave_s); GEMM_AGAIN; PH_END; } ++ph;
        if (PH_ON) { MK_IDS;
            for (int u = blockIdx.x; u < 128; u += G) { SCAN_CALL; __syncthreads(); }
            for (int u = (blockIdx.x >= 128 ? blockIdx.x : blockIdx.x + ((127 - blockIdx.x) / G + 1) * G); u < 256; u += G) { ATTN_CALL; __syncthreads(); ATTN_CALL2; __syncthreads(); }
            PH_END; } ++ph;
        if (PH_ON) { MK_IDS; post_phase(XN, (const bf16*)(ws + WS_YS), (const bf16*)(ws + WS_G), (const bf16*)(ws + WS_VC), (const float*)(ws + WS_BON), p.in[9] + l * 512, p.in[20] + l * 512, p.in[21] + l * 512, gw, NGW, lane); PH_END; } ++ph;
        if (PH_ON) { pg8::Gemm g{XN, (const bf16*)(ws + WS_WOUT) + (size_t)l * 1024 * 1024, NT, 1024, 1024}; pg8::StaticOrder S; S.init(NT, 1024, G, (int)blockIdx.x);
            pg8::EpiAct<0> E{Y1, 1024}; pg8::gemm_phase<pg8::EpiAct<0>, pg8::StaticOrder, true, true>(lds, g, S, E, wave_s); GEMM_AGAIN; PH_END; } ++ph;
        if (PH_ON) { MK_IDS; norm_phase(Y1, p.out, XN, p.in[2] + l * 1024, p.in[3] + l * 1024, gw, NGW, lane); PH_END; } ++ph;
        if (PH_ON) { pg8::Gemm g{XN, (const bf16*)(ws + WS_WUP) + (size_t)l * 4096 * 1024, NT, DFF, 1024}; pg8::StaticOrder S; S.init(NT, DFF, G, (int)blockIdx.x);
            pg8::EpiAct<1> E{Hb, DFF}; pg8::gemm_phase<pg8::EpiAct<1>, pg8::StaticOrder, true, true>(lds, g, S, E, wave_s); GEMM_AGAIN; PH_END; } ++ph;
        if (PH_ON) { pg8::Gemm g{Hb, (const bf16*)(ws + WS_WDN) + (size_t)l * 1024 * 4096, NT, 1024, DFF}; pg8::StaticOrder S; S.init(NT, 1024, G, (int)blockIdx.x);
            pg8::EpiAct<0> E{XN, 1024}; pg8::gemm_phase<pg8::EpiAct<0>, pg8::StaticOrder, true, true>(lds, g, S, E, wave_s); GEMM_AGAIN; PH_END; } ++ph;
        if (PH_ON) { MK_IDS; norm_phase(XN, p.out, XN, p.in[4] + l * 1024, (l + 1 < DEPTH) ? p.in[1] + (l + 1) * 1024 : nullptr, gw, NGW, lane); PH_END; } ++ph;
    }
}
constexpr int N_PHASES = 1 + 8 * DEPTH;

extern "C" void kernel_launch(void* const* d_in, const int* in_sizes, int n_in, void* d_out, int out_size, void* d_ws, size_t ws_size, hipStream_t stream) {
    static int grid = 0;
    if (grid == 0) {
        if (n_in != 25 || out_size != NT * DM || ws_size < WS_END) { fprintf(stderr, "kernel_launch: unexpected sizes n_in=%d out=%d ws=%zu\n", n_in, out_size, ws_size); grid = -1; return; }
        int dev = 0, cus = 0, per_cu = 0;
        hipGetDevice(&dev); hipDeviceGetAttribute(&cus, hipDeviceAttributeMultiprocessorCount, dev);
        if (hipFuncSetAttribute((const void*)mk_fwd, hipFuncAttributeMaxDynamicSharedMemorySize, LDS_BYTES) != hipSuccess) { fprintf(stderr, "kernel_launch: hipFuncSetAttribute failed\n"); grid = -1; return; }
        if (hipOccupancyMaxActiveBlocksPerMultiprocessor(&per_cu, (const void*)mk_fwd, 512, LDS_BYTES) != hipSuccess || per_cu < 1) { fprintf(stderr, "kernel_launch: occupancy query gave %d\n", per_cu); per_cu = 1; }
        (void)hipGetLastError();
        grid = cus * per_cu;
        fprintf(stderr, "kernel_launch: grid %d (cus %d x %d)\n", grid, cus, per_cu);
    }
    if (grid < 0) return;
    Params p{};
    for (int i = 0; i < 25; ++i) p.in[i] = (const float*)d_in[i];
    p.out = (float*)d_out; p.ws = (unsigned char*)d_ws;
#if MK_MULTI
    for (int ph = 0; ph < N_PHASES; ++ph) { p.ph_lo = ph; p.ph_hi = ph + 1; hipLaunchKernelGGL(mk_fwd, dim3(grid), dim3(512), LDS_BYTES, stream, p); }
#else
    p.ph_lo = 0; p.ph_hi = N_PHASES;
    void* args[] = {&p};
    hipError_t e = hipLaunchCooperativeKernel((const void*)mk_fwd, dim3(grid), dim3(512), args, LDS_BYTES, stream);
    if (e != hipSuccess) fprintf(stderr, "kernel_launch: cooperative launch failed: %s (grid %d)\n", hipGetErrorString(e), grid);
#endif
}
```

```cpp
#include <hip/hip_runtime.h>
#include <hip/hip_cooperative_groups.h>
#include <cstdio>
#include <cstdint>
namespace cg = cooperative_groups;
#ifndef MK_MULTI
#define MK_MULTI 0
#endif
namespace pg8 {
#define PG8_LAS __attribute__((address_space(3)))
typedef unsigned short bf16_t;
typedef short bf16x8 __attribute__((ext_vector_type(8)));
typedef float f32x4 __attribute__((ext_vector_type(4)));
typedef unsigned u32x4 __attribute__((ext_vector_type(4)));
constexpr int BM = 256, BK = 64, HALF = 128, HTB = HALF * BK * 2  , STAGE_BYTES = 8 * HTB, NXCD = 8, WGM = 8;

__host__ __device__ __forceinline__ int lds_byte(int r, int c) { const int st = (r >> 4) * 2 + (c >> 5), rr = r & 15, cc = c & 31, ob = rr * 64 + cc * 2; return st * 1024 + (ob ^ (((ob >> 9) & 1) << 5)); }
__host__ __device__ __forceinline__ void stage_rc(int b, int& R, int& C) { const int st = b / 1024, sb = b % 1024, swz = sb ^ (((sb >> 9) & 1) << 5); R = (st >> 1) * 16 + swz / 64; C = (st & 1) * 32 + (swz % 64) / 2; }
__host__ __device__ __forceinline__ int perm32(int rho) { const int n = rho >> 4, i = rho & 15; return 8 * (i >> 2) + 4 * n + (i & 3); }

struct Unit { int pm, pn; };
struct Gemm { const bf16_t* A; const bf16_t* Bt; int M, N, K; };
struct StaticOrder {
    int nM, nN, nwg, G, c;
    __host__ __device__ void init(int M, int N, int G_, int c_) { nM = M / BM; nN = N / BM; nwg = nM * nN; G = G_; c = c_; }
    __host__ __device__ bool next(int i, Unit& u) const {
        const long L = (long)i * G + c; if (L >= nwg) return false;
        int wgid = (int)L; { const int q = nwg / NXCD, r = nwg % NXCD, xcd = wgid % NXCD, off = wgid / NXCD; wgid = (xcd < r ? xcd * (q + 1) : r * (q + 1) + (xcd - r) * q) + off; }
        const int nig = WGM * nN, gid = wgid / nig, fm = gid * WGM, gsz = (nM - fm) < WGM ? (nM - fm) : WGM;
        u.pm = fm + ((wgid % nig) % gsz); u.pn = (wgid % nig) / gsz; return true;
    }
    __device__ __forceinline__ void a_ready(const Unit&) const {}
    __device__ __forceinline__ void done(const Unit&) const {}
};
__device__ __forceinline__ unsigned cvt_pk_bf16(float lo, float hi) { unsigned r; asm volatile("v_cvt_pk_bf16_f32 %0, %1, %2" : "=v"(r) : "v"(lo), "v"(hi)); return r; }
typedef float f32x2 __attribute__((ext_vector_type(2)));
__device__ __forceinline__ int mk_tid(const int w) { unsigned m = ~0u; asm volatile("" : "+s"(m)); const int l = __builtin_amdgcn_mbcnt_hi(m, __builtin_amdgcn_mbcnt_lo(m, 0u)); int t = w * 64 + l; asm volatile("" : "+v"(t)); return t; }
template <int ACT> struct EpiAct {
    static constexpr bool PERM = true, AFTER_DRAIN = false;
    bf16_t* O; int ldc;
    __device__ __forceinline__ void operator()(const f32x4 (&acc)[2][2][4][2], const Unit& u, int wr, int wc, int fr, int fq) const {
        const int row0 = u.pm * BM + wr * 64 + fr; const int col0 = u.pn * BM + wc * 32 + 8 * fq;
#pragma unroll
        for (int ai = 0; ai < 2; ++ai)
#pragma unroll
            for (int m = 0; m < 4; ++m) { bf16_t* rowp = O + (size_t)(row0 + ai * HALF + m * 16) * ldc + col0;
#pragma unroll
                for (int bj = 0; bj < 2; ++bj) { f32x4 v0 = acc[ai][bj][m][0], v1 = acc[ai][bj][m][1];
                    if (ACT == 1) {
#pragma unroll
                        for (int e = 0; e < 4; ++e) { float a = v0[e] > 0.f ? v0[e] : 0.f, b = v1[e] > 0.f ? v1[e] : 0.f; v0[e] = a * a; v1[e] = b * b; } }
                    u32x4 w; w.x = cvt_pk_bf16(v0[0], v0[1]); w.y = cvt_pk_bf16(v0[2], v0[3]); w.z = cvt_pk_bf16(v1[0], v1[1]); w.w = cvt_pk_bf16(v1[2], v1[3]);
                    *(u32x4*)(rowp + bj * HALF) = w; } }
    }
};
template <class Epi, class Sched, bool ALIGN_EPI = false, bool SP2 = false>
__device__ __forceinline__ void gemm_phase(PG8_LAS unsigned char* lds, const Gemm g, const Sched& S, const Epi& E, const int wave_s) {
    const int tid = mk_tid(wave_s), wid = __builtin_amdgcn_readfirstlane(tid >> 6), lane = tid & 63, wr = wid >> 2, wc = wid & 3, fr = lane & 15, fq = lane >> 4;
    const int K = g.K, nt = K / BK;
    unsigned voffA[2], voffB[2];
#pragma unroll
    for (int i = 0; i < 2; ++i) { int R, C; stage_rc(tid * 16 + i * 8192, R, C); const int Rb = Epi::PERM ? ((R & ~31) + perm32(R & 31)) : R;
        voffA[i] = (unsigned)(R * K + C) * 2u; voffB[i] = (unsigned)(Rb * K + C) * 2u; }
    const size_t kstep = (size_t)(BK * 2);
    const size_t hstep = (size_t)HALF * K * 2;
    const size_t tstep = 2 * hstep;
    const unsigned ldsw = (unsigned)wid * 1024u;
    const int aoff = lds_byte(wr * 64 + fr, fq * 8), boff = lds_byte(wc * 32 + fr, fq * 8);
#define PG8_SA(b, h) (((b) * 2 + (h)) * HTB)
#define PG8_SB(b, h) ((4 + (b) * 2 + (h)) * HTB)
#define PG8_STAGE(bufoff, gbase, voff) do { _Pragma("unroll") for (int _i = 0; _i < 2; ++_i) \
        __builtin_amdgcn_global_load_lds((const unsigned*)((const char*)(gbase) + (voff)[_i]), (PG8_LAS unsigned*)(lds + (bufoff) + ldsw + _i * 8192), 16, 0, 0); } while (0)
#define PG8_LDA(dst, b, h) do { _Pragma("unroll") for (int m = 0; m < 4; ++m) _Pragma("unroll") for (int k = 0; k < 2; ++k) dst[m][k] = *(const PG8_LAS bf16x8*)(lds + PG8_SA(b, h) + aoff + m * 2048 + k * 1024); } while (0)
#define PG8_LDB(dst, b, h) do { _Pragma("unroll") for (int n = 0; n < 2; ++n) _Pragma("unroll") for (int k = 0; k < 2; ++k) dst[n][k] = *(const PG8_LAS bf16x8*)(lds + PG8_SB(b, h) + boff + n * 2048 + k * 1024); } while (0)
#define PG8_MMA(ai, bj, At, Bt) do { __builtin_amdgcn_s_setprio(1); _Pragma("unroll") for (int m = 0; m < 4; ++m) _Pragma("unroll") for (int n = 0; n < 2; ++n) _Pragma("unroll") for (int k = 0; k < 2; ++k) \
        acc[ai][bj][m][n] = __builtin_amdgcn_mfma_f32_16x16x32_bf16(Bt[n][k], At[m][k], acc[ai][bj][m][n], 0, 0, 0); __builtin_amdgcn_s_setprio(0); } while (0)
#define PG8_WAIT_V(n) asm volatile("s_waitcnt vmcnt(" #n ")" ::: "memory")
#define PG8_WAIT_L(n) asm volatile("s_waitcnt lgkmcnt(" #n ")" ::: "memory")
#define PG8_BAR __builtin_amdgcn_s_barrier()
#define PG8_SCHED __builtin_amdgcn_sched_barrier(0)
    Unit cur, nxt; int ui = 0;
    if (!S.next(0, cur)) return;
    f32x4 acc[2][2][4][2];
#pragma unroll
    for (int a = 0; a < 2; ++a)
#pragma unroll
        for (int b = 0; b < 2; ++b)
#pragma unroll
            for (int m = 0; m < 4; ++m)
#pragma unroll
                for (int n = 0; n < 2; ++n) acc[a][b][m][n] = (f32x4){0.f, 0.f, 0.f, 0.f};
    bf16x8 At[4][2], B0[2][2], B1[2][2];
    const char* cA = (const char*)g.A + (size_t)cur.pm * tstep; const char* cB = (const char*)g.Bt + (size_t)cur.pn * tstep;
    S.a_ready(cur);
    if constexpr (SP2) {
        PG8_STAGE(PG8_SB(0, 0), cB, voffB); PG8_STAGE(PG8_SB(0, 1), cB + hstep, voffB); PG8_STAGE(PG8_SA(0, 0), cA, voffA); PG8_STAGE(PG8_SA(0, 1), cA + hstep, voffA);
        if (wr == 1) PG8_BAR;
        PG8_WAIT_V(2); PG8_BAR;
        PG8_STAGE(PG8_SB(1, 0), cB + kstep, voffB); PG8_STAGE(PG8_SA(1, 0), cA + kstep, voffA); PG8_STAGE(PG8_SB(1, 1), cB + hstep + kstep, voffB);
        PG8_WAIT_V(6); PG8_BAR;
    } else {
        PG8_STAGE(PG8_SB(0, 0), cB, voffB); PG8_STAGE(PG8_SA(0, 0), cA, voffA); PG8_STAGE(PG8_SB(0, 1), cB + hstep, voffB); PG8_STAGE(PG8_SA(0, 1), cA + hstep, voffA);
        if (wr == 1) PG8_BAR;
        PG8_WAIT_V(4); PG8_BAR;
        PG8_STAGE(PG8_SB(1, 0), cB + kstep, voffB); PG8_STAGE(PG8_SA(1, 0), cA + kstep, voffA); PG8_STAGE(PG8_SB(1, 1), cB + hstep + kstep, voffB);
        PG8_WAIT_V(6); PG8_BAR;
    }
    for (;;) {
        const bool has_next = S.next(ui + 1, nxt);
        const char* nA = has_next ? (const char*)g.A + (size_t)nxt.pm * tstep : cA; const char* nB = has_next ? (const char*)g.Bt + (size_t)nxt.pn * tstep : cB;
        for (int t = 0; t < nt; t += 2) {
            const bool last = (t == nt - 2);
            const char* a1 = cA + (size_t)(t + 1) * kstep;
            const char* a2 = last ? nA : cA + (size_t)(t + 2) * kstep; const char* b2 = last ? nB : cB + (size_t)(t + 2) * kstep;
            const char* a3 = a2 + kstep; const char* b3 = b2 + kstep;
            if (last && has_next) S.a_ready(nxt);
            if constexpr (SP2) {
            PG8_LDB(B0, 0, 0); PG8_LDB(B1, 0, 1); PG8_SCHED; PG8_LDA(At, 0, 0); PG8_STAGE(PG8_SA(1, 1), a1 + hstep, voffA);
            PG8_WAIT_V(8); PG8_WAIT_L(0); PG8_BAR; PG8_MMA(0, 0, At, B0); PG8_MMA(0, 1, At, B1); PG8_BAR; PG8_SCHED;
            PG8_LDA(At, 0, 1); PG8_STAGE(PG8_SB(0, 0), b2, voffB); PG8_STAGE(PG8_SB(0, 1), b2 + hstep, voffB); PG8_STAGE(PG8_SA(0, 0), a2, voffA);
            PG8_WAIT_V(8); PG8_WAIT_L(0); PG8_BAR; PG8_MMA(1, 0, At, B0); PG8_MMA(1, 1, At, B1); PG8_BAR; PG8_SCHED;
            PG8_LDB(B0, 1, 0); PG8_LDB(B1, 1, 1); PG8_SCHED; PG8_LDA(At, 1, 0); PG8_STAGE(PG8_SA(0, 1), a2 + hstep, voffA);
            PG8_WAIT_V(8); PG8_WAIT_L(0); PG8_BAR; PG8_MMA(0, 0, At, B0); PG8_MMA(0, 1, At, B1); PG8_BAR; PG8_SCHED;
            PG8_LDA(At, 1, 1); PG8_STAGE(PG8_SB(1, 0), b3, voffB); PG8_STAGE(PG8_SB(1, 1), b3 + hstep, voffB); PG8_STAGE(PG8_SA(1, 0), a3, voffA);
            PG8_WAIT_V(8); PG8_WAIT_L(0); PG8_BAR; PG8_MMA(1, 0, At, B0); PG8_MMA(1, 1, At, B1); PG8_BAR; PG8_SCHED;
            } else {
            PG8_LDB(B0, 0, 0); PG8_SCHED; PG8_LDA(At, 0, 0); PG8_STAGE(PG8_SA(1, 1), a1 + hstep, voffA);
            PG8_WAIT_L(8); PG8_BAR; PG8_WAIT_L(0); PG8_MMA(0, 0, At, B0); PG8_BAR; PG8_SCHED;
            PG8_LDB(B1, 0, 1); PG8_STAGE(PG8_SB(0, 0), b2, voffB);
            PG8_BAR; PG8_WAIT_L(0); PG8_MMA(0, 1, At, B1); PG8_BAR;
            PG8_LDA(At, 0, 1); PG8_STAGE(PG8_SA(0, 0), a2, voffA);
            PG8_BAR; PG8_WAIT_L(0); PG8_MMA(1, 0, At, B0); PG8_BAR; PG8_SCHED;
            PG8_STAGE(PG8_SB(0, 1), b2 + hstep, voffB);
            PG8_WAIT_V(6); PG8_BAR; PG8_MMA(1, 1, At, B1); PG8_BAR;
            PG8_LDB(B0, 1, 0); PG8_SCHED; PG8_LDA(At, 1, 0); PG8_STAGE(PG8_SA(0, 1), a2 + hstep, voffA);
            PG8_WAIT_L(8); PG8_BAR; PG8_WAIT_L(0); PG8_MMA(0, 0, At, B0); PG8_BAR; PG8_SCHED;
            PG8_LDB(B1, 1, 1); PG8_STAGE(PG8_SB(1, 0), b3, voffB);
            PG8_BAR; PG8_WAIT_L(0); PG8_MMA(0, 1, At, B1); PG8_BAR;
            PG8_LDA(At, 1, 1); PG8_STAGE(PG8_SA(1, 0), a3, voffA);
            PG8_BAR; PG8_WAIT_L(0); PG8_MMA(1, 0, At, B0); PG8_BAR; PG8_SCHED;
            PG8_STAGE(PG8_SB(1, 1), b3 + hstep, voffB);
            PG8_WAIT_V(6); PG8_BAR; PG8_MMA(1, 1, At, B1); PG8_BAR;
            }
        }
        if constexpr (ALIGN_EPI) { if (wr == 0) PG8_BAR; }
        if constexpr (!Epi::AFTER_DRAIN) { E(acc, cur, wr, wc, fr, fq); S.done(cur); }
        if (!has_next) break;
#pragma unroll
        for (int a = 0; a < 2; ++a)
#pragma unroll
            for (int b = 0; b < 2; ++b)
#pragma unroll
                for (int m = 0; m < 4; ++m)
#pragma unroll
                    for (int n = 0; n < 2; ++n) acc[a][b][m][n] = (f32x4){0.f, 0.f, 0.f, 0.f};
        cur = nxt; cA = nA; cB = nB; ++ui;
        if constexpr (ALIGN_EPI) { if (wr == 1) PG8_BAR; }
    }
    PG8_WAIT_V(0);
    if constexpr (!ALIGN_EPI) { if (wr == 0) PG8_BAR; }
    PG8_BAR;
    if constexpr (Epi::AFTER_DRAIN) { E.fused(acc, cur, wr, wc, fr, fq, lds, wid, lane); S.done(cur); }
#undef PG8_SA
#undef PG8_SB
#undef PG8_STAGE
#undef PG8_LDA
#undef PG8_LDB
#undef PG8_MMA
#undef PG8_WAIT_V
#undef PG8_WAIT_L
#undef PG8_BAR
#undef PG8_SCHED
}
}
constexpr int NB = 8, SEQ = 4096, DM = 1024, NT = NB * SEQ, DEPTH = 4, DFF = 4096;
constexpr int NZ = 3328;
constexpr int ZQ = 0, ZK = 512, ZV = 1024, ZR = 1536, ZKR = 2048, ZVR = 2560, ZXW = 3072, ZMV = 3232;
constexpr size_t MiB = 1u << 20;
constexpr size_t WS_WIN = 1 * MiB, WS_WOUT = 27 * MiB, WS_WUP = 35 * MiB, WS_WDN = 67 * MiB, WS_LT = 99 * MiB;
constexpr size_t WS_XN = 100 * MiB, WS_VF = 164 * MiB, WS_BON = 196 * MiB, WS_BIG = 198 * MiB;
constexpr size_t WS_Z = WS_BIG, WS_YS = 406 * MiB, WS_G = 438 * MiB, WS_VC = 470 * MiB, WS_H = WS_BIG, WS_Y1 = WS_BIG, WS_END = 502 * MiB;
constexpr int LDS_BYTES = 147456;

#define LAS __attribute__((address_space(3)))
typedef unsigned short bf16;
typedef float f32x4 __attribute__((ext_vector_type(4)));
typedef unsigned u32x4 __attribute__((ext_vector_type(4)));
typedef unsigned u32x2 __attribute__((ext_vector_type(2)));
typedef short bf16x8 __attribute__((ext_vector_type(8)));
typedef short s16x4 __attribute__((ext_vector_type(4)));

__device__ __forceinline__ float bf2f(unsigned u) { return __uint_as_float(u << 16); }
__device__ __forceinline__ float bflo(unsigned u) { return __uint_as_float(u << 16); }
__device__ __forceinline__ float bfhi(unsigned u) { return __uint_as_float(u & 0xffff0000u); }
__device__ __forceinline__ unsigned f2bf(float f) { unsigned u = __float_as_uint(f); return (u + 0x7fffu + ((u >> 16) & 1u)) >> 16; }
__device__ __forceinline__ unsigned pk2(float lo, float hi) { return f2bf(lo) | (f2bf(hi) << 16); }
__device__ __forceinline__ float wave_sum(float v) {
#pragma unroll
    for (int o = 1; o < 64; o <<= 1) v += __shfl_xor(v, o);
    return v;
}
__device__ __forceinline__ float dppf(float v, const int ctrl_sel) {
    int r;
    if (ctrl_sel == 0) r = __builtin_amdgcn_update_dpp(0, __float_as_int(v), 0xB1, 0xF, 0xF, false);
    else if (ctrl_sel == 1) r = __builtin_amdgcn_update_dpp(0, __float_as_int(v), 0x4E, 0xF, 0xF, false);
    else if (ctrl_sel == 2) r = __builtin_amdgcn_update_dpp(0, __float_as_int(v), 0x141, 0xF, 0xF, false);
    else r = __builtin_amdgcn_update_dpp(0, __float_as_int(v), 0x140, 0xF, 0xF, false);
    return __int_as_float(r);
}
__device__ __forceinline__ float rowsum16(float v) { v += dppf(v, 0); v += dppf(v, 1); v += dppf(v, 2); v += dppf(v, 3); return v; }
__device__ __forceinline__ float sigmoidf_(float x) { return 1.0f / (1.0f + __expf(-x)); }

struct Params { const float* in[25]; float* out; unsigned char* ws; int ph_lo, ph_hi; };
#define MK_IDS const int tid = pg8::mk_tid(wave_s), lane = tid & 63, wave = __builtin_amdgcn_readfirstlane(tid >> 6); const int gw = blockIdx.x * 8 + wave; (void)gw; (void)lane

__device__ __forceinline__ void transpose_item(const float* W, int K, int N, bf16* WT, LAS float* scr, int item, int lane) {
    const int nblk = N / 32, kb = item / nblk, nb = item % nblk, k0 = 64 * kb, n0 = 32 * nb;
#pragma unroll 8
    for (int i = 0; i < 32; ++i) { const int kk = 2 * i + (lane >> 5); scr[kk * 33 + (lane & 31)] = W[(size_t)(k0 + kk) * N + n0 + (lane & 31)]; }
    asm volatile("s_waitcnt lgkmcnt(0)" ::: "memory");
    const int c = lane & 7;
#pragma unroll
    for (int j = 0; j < 4; ++j) { const int n = (lane >> 3) + 8 * j; const LAS float* s = scr + (8 * c) * 33 + n;
        u32x4 o; o.x = pk2(s[0 * 33], s[1 * 33]); o.y = pk2(s[2 * 33], s[3 * 33]); o.z = pk2(s[4 * 33], s[5 * 33]); o.w = pk2(s[6 * 33], s[7 * 33]);
        *(u32x4*)(WT + (size_t)(n0 + n) * K + k0 + 8 * c) = o; }
    asm volatile("s_waitcnt lgkmcnt(0)" ::: "memory");
}

__device__ __forceinline__ void prologue(const Params& p, LAS unsigned char* lds, int gw, int NGW, int wave, int lane) {
    unsigned char* ws = p.ws;
    LAS float* scr = (LAS float*)(lds + wave * 16384);
    constexpr int I_IN0 = 16 * 101, I_INR = 16 * 102, I_OUT = 16 * 32, I_UP = 16 * 128, I_DN = 64 * 32;
    constexpr int NITEMS = I_IN0 + 3 * I_INR + 4 * I_OUT + 4 * I_UP + 4 * I_DN;
    for (int it = gw; it < NITEMS; it += NGW) {
        int r = it;
        if (r < I_IN0) { transpose_item(p.in[5], 1024, 3232, (bf16*)(ws + WS_WIN), scr, r, lane); continue; } r -= I_IN0;
        if (r < 3 * I_INR) { const int l = r / I_INR; transpose_item(p.in[6] + (size_t)l * 1024 * 3264, 1024, 3264, (bf16*)(ws + WS_WIN) + (size_t)(l + 1) * NZ * 1024, scr, r % I_INR, lane); continue; } r -= 3 * I_INR;
        if (r < 4 * I_OUT) { const int l = r / I_OUT; transpose_item(p.in[22] + (size_t)l * 1024 * 1024, 1024, 1024, (bf16*)(ws + WS_WOUT) + (size_t)l * 1024 * 1024, scr, r % I_OUT, lane); continue; } r -= 4 * I_OUT;
        if (r < 4 * I_UP) { const int l = r / I_UP; transpose_item(p.in[23] + (size_t)l * 1024 * 4096, 1024, 4096, (bf16*)(ws + WS_WUP) + (size_t)l * 4096 * 1024, scr, r % I_UP, lane); continue; } r -= 4 * I_UP;
        { const int l = r / I_DN; transpose_item(p.in[24] + (size_t)l * 4096 * 1024, 4096, 1024, (bf16*)(ws + WS_WDN) + (size_t)l * 1024 * 4096, scr, r % I_DN, lane); }
    }
    {
        const int gt = gw * 64 + lane, NG = NGW * 64;
        const u32x4 z4 = {0u, 0u, 0u, 0u};
        for (int l = 0; l < 4; ++l) { const int r0 = (l == 0) ? 3232 : 3264; const int nvec = (NZ - r0) * 1024 / 8;
            u32x4* base = (u32x4*)((bf16*)(ws + WS_WIN) + ((size_t)l * NZ + r0) * 1024);
            for (int i = gt; i < nvec; i += NG) base[i] = z4; }
        bf16* LT = (bf16*)(ws + WS_LT);
        for (int i = gt; i < 4 * 512 * 192; i += NG) { const int l = i / (512 * 192), rem = i % (512 * 192), c = rem / 192, m = rem % 192; float v;
            if (m < 32) v = p.in[11][((size_t)l * 32 + m) * 512 + c];
            else if (m < 64) v = p.in[13][((size_t)l * 32 + (m - 32)) * 512 + c];
            else if (m < 160) v = p.in[16][((size_t)l * 96 + (m - 64)) * 512 + c];
            else v = (l > 0) ? p.in[15][((size_t)(l - 1) * 32 + (m - 160)) * 512 + c] : 0.f;
            LT[i] = (bf16)f2bf(v); }
    }
    const float* x = p.in[0]; const float* g = p.in[1]; bf16* XN = (bf16*)(ws + WS_XN);
    for (int row = gw; row < NT; row += NGW) {
        const f32x4* xr = (const f32x4*)(x + (size_t)row * DM) + lane; f32x4* orow = (f32x4*)(p.out + (size_t)row * DM) + lane;
        f32x4 v[4]; float s = 0.f;
#pragma unroll
        for (int j = 0; j < 4; ++j) { v[j] = xr[64 * j]; orow[64 * j] = v[j]; s += (v[j].x * v[j].x + v[j].y * v[j].y) + (v[j].z * v[j].z + v[j].w * v[j].w); }
        const float rstd = 1.0f / sqrtf(wave_sum(s) * (1.0f / DM) + 1e-6f);
        u32x2* o8 = (u32x2*)(XN + (size_t)row * DM) + lane;
#pragma unroll
        for (int j = 0; j < 4; ++j) { const f32x4 gg = ((const f32x4*)g)[lane + 64 * j]; u32x2 w; w.x = pk2(v[j].x * rstd * gg.x, v[j].y * rstd * gg.y); w.y = pk2(v[j].z * rstd * gg.z, v[j].w * rstd * gg.w); o8[64 * j] = w; }
    }
}

__device__ __forceinline__ void norm_phase(const bf16* Y, float* X, bf16* XN, const float* gpost, const float* gnext, int gw, int NGW, int lane) {
    for (int row = gw; row < NT; row += NGW) {
        const u32x4* yr = (const u32x4*)(Y + (size_t)row * DM); f32x4* xr = (f32x4*)(X + (size_t)row * DM);
        float y[16]; float ss = 0.f;
#pragma unroll
        for (int k = 0; k < 2; ++k) { const u32x4 w = yr[k * 64 + lane];
            y[k * 8 + 0] = bflo(w.x); y[k * 8 + 1] = bfhi(w.x); y[k * 8 + 2] = bflo(w.y); y[k * 8 + 3] = bfhi(w.y); y[k * 8 + 4] = bflo(w.z); y[k * 8 + 5] = bfhi(w.z); y[k * 8 + 6] = bflo(w.w); y[k * 8 + 7] = bfhi(w.w); }
#pragma unroll
        for (int e = 0; e < 16; ++e) ss += y[e] * y[e];
        const float rstd = 1.0f / sqrtf(wave_sum(ss) * (1.0f / DM) + 1e-6f);
        float xn[16]; float s2 = 0.f;
#pragma unroll
        for (int k = 0; k < 2; ++k)
#pragma unroll
            for (int q = 0; q < 2; ++q) { const int vi = k * 128 + lane * 2 + q; f32x4 xv = xr[vi]; const f32x4 gg = ((const f32x4*)gpost)[vi];
#pragma unroll
                for (int e = 0; e < 4; ++e) { const float t = xv[e] + y[k * 8 + q * 4 + e] * rstd * gg[e]; xv[e] = t; xn[k * 8 + q * 4 + e] = t; s2 += t * t; }
                xr[vi] = xv; }
        if (gnext) {
            const float r2 = 1.0f / sqrtf(wave_sum(s2) * (1.0f / DM) + 1e-6f);
            u32x4* o = (u32x4*)(XN + (size_t)row * DM);
#pragma unroll
            for (int k = 0; k < 2; ++k) { const f32x4 g0 = ((const f32x4*)gnext)[k * 128 + lane * 2], g1 = ((const f32x4*)gnext)[k * 128 + lane * 2 + 1]; u32x4 w;
                w.x = pk2(xn[k * 8 + 0] * r2 * g0.x, xn[k * 8 + 1] * r2 * g0.y); w.y = pk2(xn[k * 8 + 2] * r2 * g0.z, xn[k * 8 + 3] * r2 * g0.w);
                w.z = pk2(xn[k * 8 + 4] * r2 * g1.x, xn[k * 8 + 5] * r2 * g1.y); w.w = pk2(xn[k * 8 + 6] * r2 * g1.z, xn[k * 8 + 7] * r2 * g1.w);
                o[k * 64 + lane] = w; }
        }
    }
}

__device__ __forceinline__ void post_phase(bf16* MIX, const bf16* YS, const bf16* GB, const bf16* VC, const float* BON, const float* again, const float* gnw, const float* gnb, int gw, int NGW, int lane) {
    for (int row = gw; row < NT; row += NGW) {
        u32x4* mrow = (u32x4*)(MIX + (size_t)row * DM);
        {
            const u32x4 w = mrow[lane]; float o[8] = {bflo(w.x), bfhi(w.x), bflo(w.y), bfhi(w.y), bflo(w.z), bfhi(w.z), bflo(w.w), bfhi(w.w)}; float ss = 0.f;
#pragma unroll
            for (int e = 0; e < 8; ++e) ss += o[e] * o[e];
            const float rstd = 1.0f / sqrtf(wave_sum(ss) * (1.0f / 512.0f) + 1e-6f);
            const f32x4 g0 = ((const f32x4*)again)[lane * 2], g1 = ((const f32x4*)again)[lane * 2 + 1]; u32x4 r;
            r.x = pk2(o[0] * rstd * g0.x, o[1] * rstd * g0.y); r.y = pk2(o[2] * rstd * g0.z, o[3] * rstd * g0.w); r.z = pk2(o[4] * rstd * g1.x, o[5] * rstd * g1.y); r.w = pk2(o[6] * rstd * g1.z, o[7] * rstd * g1.w);
            mrow[lane] = r;
        }
        {
            const u32x4 w = ((const u32x4*)(YS + (size_t)row * 512))[lane]; float y[8] = {bflo(w.x), bfhi(w.x), bflo(w.y), bfhi(w.y), bflo(w.z), bfhi(w.z), bflo(w.w), bfhi(w.w)};
            float s1 = 0.f;
#pragma unroll
            for (int e = 0; e < 8; ++e) s1 += y[e];
            s1 += __shfl_xor(s1, 1); s1 += __shfl_xor(s1, 2); s1 += __shfl_xor(s1, 4);
            const float mean = s1 * (1.0f / 64.0f); float s2 = 0.f;
#pragma unroll
            for (int e = 0; e < 8; ++e) { y[e] -= mean; s2 += y[e] * y[e]; }
            s2 += __shfl_xor(s2, 1); s2 += __shfl_xor(s2, 2); s2 += __shfl_xor(s2, 4);
            const float rs = 1.0f / sqrtf(s2 * (1.0f / 64.0f) + 64e-5f);
            const u32x4 vw = ((const u32x4*)(VC + (size_t)row * 512))[lane], gw4 = ((const u32x4*)(GB + (size_t)row * 512))[lane];
            const float v[8] = {bflo(vw.x), bfhi(vw.x), bflo(vw.y), bfhi(vw.y), bflo(vw.z), bfhi(vw.z), bflo(vw.w), bfhi(vw.w)};
            const float g[8] = {bflo(gw4.x), bfhi(gw4.x), bflo(gw4.y), bfhi(gw4.y), bflo(gw4.z), bfhi(gw4.z), bflo(gw4.w), bfhi(gw4.w)};
            const float bon = BON[(size_t)row * 8 + (lane >> 3)];
            const f32x4 w0 = ((const f32x4*)gnw)[lane * 2], w1 = ((const f32x4*)gnw)[lane * 2 + 1], b0 = ((const f32x4*)gnb)[lane * 2], b1 = ((const f32x4*)gnb)[lane * 2 + 1];
            const float gwv[8] = {w0.x, w0.y, w0.z, w0.w, w1.x, w1.y, w1.z, w1.w}, gbv[8] = {b0.x, b0.y, b0.z, b0.w, b1.x, b1.y, b1.z, b1.w};
            float o[8];
#pragma unroll
            for (int e = 0; e < 8; ++e) o[e] = (y[e] * rs * gwv[e] + gbv[e] + bon * v[e]) * g[e];
            u32x4 r; r.x = pk2(o[0], o[1]); r.y = pk2(o[2], o[3]); r.z = pk2(o[4], o[5]); r.w = pk2(o[6], o[7]);
            mrow[64 + lane] = r;
        }
    }
}

__device__ __forceinline__ void attn_unit(LAS unsigned char* lds, const bf16* Z, bf16* MIX, int unit, int wave, int lane) {
    const int b = unit >> 4, t0 = (unit & 15) * 256;
    LAS float* ACC = (LAS float*)lds;
    LAS float* ML = (LAS float*)(lds + 256 * 68 * 4);
    LAS unsigned char* VST = lds + 256 * 68 * 4 + 2048 + wave * 4096;
    const int li = lane & 15, quad = lane >> 4;
    const float C = 0.125f * 1.4426950408889634f;
    const size_t rowbase = (size_t)b * SEQ;
    for (int h = 0; h < 8; ++h) {
#pragma unroll 1
        for (int br = 0; br < 3; ++br) {
            const int lg = br * 2; const int L = SEQ >> lg;
#pragma unroll 1
            for (int u = 0; u < 2; ++u) {
                const int tu = wave * 2 + u;
                int r, i0;
                if (br == 0) { r = 0; i0 = t0 + tu * 16; } else if (br == 1) { r = tu & 3; i0 = (t0 >> 2) + (tu >> 2) * 16; } else { r = tu; i0 = t0 >> 4; }
                const int tq = ((i0 + li) << lg) + r;
                const bf16* qp = Z + (rowbase + tq) * NZ + ZQ + h * 64 + quad * 8;
                const bf16x8 q0 = *(const bf16x8*)qp, q1 = *(const bf16x8*)(qp + 32);
                f32x4 s[9];
#pragma unroll
                for (int kt = 0; kt < 9; ++kt) {
                    int ik = i0 - 128 + kt * 16 + li; ik = ik < 0 ? 0 : ik;
                    const bf16* kp = Z + (rowbase + (ik << lg) + r) * NZ + ZK + h * 64 + quad * 8;
                    const bf16x8 k0 = *(const bf16x8*)kp, k1 = *(const bf16x8*)(kp + 32);
                    f32x4 a = {0.f, 0.f, 0.f, 0.f};
                    a = __builtin_amdgcn_mfma_f32_16x16x32_bf16(k0, q0, a, 0, 0, 0);
                    a = __builtin_amdgcn_mfma_f32_16x16x32_bf16(k1, q1, a, 0, 0, 0);
                    s[kt] = a;
                }
                u32x4 vv[5][4];
#pragma unroll
                for (int cc = 0; cc < 5; ++cc)
#pragma unroll
                    for (int it = 0; it < 4; ++it) { const int idx = it * 64 + lane, rr = idx >> 3, c16 = idx & 7; int ik = i0 - 128 + cc * 32 + rr; ik = ik < 0 ? 0 : (ik > L - 1 ? L - 1 : ik);
                        vv[cc][it] = *(const u32x4*)(Z + (rowbase + (ik << lg) + r) * NZ + ZV + h * 64 + c16 * 8); }
                float mx = -1e30f;
#pragma unroll
                for (int kt = 0; kt < 9; ++kt)
#pragma unroll
                    for (int j = 0; j < 4; ++j) { const int key = kt * 16 + quad * 4 + j; const int dist = 128 + li - key; const int ik = i0 - 128 + key;
                        const bool valid = (dist >= 0) && (dist <= 128) && (ik >= 0);
                        const float sv = valid ? s[kt][j] : -1e30f; s[kt][j] = sv; mx = fmaxf(mx, sv); }
                mx = fmaxf(mx, __shfl_xor(mx, 16)); mx = fmaxf(mx, __shfl_xor(mx, 32));
                float lsum = 0.f;
#pragma unroll
                for (int kt = 0; kt < 9; ++kt)
#pragma unroll
                    for (int j = 0; j < 4; ++j) { const float pv = __builtin_amdgcn_exp2f((s[kt][j] - mx) * C); s[kt][j] = pv; lsum += pv; }
                lsum += __shfl_xor(lsum, 16); lsum += __shfl_xor(lsum, 32);
                f32x4 o[4];
#pragma unroll
                for (int dt = 0; dt < 4; ++dt) o[dt] = (f32x4){0.f, 0.f, 0.f, 0.f};
#pragma unroll
                for (int cc = 0; cc < 5; ++cc) {
                    asm volatile("s_waitcnt lgkmcnt(0)" ::: "memory");
#pragma unroll
                    for (int it = 0; it < 4; ++it) { const int idx = it * 64 + lane, rr = idx >> 3, c16 = idx & 7;
                        *(LAS u32x4*)(VST + rr * 128 + c16 * 16) = vv[cc][it]; }
                    asm volatile("s_waitcnt lgkmcnt(0)" ::: "memory");
                    bf16x8 pa;
                    { const f32x4 p0 = s[2 * cc]; const unsigned a0 = pk2(p0[0], p0[1]), a1 = pk2(p0[2], p0[3]); unsigned a2 = 0u, a3 = 0u;
                      if (cc < 4) { const f32x4 p1 = s[2 * cc + 1 < 9 ? 2 * cc + 1 : 8]; a2 = pk2(p1[0], p1[1]); a3 = pk2(p1[2], p1[3]); }
                      const u32x4 pw = {a0, a1, a2, a3}; pa = __builtin_bit_cast(bf16x8, pw); }
#pragma unroll
                    for (int dt = 0; dt < 4; ++dt) {
                        LAS unsigned char* ap = VST + (quad * 4 + (li >> 2)) * 128 + (dt * 16 + (li & 3) * 4) * 2;
                        const s16x4 b1 = __builtin_bit_cast(s16x4, __builtin_amdgcn_ds_read_tr16_b64_v4i16((LAS s16x4*)ap));
                        const s16x4 b2 = __builtin_bit_cast(s16x4, __builtin_amdgcn_ds_read_tr16_b64_v4i16((LAS s16x4*)(ap + 16 * 128)));
                        const bf16x8 vb = {b1[0], b1[1], b1[2], b1[3], b2[0], b2[1], b2[2], b2[3]};
                        o[dt] = __builtin_amdgcn_mfma_f32_16x16x32_bf16(pa, vb, o[dt], 0, 0, 0);
                    }
                }
#pragma unroll
                for (int j = 0; j < 4; ++j) {
                    const int qq = quad * 4 + j;
                    const float mr = __shfl(mx, qq), lr = __shfl(lsum, qq);
                    const int tl = (br == 0) ? tu * 16 + qq : (br == 1) ? ((((tu >> 2) * 16 + qq) << 2) + (tu & 3)) : qq * 16 + tu;
                    LAS float* arow = ACC + tl * 68;
                    if (br == 0) {
#pragma unroll
                        for (int dt = 0; dt < 4; ++dt) arow[dt * 16 + li] = o[dt][j];
                        if (li == 0) { ML[tl * 2] = mr; ML[tl * 2 + 1] = lr; }
                    } else {
                        const float m0 = ML[tl * 2], l0 = ML[tl * 2 + 1];
                        const float mn = fmaxf(m0, mr); const float a0 = __builtin_amdgcn_exp2f((m0 - mn) * C), a1 = __builtin_amdgcn_exp2f((mr - mn) * C);
                        const float ln = l0 * a0 + lr * a1;
                        float val[4];
#pragma unroll
                        for (int dt = 0; dt < 4; ++dt) val[dt] = arow[dt * 16 + li] * a0 + o[dt][j] * a1;
                        asm volatile("s_waitcnt lgkmcnt(0)" ::: "memory");
                        if (br == 1) {
#pragma unroll
                            for (int dt = 0; dt < 4; ++dt) arow[dt * 16 + li] = val[dt];
                            if (li == 0) { ML[tl * 2] = mn; ML[tl * 2 + 1] = ln; }
                        } else {
                            const float inv = 1.0f / ln; bf16* orow = MIX + (rowbase + t0 + tl) * DM + h * 64 + li;
#pragma unroll
                            for (int dt = 0; dt < 4; ++dt) orow[dt * 16] = (bf16)f2bf(val[dt] * inv);
                        }
                    }
                }
            }
            __syncthreads();
        }
    }
}

constexpr int TC = 32, NCH = SEQ / TC;
constexpr int SB_STRIDE = 49152, SC_RS = 0, SC_WW = 8192, SC_KS = 16384, SC_KK = 24576, SC_BV = 32768, SC_VS = 40960;
constexpr int ACT_PITCH = 400, SC_ACT = 2 * SB_STRIDE, SC_LTS = SC_ACT + 4 * 8 * ACT_PITCH, SC_MU = SC_LTS + 64 * ACT_PITCH, SC_INV = SC_MU + 1536, SC_CT = SC_INV + 128;
static_assert(SC_CT + 1536 <= LDS_BYTES, "scan LDS map");
__device__ __forceinline__ float rowsum8(float v) { v += dppf(v, 0); v += dppf(v, 1); v += dppf(v, 2); return v; }
typedef float f32x2 __attribute__((ext_vector_type(2)));
struct ScanVec { f32x4 w0, w1, k0, k1, b0, b1, x0, x1, r0, r1; float v; };
__device__ __forceinline__ ScanVec scan_load(LAS const unsigned char* buf, int t, int j0, int irow) {
    ScanVec s; const LAS float* W = (const LAS float*)(buf + SC_WW) + t * 64 + j0; const LAS float* K = (const LAS float*)(buf + SC_KK) + t * 64 + j0; const LAS float* B = (const LAS float*)(buf + SC_BV) + t * 64 + j0;
    const LAS float* X = (const LAS float*)(buf + SC_KS) + t * 64 + j0; const LAS float* R = (const LAS float*)(buf + SC_RS) + t * 64 + j0;
    s.w0 = *(const LAS f32x4*)W; s.w1 = *(const LAS f32x4*)(W + 4); s.k0 = *(const LAS f32x4*)K; s.k1 = *(const LAS f32x4*)(K + 4); s.b0 = *(const LAS f32x4*)B; s.b1 = *(const LAS f32x4*)(B + 4);
    s.x0 = *(const LAS f32x4*)X; s.x1 = *(const LAS f32x4*)(X + 4); s.r0 = *(const LAS f32x4*)R; s.r1 = *(const LAS f32x4*)(R + 4); s.v = ((const LAS float*)(buf + SC_VS))[t * 64 + irow];
    return s;
}
#define LO2(a) ((f32x2){(a).x, (a).y})
#define HI2(a) ((f32x2){(a).z, (a).w})
__device__ __forceinline__ void scan_unit(LAS unsigned char* lds, const Params& p, int layer, int unit, int tid, int wave, int lane) {
    const int chain = unit >> 1, hf = unit & 1, b = chain >> 3, h = chain & 7;
    unsigned char* ws = p.ws;
    const bf16* Z = (const bf16*)(ws + WS_Z); bf16* VF = (bf16*)(ws + WS_VF); bf16* YS = (bf16*)(ws + WS_YS); bf16* GB = (bf16*)(ws + WS_G); bf16* VC = (bf16*)(ws + WS_VC); float* BON = (float*)(ws + WS_BON);
    const bf16* LT = (const bf16*)(ws + WS_LT) + (size_t)layer * 512 * 192;
    const float* mu = p.in[7] + (size_t)layer * 1696; const float* mumv = (layer > 0) ? p.in[8] + (size_t)(layer - 1) * 32 : nullptr;
    const size_t rowbase = (size_t)b * SEQ;
    LAS float* MU = (LAS float*)(lds + SC_MU); LAS unsigned char* LTS = lds + SC_LTS;
    if (tid < 96) { const int cgp = tid, cat = cgp >> 4; const int zc = (cat < 3) ? ZR + cat * 512 + h * 64 + (cgp & 15) * 4 : ZXW + (cgp - 48) * 4;
        const bool ismv = zc >= ZMV; const float* src = ismv ? (mumv ? mumv + (zc - ZMV) : mu) : mu + (zc - ZR);
        f32x4 m4 = *(const f32x4*)src; if (ismv && !mumv) m4 = (f32x4){0.f, 0.f, 0.f, 0.f};
        *(LAS f32x4*)(MU + cgp * 4) = m4; }
    if (tid < 384) { const int arr = tid >> 6, c = tid & 63, gi = layer * 512 + h * 64 + c; float v;
        if (arr == 0) v = p.in[10][gi]; else if (arr == 1) v = p.in[12][gi]; else if (arr == 2) v = (layer > 0) ? p.in[14][(layer - 1) * 512 + h * 64 + c] : 0.f; else if (arr == 3) v = p.in[17][gi]; else if (arr == 4) v = p.in[18][gi]; else v = p.in[19][gi];
        ((LAS float*)(lds + SC_CT))[tid] = v; }
    for (int i = tid; i < 64 * 24; i += 512) { const int c = i / 24, ch = i % 24; *(LAS u32x4*)(LTS + c * ACT_PITCH + ch * 16) = *(const u32x4*)(LT + (size_t)(h * 64 + c) * 192 + ch * 8); }
    __syncthreads();
    if (wave < 4) {
        const int rl = wave * 8 + (lane >> 3), irow = hf * 32 + rl, q = lane & 7, j0 = q * 8;
        f32x2 S0 = {0.f, 0.f}, S1 = {0.f, 0.f}, S2 = {0.f, 0.f}, S3 = {0.f, 0.f}; float ykeep = 0.f;
        __syncthreads();
#pragma unroll 1
        for (int c = 0; c < NCH; ++c) {
            LAS const unsigned char* buf = lds + (c & 1) * SB_STRIDE;
            const int tch = c * TC;
            ScanVec cur = scan_load(buf, 0, j0, irow);
#pragma unroll
            for (int t = 0; t < TC; ++t) {
                ScanVec nx; if (t + 1 < TC) nx = scan_load(buf, t + 1, j0, irow); else nx = cur;
                f32x2 d = S0 * LO2(cur.k0); d = S1 * HI2(cur.k0) + d; d = S2 * LO2(cur.k1) + d; d = S3 * HI2(cur.k1) + d;
                float sa = rowsum8(d.x + d.y);
                const f32x2 v2 = {cur.v, cur.v}, sa2 = {sa, sa};
                S0 = S0 * LO2(cur.w0) + (v2 * LO2(cur.x0) - sa2 * LO2(cur.b0)); S1 = S1 * HI2(cur.w0) + (v2 * HI2(cur.x0) - sa2 * HI2(cur.b0));
                S2 = S2 * LO2(cur.w1) + (v2 * LO2(cur.x1) - sa2 * LO2(cur.b1)); S3 = S3 * HI2(cur.w1) + (v2 * HI2(cur.x1) - sa2 * HI2(cur.b1));
                f32x2 e = S0 * LO2(cur.r0); e = S1 * HI2(cur.r0) + e; e = S2 * LO2(cur.r1) + e; e = S3 * HI2(cur.r1) + e;
                const float y = rowsum8(e.x + e.y);
                ykeep = (q == (t & 7)) ? y : ykeep;
                if ((t & 7) == 7) YS[(rowbase + tch + (t & ~7) + q) * 512 + h * 64 + irow] = (bf16)f2bf(ykeep);
                cur = nx;
            }
            __syncthreads();
        }
    } else {
        const int pw = wave - 4, s = lane >> 3, q = lane & 7, li = lane & 15, quad = lane >> 4;
        LAS unsigned char* ACT = lds + SC_ACT + pw * 8 * ACT_PITCH; LAS float* INV = (LAS float*)(lds + SC_INV) + pw * 8;
        const LAS float* CT = (const LAS float*)(lds + SC_CT);
        u32x2 pc[12], pp[12]; u32x4 pvf[2];
        pvf[0] = (u32x4){0u, 0u, 0u, 0u}; pvf[1] = pvf[0];
#define PR_OFF(k) ((k) < 2 ? (ZR - ZKR) + (k) * 32 : (k) < 4 ? ((k) - 2) * 32 : (k) < 6 ? (ZVR - ZKR) + ((k) - 4) * 32 : ((k) - 6) * 32)
#define PR_ISSUE(tchv) do { const int tg = (tchv) + pw * 8 + s; const int tgp = tg > 0 ? tg - 1 : 0; \
        const bf16* c1 = Z + (rowbase + tg) * NZ + ZKR + h * 64 + q * 4; const bf16* c2 = Z + (rowbase + tg) * NZ + ZXW + q * 4; \
        const bf16* p1 = Z + (rowbase + tgp) * NZ + ZKR + h * 64 + q * 4; const bf16* p2 = Z + (rowbase + tgp) * NZ + ZXW + q * 4; \
        asm volatile("" : "+v"(c1), "+v"(c2), "+v"(p1), "+v"(p2)); \
        _Pragma("unroll") for (int k = 0; k < 12; ++k) { pc[k] = *(const __attribute__((address_space(1))) u32x2*)((k < 6 ? c1 : c2) + PR_OFF(k)); pp[k] = *(const __attribute__((address_space(1))) u32x2*)((k < 6 ? p1 : p2) + PR_OFF(k)); } \
        if (layer > 0) { pvf[0] = *(const u32x4*)(VF + (rowbase + (tchv) + pw * 8 + s) * 512 + h * 64 + q * 8); } } while (0)
        PR_ISSUE(0);
#pragma unroll 1
        for (int c = 0; c <= NCH; ++c) {
            if (c < NCH) {
                const int tch = c * TC;
                LAS unsigned char* buf = lds + (c & 1) * SB_STRIDE;
                LAS float* RS = (LAS float*)(buf + SC_RS); LAS float* WW = (LAS float*)(buf + SC_WW); LAS float* KS = (LAS float*)(buf + SC_KS); LAS float* KK = (LAS float*)(buf + SC_KK);
                LAS float* BV = (LAS float*)(buf + SC_BV); LAS float* VS = (LAS float*)(buf + SC_VS);
                const u32x4 cvf0 = pvf[0];
                const float pz = (tch + pw * 8 + s > 0) ? 1.0f : 0.0f;
                const int trow = pw * 8 + s;
#pragma unroll
                for (int k = 0; k < 12; ++k) {
                    const u32x2 cw = pc[k], pw2 = pp[k];
                    const f32x4 m4 = *(const LAS f32x4*)(MU + (k * 8 + q) * 4);
                    const float c0 = bflo(cw.x), c1 = bfhi(cw.x), c2 = bflo(cw.y), c3 = bfhi(cw.y), p0 = bflo(pw2.x) * pz, p1 = bfhi(pw2.x) * pz, p2 = bflo(pw2.y) * pz, p3 = bfhi(pw2.y) * pz;
                    f32x4 v = {c0 + (p0 - c0) * m4.x, c1 + (p1 - c1) * m4.y, c2 + (p2 - c2) * m4.z, c3 + (p3 - c3) * m4.w};
                    if (k < 2) *(LAS f32x4*)(RS + trow * 64 + (k * 8 + q) * 4) = v;
                    else if (k < 4) *(LAS f32x4*)(KS + trow * 64 + ((k - 2) * 8 + q) * 4) = v;
                    else if (k < 6) *(LAS f32x4*)(VS + trow * 64 + ((k - 4) * 8 + q) * 4) = v;
                    else {
                        const int ac = ((k - 6) * 8 + q) * 4;
                        if (k == 6) {
#pragma unroll
                            for (int e = 0; e < 4; ++e) v[e] = 1.0f - 2.0f * __builtin_amdgcn_rcpf(1.0f + __expf(2.0f * v[e])); }
                        else if (k >= 8 && k <= 10) {
#pragma unroll
                            for (int e = 0; e < 4; ++e) v[e] = __builtin_amdgcn_rcpf(1.0f + __expf(-v[e])); }
                        u32x2 w; w.x = pk2(v.x, v.y); w.y = pk2(v.z, v.w); *(LAS u32x2*)(ACT + s * ACT_PITCH + ac * 2) = w; }
                }
                if (c + 1 < NCH) PR_ISSUE(tch + TC);
                asm volatile("s_waitcnt lgkmcnt(0)" ::: "memory");
                { const f32x4 ka = *(const LAS f32x4*)(KS + trow * 64 + q * 8), kb = *(const LAS f32x4*)(KS + trow * 64 + q * 8 + 4); const f32x4 kc0 = *(const LAS f32x4*)(CT + 3 * 64 + q * 8), kc1 = *(const LAS f32x4*)(CT + 3 * 64 + q * 8 + 4); const float kkl[8] = {kc0.x, kc0.y, kc0.z, kc0.w, kc1.x, kc1.y, kc1.z, kc1.w};
                  float ss = ((ka.x * kkl[0]) * (ka.x * kkl[0]) + (ka.y * kkl[1]) * (ka.y * kkl[1])) + ((ka.z * kkl[2]) * (ka.z * kkl[2]) + (ka.w * kkl[3]) * (ka.w * kkl[3]));
                  ss += ((kb.x * kkl[4]) * (kb.x * kkl[4]) + (kb.y * kkl[5]) * (kb.y * kkl[5])) + ((kb.z * kkl[6]) * (kb.z * kkl[6]) + (kb.w * kkl[7]) * (kb.w * kkl[7]));
                  ss = rowsum8(ss);
                  if (q == 0) INV[s] = 1.0f / fmaxf(sqrtf(ss), 1e-12f); }
                asm volatile("s_waitcnt lgkmcnt(0)" ::: "memory");
                {
                    bf16x8 Af[6];
#pragma unroll
                    for (int ks = 0; ks < 6; ++ks) Af[ks] = *(const LAS bf16x8*)(ACT + (li & 7) * ACT_PITCH + ks * 64 + quad * 16);
                    asm volatile("s_waitcnt lgkmcnt(0)" ::: "memory");
                    LAS float* GT = (LAS float*)ACT;
                    const int lbase = (pw * 8 + (quad & 1) * 4) * 64 + li;
#pragma unroll
                    for (int ct = 0; ct < 4; ++ct) {
                        bf16x8 Bf[6];
#pragma unroll
                        for (int ks = 0; ks < 6; ++ks) Bf[ks] = *(const LAS bf16x8*)(LTS + (ct * 16 + li) * ACT_PITCH + ks * 64 + quad * 16);
                        const f32x4 z4 = {0.f, 0.f, 0.f, 0.f};
                        const f32x4 LW = __builtin_amdgcn_mfma_f32_16x16x32_bf16(Af[0], Bf[0], z4, 0, 0, 0);
                        const f32x4 AA = __builtin_amdgcn_mfma_f32_16x16x32_bf16(Af[1], Bf[1], z4, 0, 0, 0);
                        f32x4 G = __builtin_amdgcn_mfma_f32_16x16x32_bf16(Af[2], Bf[2], z4, 0, 0, 0);
                        G = __builtin_amdgcn_mfma_f32_16x16x32_bf16(Af[3], Bf[3], G, 0, 0, 0);
                        G = __builtin_amdgcn_mfma_f32_16x16x32_bf16(Af[4], Bf[4], G, 0, 0, 0);
                        const f32x4 VG = __builtin_amdgcn_mfma_f32_16x16x32_bf16(Af[5], Bf[5], z4, 0, 0, 0);
                        if (quad < 2) {
#pragma unroll
                            for (int j = 0; j < 4; ++j) { const int lo = lbase + j * 64 + ct * 16; WW[lo] = LW[j]; KK[lo] = AA[j]; BV[lo] = VG[j]; GT[((quad & 1) * 4 + j) * 64 + ct * 16 + li] = G[j]; }
                        }
                    }
                }
                asm volatile("s_waitcnt lgkmcnt(0)" ::: "memory");
                {
                    const LAS float* GT = (const LAS float*)ACT;
                    const int lo8 = trow * 64 + q * 8; const size_t go8 = (rowbase + tch + trow) * 512 + h * 64 + q * 8;
                    float r[8], k[8], v[8], lw[8], aa[8], vg[8], g[8], c_w0[8], c_a0[8], c_v0[8], c_kk[8], c_ka[8], c_rk[8];
#define LD8(dst, ptr) do { const f32x4 _a = *(const LAS f32x4*)(ptr), _b = *(const LAS f32x4*)((ptr) + 4); dst[0] = _a.x; dst[1] = _a.y; dst[2] = _a.z; dst[3] = _a.w; dst[4] = _b.x; dst[5] = _b.y; dst[6] = _b.z; dst[7] = _b.w; } while (0)
                    LD8(r, RS + lo8); LD8(k, KS + lo8); LD8(v, VS + lo8); LD8(lw, WW + lo8); LD8(aa, KK + lo8); LD8(vg, BV + lo8); LD8(g, GT + s * 64 + q * 8);
                    LD8(c_w0, CT + q * 8); LD8(c_a0, CT + 64 + q * 8); LD8(c_v0, CT + 128 + q * 8); LD8(c_kk, CT + 192 + q * 8); LD8(c_ka, CT + 256 + q * 8); LD8(c_rk, CT + 320 + q * 8);
                    const float invn = INV[s];
                    float vf[8];
                    { const u32x4 cv = cvf0; vf[0] = bflo(cv.x); vf[1] = bfhi(cv.x); vf[2] = bflo(cv.y); vf[3] = bfhi(cv.y); vf[4] = bflo(cv.z); vf[5] = bfhi(cv.z); vf[6] = bflo(cv.w); vf[7] = bfhi(cv.w); }
                    float ow[8], okm[8], okk[8], obv[8]; float bp = 0.f;
#pragma unroll
                    for (int e = 0; e < 8; ++e) {
                        const float sg = __builtin_amdgcn_rcpf(1.0f + __expf(-(c_w0[e] + lw[e])));
                        ow[e] = __expf(-0.6065306597126334f * sg);
                        const float a = __builtin_amdgcn_rcpf(1.0f + __expf(-(c_a0[e] + aa[e])));
                        okk[e] = k[e] * c_kk[e] * invn; okm[e] = k[e] * (1.0f + (a - 1.0f) * c_ka[e]); obv[e] = okk[e] * a;
                        if (layer > 0) { const float vgs = __builtin_amdgcn_rcpf(1.0f + __expf(-(c_v0[e] + vg[e]))); v[e] = v[e] + (vf[e] - v[e]) * vgs; }
                        bp += r[e] * okm[e] * c_rk[e];
                    }
#define ST8(ptr, src) do { *(LAS f32x4*)(ptr) = (f32x4){src[0], src[1], src[2], src[3]}; *(LAS f32x4*)((ptr) + 4) = (f32x4){src[4], src[5], src[6], src[7]}; } while (0)
                    ST8(WW + lo8, ow); ST8(KS + lo8, okm); ST8(KK + lo8, okk); ST8(BV + lo8, obv); ST8(VS + lo8, v);
                    bp = rowsum8(bp);
                    if (hf == 0) {
                        u32x4 gv, vv; gv.x = pk2(g[0], g[1]); gv.y = pk2(g[2], g[3]); gv.z = pk2(g[4], g[5]); gv.w = pk2(g[6], g[7]);
                        vv.x = pk2(v[0], v[1]); vv.y = pk2(v[2], v[3]); vv.z = pk2(v[4], v[5]); vv.w = pk2(v[6], v[7]);
                        *(u32x4*)(GB + go8) = gv; *(u32x4*)(VC + go8) = vv; if (layer == 0) *(u32x4*)(VF + go8) = vv;
                        if (q == 0) BON[(rowbase + tch + trow) * 8 + h] = bp;
                    }
                }
            }
            __syncthreads();
        }
    }
}

#ifdef MK_GEMM_TWICE
#define GEMM_AGAIN __syncthreads(); pg8::gemm_phase<decltype(E), pg8::StaticOrder, true, true>(lds, g, S, E, wave_s)
#else
#define GEMM_AGAIN
#endif
#ifdef MK_ATTN_TWICE
#define ATTN_CALL2 attn_unit(lds, Zb, XN, u - 128, wave, lane)
#else
#define ATTN_CALL2
#endif
#ifndef MK_NO_SCAN
#define SCAN_CALL scan_unit(lds, p, l, u, tid, wave, lane)
#else
#define SCAN_CALL
#endif
#ifndef MK_NO_ATTN
#define ATTN_CALL attn_unit(lds, Zb, XN, u - 128, wave, lane)
#else
#define ATTN_CALL
#endif
__global__ void __launch_bounds__(512, 2) mk_fwd(Params p) {
    extern __shared__ __attribute__((aligned(16))) unsigned char lds_raw[];
    LAS unsigned char* lds = (LAS unsigned char*)lds_raw;
    cg::grid_group grid = cg::this_grid();
    const int G = gridDim.x, NGW = G * 8;
    const int wave_s = __builtin_amdgcn_readfirstlane(threadIdx.x >> 6);
    unsigned char* ws = p.ws;
    bf16* XN = (bf16*)(ws + WS_XN); bf16* Zb = (bf16*)(ws + WS_Z); bf16* Hb = (bf16*)(ws + WS_H); bf16* Y1 = (bf16*)(ws + WS_Y1);
    int ph = 0;
#define PH_ON (ph >= p.ph_lo && ph < p.ph_hi)
#define PH_END do { if (ph + 1 < p.ph_hi) grid.sync(); } while (0)
    if (PH_ON) { MK_IDS; prologue(p, lds, gw, NGW, wave, lane); PH_END; } ++ph;
#pragma unroll 1
    for (int l = 0; l < DEPTH; ++l) {
        if (PH_ON) { pg8::Gemm g{XN, (const bf16*)(ws + WS_WIN) + (size_t)l * NZ * 1024, NT, NZ, 1024}; pg8::StaticOrder S; S.init(NT, NZ, G, (int)blockIdx.x);
            pg8::EpiAct<0> E{Zb, NZ}; pg8::gemm_phase<pg8::EpiAct<0>, pg8::StaticOrder, true, true>(lds, g, S, E, wave_s); GEMM_AGAIN; PH_END; } ++ph;
        if (PH_ON) { MK_IDS;
#ifdef MK_P2_TWICE
            for (int rep = 0; rep < 2; ++rep) {
#endif
            for (int u = blockIdx.x; u < 128; u += G) { SCAN_CALL; __syncthreads(); }
            for (int u = (blockIdx.x >= 128 ? blockIdx.x : blockIdx.x + ((127 - blockIdx.x) / G + 1) * G); u < 256; u += G) { ATTN_CALL; __syncthreads(); ATTN_CALL2; __syncthreads(); }
#ifdef MK_P2_TWICE
            __syncthreads(); }
#endif
            PH_END; } ++ph;
        if (PH_ON) { MK_IDS; post_phase(XN, (const bf16*)(ws + WS_YS), (const bf16*)(ws + WS_G), (const bf16*)(ws + WS_VC), (const float*)(ws + WS_BON), p.in[9] + l * 512, p.in[20] + l * 512, p.in[21] + l * 512, gw, NGW, lane); PH_END; } ++ph;
        if (PH_ON) { pg8::Gemm g{XN, (const bf16*)(ws + WS_WOUT) + (size_t)l * 1024 * 1024, NT, 1024, 1024}; pg8::StaticOrder S; S.init(NT, 1024, G, (int)blockIdx.x);
            pg8::EpiAct<0> E{Y1, 1024}; pg8::gemm_phase<pg8::EpiAct<0>, pg8::StaticOrder, true, true>(lds, g, S, E, wave_s); GEMM_AGAIN; PH_END; } ++ph;
        if (PH_ON) { MK_IDS; norm_phase(Y1, p.out, XN, p.in[2] + l * 1024, p.in[3] + l * 1024, gw, NGW, lane); PH_END; } ++ph;
        if (PH_ON) { pg8::Gemm g{XN, (const bf16*)(ws + WS_WUP) + (size_t)l * 4096 * 1024, NT, DFF, 1024}; pg8::StaticOrder S; S.init(NT, DFF, G, (int)blockIdx.x);
            pg8::EpiAct<1> E{Hb, DFF}; pg8::gemm_phase<pg8::EpiAct<1>, pg8::StaticOrder, true, true>(lds, g, S, E, wave_s); GEMM_AGAIN; PH_END; } ++ph;
        if (PH_ON) { pg8::Gemm g{Hb, (const bf16*)(ws + WS_WDN) + (size_t)l * 1024 * 4096, NT, 1024, DFF}; pg8::StaticOrder S; S.init(NT, 1024, G, (int)blockIdx.x);
            pg8::EpiAct<0> E{XN, 1024}; pg8::gemm_phase<pg8::EpiAct<0>, pg8::StaticOrder, true, true>(lds, g, S, E, wave_s); GEMM_AGAIN; PH_END; } ++ph;
        if (PH_ON) { MK_IDS; norm_phase(XN, p.out, XN, p.in[4] + l * 1024, (l + 1 < DEPTH) ? p.in[1] + (l + 1) * 1024 : nullptr, gw, NGW, lane); PH_END; } ++ph;
    }
}
constexpr int N_PHASES = 1 + 8 * DEPTH;

extern "C" void kernel_launch(void* const* d_in, const int* in_sizes, int n_in, void* d_out, int out_size, void* d_ws, size_t ws_size, hipStream_t stream) {
    static int grid = 0;
    if (grid == 0) {
        if (n_in != 25 || out_size != NT * DM || ws_size < WS_END) { fprintf(stderr, "kernel_launch: unexpected sizes n_in=%d out=%d ws=%zu\n", n_in, out_size, ws_size); grid = -1; return; }
        int dev = 0, cus = 0, per_cu = 0;
        hipGetDevice(&dev); hipDeviceGetAttribute(&cus, hipDeviceAttributeMultiprocessorCount, dev);
        if (hipFuncSetAttribute((const void*)mk_fwd, hipFuncAttributeMaxDynamicSharedMemorySize, LDS_BYTES) != hipSuccess) { fprintf(stderr, "kernel_launch: hipFuncSetAttribute failed\n"); grid = -1; return; }
        if (hipOccupancyMaxActiveBlocksPerMultiprocessor(&per_cu, (const void*)mk_fwd, 512, LDS_BYTES) != hipSuccess || per_cu < 1) { fprintf(stderr, "kernel_launch: occupancy query gave %d\n", per_cu); per_cu = 1; }
        (void)hipGetLastError();
        grid = cus * per_cu;
        fprintf(stderr, "kernel_launch: grid %d (cus %d x %d)\n", grid, cus, per_cu);
    }
    if (grid < 0) return;
    Params p{};
    for (int i = 0; i < 25; ++i) p.in[i] = (const float*)d_in[i];
    p.out = (float*)d_out; p.ws = (unsigned char*)d_ws;
#if MK_MULTI
    for (int ph = 0; ph < N_PHASES; ++ph) { p.ph_lo = ph; p.ph_hi = ph + 1; hipLaunchKernelGGL(mk_fwd, dim3(grid), dim3(512), LDS_BYTES, stream, p); }
#else
    p.ph_lo = 0; p.ph_hi = N_PHASES;
    void* args[] = {&p};
    hipError_t e = hipLaunchCooperativeKernel((const void*)mk_fwd, dim3(grid), dim3(512), args, LDS_BYTES, stream);
    if (e != hipSuccess) fprintf(stderr, "kernel_launch: cooperative launch failed: %s (grid %d)\n", hipGetErrorString(e), grid);
#endif
}
```

```cpp
#include <hip/hip_runtime.h>
#include <hip/hip_cooperative_groups.h>
#include <cstdio>
#include <cstdint>
namespace cg = cooperative_groups;
#ifndef MK_MULTI
#define MK_MULTI 0
#endif
namespace pg8 {
#define PG8_LAS __attribute__((address_space(3)))
typedef unsigned short bf16_t;
typedef short bf16x8 __attribute__((ext_vector_type(8)));
typedef float f32x4 __attribute__((ext_vector_type(4)));
typedef unsigned u32x4 __attribute__((ext_vector_type(4)));
constexpr int BM = 256, BK = 64, HALF = 128, HTB = HALF * BK * 2  , STAGE_BYTES = 8 * HTB, NXCD = 8, WGM = 8;

__host__ __device__ __forceinline__ int lds_byte(int r, int c) { const int st = (r >> 4) * 2 + (c >> 5), rr = r & 15, cc = c & 31, ob = rr * 64 + cc * 2; return st * 1024 + (ob ^ (((ob >> 9) & 1) << 5)); }
__host__ __device__ __forceinline__ void stage_rc(int b, int& R, int& C) { const int st = b / 1024, sb = b % 1024, swz = sb ^ (((sb >> 9) & 1) << 5); R = (st >> 1) * 16 + swz / 64; C = (st & 1) * 32 + (swz % 64) / 2; }
__host__ __device__ __forceinline__ int perm32(int rho) { const int n = rho >> 4, i = rho & 15; return 8 * (i >> 2) + 4 * n + (i & 3); }

struct Unit { int pm, pn; };
struct Gemm { const bf16_t* A; const bf16_t* Bt; int M, N, K; };
struct StaticOrder {
    int nM, nN, nwg, G, c;
    __host__ __device__ void init(int M, int N, int G_, int c_) { nM = M / BM; nN = N / BM; nwg = nM * nN; G = G_; c = c_; }
    __host__ __device__ bool next(int i, Unit& u) const {
        const long L = (long)i * G + c; if (L >= nwg) return false;
        int wgid = (int)L; { const int q = nwg / NXCD, r = nwg % NXCD, xcd = wgid % NXCD, off = wgid / NXCD; wgid = (xcd < r ? xcd * (q + 1) : r * (q + 1) + (xcd - r) * q) + off; }
        const int nig = WGM * nN, gid = wgid / nig, fm = gid * WGM, gsz = (nM - fm) < WGM ? (nM - fm) : WGM;
        u.pm = fm + ((wgid % nig) % gsz); u.pn = (wgid % nig) / gsz; return true;
    }
    __device__ __forceinline__ void a_ready(const Unit&) const {}
    __device__ __forceinline__ void done(const Unit&) const {}
};
__device__ __forceinline__ unsigned cvt_pk_bf16(float lo, float hi) { unsigned r; asm volatile("v_cvt_pk_bf16_f32 %0, %1, %2" : "=v"(r) : "v"(lo), "v"(hi)); return r; }
typedef float f32x2 __attribute__((ext_vector_type(2)));
__device__ __forceinline__ int mk_tid(const int w) { unsigned m = ~0u; asm volatile("" : "+s"(m)); const int l = __builtin_amdgcn_mbcnt_hi(m, __builtin_amdgcn_mbcnt_lo(m, 0u)); int t = w * 64 + l; asm volatile("" : "+v"(t)); return t; }
template <int ACT> struct EpiAct {
    static constexpr bool PERM = true, AFTER_DRAIN = false;
    bf16_t* O; int ldc;
    __device__ __forceinline__ void operator()(const f32x4 (&acc)[2][2][4][2], const Unit& u, int wr, int wc, int fr, int fq) const {
        const int row0 = u.pm * BM + wr * 64 + fr; const int col0 = u.pn * BM + wc * 32 + 8 * fq;
#pragma unroll
        for (int ai = 0; ai < 2; ++ai)
#pragma unroll
            for (int m = 0; m < 4; ++m) { bf16_t* rowp = O + (size_t)(row0 + ai * HALF + m * 16) * ldc + col0;
#pragma unroll
                for (int bj = 0; bj < 2; ++bj) { f32x4 v0 = acc[ai][bj][m][0], v1 = acc[ai][bj][m][1];
                    if (ACT == 1) {
#pragma unroll
                        for (int e = 0; e < 4; ++e) { float a = v0[e] > 0.f ? v0[e] : 0.f, b = v1[e] > 0.f ? v1[e] : 0.f; v0[e] = a * a; v1[e] = b * b; } }
                    u32x4 w; w.x = cvt_pk_bf16(v0[0], v0[1]); w.y = cvt_pk_bf16(v0[2], v0[3]); w.z = cvt_pk_bf16(v1[0], v1[1]); w.w = cvt_pk_bf16(v1[2], v1[3]);
                    *(u32x4*)(rowp + bj * HALF) = w; } }
    }
};
template <class Epi, class Sched, bool ALIGN_EPI = false, bool SP2 = false>
__device__ __forceinline__ void gemm_phase(PG8_LAS unsigned char* lds, const Gemm g, const Sched& S, const Epi& E, const int wave_s) {
    const int tid = mk_tid(wave_s), wid = __builtin_amdgcn_readfirstlane(tid >> 6), lane = tid & 63, wr = wid >> 2, wc = wid & 3, fr = lane & 15, fq = lane >> 4;
    const int K = g.K, nt = K / BK;
    unsigned voffA[2], voffB[2];
#pragma unroll
    for (int i = 0; i < 2; ++i) { int R, C; stage_rc(tid * 16 + i * 8192, R, C); const int Rb = Epi::PERM ? ((R & ~31) + perm32(R & 31)) : R;
        voffA[i] = (unsigned)(R * K + C) * 2u; voffB[i] = (unsigned)(Rb * K + C) * 2u; }
    const size_t kstep = (size_t)(BK * 2);
    const size_t hstep = (size_t)HALF * K * 2;
    const size_t tstep = 2 * hstep;
    const unsigned ldsw = (unsigned)wid * 1024u;
    const int aoff = lds_byte(wr * 64 + fr, fq * 8), boff = lds_byte(wc * 32 + fr, fq * 8);
#define PG8_SA(b, h) (((b) * 2 + (h)) * HTB)
#define PG8_SB(b, h) ((4 + (b) * 2 + (h)) * HTB)
#define PG8_STAGE(bufoff, gbase, voff) do { _Pragma("unroll") for (int _i = 0; _i < 2; ++_i) \
        __builtin_amdgcn_global_load_lds((const unsigned*)((const char*)(gbase) + (voff)[_i]), (PG8_LAS unsigned*)(lds + (bufoff) + ldsw + _i * 8192), 16, 0, 0); } while (0)
#define PG8_LDA(dst, b, h) do { _Pragma("unroll") for (int m = 0; m < 4; ++m) _Pragma("unroll") for (int k = 0; k < 2; ++k) dst[m][k] = *(const PG8_LAS bf16x8*)(lds + PG8_SA(b, h) + aoff + m * 2048 + k * 1024); } while (0)
#define PG8_LDB(dst, b, h) do { _Pragma("unroll") for (int n = 0; n < 2; ++n) _Pragma("unroll") for (int k = 0; k < 2; ++k) dst[n][k] = *(const PG8_LAS bf16x8*)(lds + PG8_SB(b, h) + boff + n * 2048 + k * 1024); } while (0)
#define PG8_MMA(ai, bj, At, Bt) do { __builtin_amdgcn_s_setprio(1); _Pragma("unroll") for (int m = 0; m < 4; ++m) _Pragma("unroll") for (int n = 0; n < 2; ++n) _Pragma("unroll") for (int k = 0; k < 2; ++k) \
        acc[ai][bj][m][n] = __builtin_amdgcn_mfma_f32_16x16x32_bf16(Bt[n][k], At[m][k], acc[ai][bj][m][n], 0, 0, 0); __builtin_amdgcn_s_setprio(0); } while (0)
#define PG8_WAIT_V(n) asm volatile("s_waitcnt vmcnt(" #n ")" ::: "memory")
#define PG8_WAIT_L(n) asm volatile("s_waitcnt lgkmcnt(" #n ")" ::: "memory")
#define PG8_BAR __builtin_amdgcn_s_barrier()
#define PG8_SCHED __builtin_amdgcn_sched_barrier(0)
    Unit cur, nxt; int ui = 0;
    if (!S.next(0, cur)) return;
    f32x4 acc[2][2][4][2];
#pragma unroll
    for (int a = 0; a < 2; ++a)
#pragma unroll
        for (int b = 0; b < 2; ++b)
#pragma unroll
            for (int m = 0; m < 4; ++m)
#pragma unroll
                for (int n = 0; n < 2; ++n) acc[a][b][m][n] = (f32x4){0.f, 0.f, 0.f, 0.f};
    bf16x8 At[4][2], B0[2][2], B1[2][2];
    const char* cA = (const char*)g.A + (size_t)cur.pm * tstep; const char* cB = (const char*)g.Bt + (size_t)cur.pn * tstep;
    S.a_ready(cur);
    if constexpr (SP2) {
        PG8_STAGE(PG8_SB(0, 0), cB, voffB); PG8_STAGE(PG8_SB(0, 1), cB + hstep, voffB); PG8_STAGE(PG8_SA(0, 0), cA, voffA); PG8_STAGE(PG8_SA(0, 1), cA + hstep, voffA);
        if (wr == 1) PG8_BAR;
        PG8_WAIT_V(2); PG8_BAR;
        PG8_STAGE(PG8_SB(1, 0), cB + kstep, voffB); PG8_STAGE(PG8_SA(1, 0), cA + kstep, voffA); PG8_STAGE(PG8_SB(1, 1), cB + hstep + kstep, voffB);
        PG8_WAIT_V(6); PG8_BAR;
    } else {
        PG8_STAGE(PG8_SB(0, 0), cB, voffB); PG8_STAGE(PG8_SA(0, 0), cA, voffA); PG8_STAGE(PG8_SB(0, 1), cB + hstep, voffB); PG8_STAGE(PG8_SA(0, 1), cA + hstep, voffA);
        if (wr == 1) PG8_BAR;
        PG8_WAIT_V(4); PG8_BAR;
        PG8_STAGE(PG8_SB(1, 0), cB + kstep, voffB); PG8_STAGE(PG8_SA(1, 0), cA + kstep, voffA); PG8_STAGE(PG8_SB(1, 1), cB + hstep + kstep, voffB);
        PG8_WAIT_V(6); PG8_BAR;
    }
    for (;;) {
        const bool has_next = S.next(ui + 1, nxt);
        const char* nA = has_next ? (const char*)g.A + (size_t)nxt.pm * tstep : cA; const char* nB = has_next ? (const char*)g.Bt + (size_t)nxt.pn * tstep : cB;
        for (int t = 0; t < nt; t += 2) {
            const bool last = (t == nt - 2);
            const char* a1 = cA + (size_t)(t + 1) * kstep;
            const char* a2 = last ? nA : cA + (size_t)(t + 2) * kstep; const char* b2 = last ? nB : cB + (size_t)(t + 2) * kstep;
            const char* a3 = a2 + kstep; const char* b3 = b2 + kstep;
            if (last && has_next) S.a_ready(nxt);
            if constexpr (SP2) {
            PG8_LDB(B0, 0, 0); PG8_LDB(B1, 0, 1); PG8_SCHED; PG8_LDA(At, 0, 0); PG8_STAGE(PG8_SA(1, 1), a1 + hstep, voffA);
            PG8_WAIT_V(8); PG8_WAIT_L(0); PG8_BAR; PG8_MMA(0, 0, At, B0); PG8_MMA(0, 1, At, B1); PG8_BAR; PG8_SCHED;
            PG8_LDA(At, 0, 1); PG8_STAGE(PG8_SB(0, 0), b2, voffB); PG8_STAGE(PG8_SB(0, 1), b2 + hstep, voffB); PG8_STAGE(PG8_SA(0, 0), a2, voffA);
            PG8_WAIT_V(8); PG8_WAIT_L(0); PG8_BAR; PG8_MMA(1, 0, At, B0); PG8_MMA(1, 1, At, B1); PG8_BAR; PG8_SCHED;
            PG8_LDB(B0, 1, 0); PG8_LDB(B1, 1, 1); PG8_SCHED; PG8_LDA(At, 1, 0); PG8_STAGE(PG8_SA(0, 1), a2 + hstep, voffA);
            PG8_WAIT_V(8); PG8_WAIT_L(0); PG8_BAR; PG8_MMA(0, 0, At, B0); PG8_MMA(0, 1, At, B1); PG8_BAR; PG8_SCHED;
            PG8_LDA(At, 1, 1); PG8_STAGE(PG8_SB(1, 0), b3, voffB); PG8_STAGE(PG8_SB(1, 1), b3 + hstep, voffB); PG8_STAGE(PG8_SA(1, 0), a3, voffA);
            PG8_WAIT_V(8); PG8_WAIT_L(0); PG8_BAR; PG8_MMA(1, 0, At, B0); PG8_MMA(1, 1, At, B1); PG8_BAR; PG8_SCHED;
            } else {
            PG8_LDB(B0, 0, 0); PG8_SCHED; PG8_LDA(At, 0, 0); PG8_STAGE(PG8_SA(1, 1), a1 + hstep, voffA);
            PG8_WAIT_L(8); PG8_BAR; PG8_WAIT_L(0); PG8_MMA(0, 0, At, B0); PG8_BAR; PG8_SCHED;
            PG8_LDB(B1, 0, 1); PG8_STAGE(PG8_SB(0, 0), b2, voffB);
            PG8_BAR; PG8_WAIT_L(0); PG8_MMA(0, 1, At, B1); PG8_BAR;
            PG8_LDA(At, 0, 1); PG8_STAGE(PG8_SA(0, 0), a2, voffA);
            PG8_BAR; PG8_WAIT_L(0); PG8_MMA(1, 0, At, B0); PG8_BAR; PG8_SCHED;
            PG8_STAGE(PG8_SB(0, 1), b2 + hstep, voffB);
            PG8_WAIT_V(6); PG8_BAR; PG8_MMA(1, 1, At, B1); PG8_BAR;
            PG8_LDB(B0, 1, 0); PG8_SCHED; PG8_LDA(At, 1, 0); PG8_STAGE(PG8_SA(0, 1), a2 + hstep, voffA);
            PG8_WAIT_L(8); PG8_BAR; PG8_WAIT_L(0); PG8_MMA(0, 0, At, B0); PG8_BAR; PG8_SCHED;
            PG8_LDB(B1, 1, 1); PG8_STAGE(PG8_SB(1, 0), b3, voffB);
            PG8_BAR; PG8_WAIT_L(0); PG8_MMA(0, 1, At, B1); PG8_BAR;
            PG8_LDA(At, 1, 1); PG8_STAGE(PG8_SA(1, 0), a3, voffA);
            PG8_BAR; PG8_WAIT_L(0); PG8_MMA(1, 0, At, B0); PG8_BAR; PG8_SCHED;
            PG8_STAGE(PG8_SB(1, 1), b3 + hstep, voffB);
            PG8_WAIT_V(6); PG8_BAR; PG8_MMA(1, 1, At, B1); PG8_BAR;
            }
        }
        if constexpr (ALIGN_EPI) { if (wr == 0) PG8_BAR; }
        if constexpr (!Epi::AFTER_DRAIN) { E(acc, cur, wr, wc, fr, fq); S.done(cur); }
        if (!has_next) break;
#pragma unroll
        for (int a = 0; a < 2; ++a)
#pragma unroll
            for (int b = 0; b < 2; ++b)
#pragma unroll
                for (int m = 0; m < 4; ++m)
#pragma unroll
                    for (int n = 0; n < 2; ++n) acc[a][b][m][n] = (f32x4){0.f, 0.f, 0.f, 0.f};
        cur = nxt; cA = nA; cB = nB; ++ui;
        if constexpr (ALIGN_EPI) { if (wr == 1) PG8_BAR; }
    }
    PG8_WAIT_V(0);
    if constexpr (!ALIGN_EPI) { if (wr == 0) PG8_BAR; }
    PG8_BAR;
    if constexpr (Epi::AFTER_DRAIN) { E.fused(acc, cur, wr, wc, fr, fq, lds, wid, lane); S.done(cur); }
#undef PG8_SA
#undef PG8_SB
#undef PG8_STAGE
#undef PG8_LDA
#undef PG8_LDB
#undef PG8_MMA
#undef PG8_WAIT_V
#undef PG8_WAIT_L
#undef PG8_BAR
#undef PG8_SCHED
}
}
constexpr int NB = 8, SEQ = 4096, DM = 1024, NT = NB * SEQ, DEPTH = 4, DFF = 4096;
constexpr int NZ = 3328;
constexpr int ZQ = 0, ZK = 512, ZV = 1024, ZR = 1536, ZKR = 2048, ZVR = 2560, ZXW = 3072, ZMV = 3232;
constexpr size_t MiB = 1u << 20;
constexpr size_t WS_WIN = 1 * MiB, WS_WOUT = 27 * MiB, WS_WUP = 35 * MiB, WS_WDN = 67 * MiB, WS_LT = 99 * MiB;
constexpr size_t WS_XN = 100 * MiB, WS_VF = 164 * MiB, WS_BON = 196 * MiB, WS_BIG = 198 * MiB;
constexpr size_t WS_Z = WS_BIG, WS_YS = 406 * MiB, WS_G = 438 * MiB, WS_VC = 470 * MiB, WS_H = WS_BIG, WS_Y1 = WS_BIG, WS_END = 502 * MiB;
constexpr int LDS_BYTES = 147456;

#define LAS __attribute__((address_space(3)))
typedef unsigned short bf16;
typedef float f32x4 __attribute__((ext_vector_type(4)));
typedef unsigned u32x4 __attribute__((ext_vector_type(4)));
typedef unsigned u32x2 __attribute__((ext_vector_type(2)));
typedef short bf16x8 __attribute__((ext_vector_type(8)));
typedef short s16x4 __attribute__((ext_vector_type(4)));

__device__ __forceinline__ float bf2f(unsigned u) { return __uint_as_float(u << 16); }
__device__ __forceinline__ float bflo(unsigned u) { return __uint_as_float(u << 16); }
__device__ __forceinline__ float bfhi(unsigned u) { return __uint_as_float(u & 0xffff0000u); }
__device__ __forceinline__ unsigned f2bf(float f) { unsigned u = __float_as_uint(f); return (u + 0x7fffu + ((u >> 16) & 1u)) >> 16; }
__device__ __forceinline__ unsigned pk2(float lo, float hi) { return f2bf(lo) | (f2bf(hi) << 16); }
__device__ __forceinline__ float dppf(float v, const int ctrl_sel) {
    int r;
    if (ctrl_sel == 0) r = __builtin_amdgcn_update_dpp(0, __float_as_int(v), 0xB1, 0xF, 0xF, false);
    else if (ctrl_sel == 1) r = __builtin_amdgcn_update_dpp(0, __float_as_int(v), 0x4E, 0xF, 0xF, false);
    else if (ctrl_sel == 2) r = __builtin_amdgcn_update_dpp(0, __float_as_int(v), 0x141, 0xF, 0xF, false);
    else r = __builtin_amdgcn_update_dpp(0, __float_as_int(v), 0x140, 0xF, 0xF, false);
    return __int_as_float(r);
}
__device__ __forceinline__ float rowsum8(float v) { v += dppf(v, 0); v += dppf(v, 1); v += dppf(v, 2); return v; }
__device__ __forceinline__ float rowsum16(float v) { v += dppf(v, 0); v += dppf(v, 1); v += dppf(v, 2); v += dppf(v, 3); return v; }
__device__ __forceinline__ float wave_sum(float v) {
    v = rowsum16(v);
    const int iv = __float_as_int(v);
    return (__int_as_float(__builtin_amdgcn_readlane(iv, 0)) + __int_as_float(__builtin_amdgcn_readlane(iv, 16))) + (__int_as_float(__builtin_amdgcn_readlane(iv, 32)) + __int_as_float(__builtin_amdgcn_readlane(iv, 48)));
}
__device__ __forceinline__ float sigmoidf_(float x) { return 1.0f / (1.0f + __expf(-x)); }

struct Params { const float* in[25]; float* out; unsigned char* ws; int ph_lo, ph_hi; };
#define MK_IDS const int tid = pg8::mk_tid(wave_s), lane = tid & 63, wave = __builtin_amdgcn_readfirstlane(tid >> 6); const int gw = blockIdx.x * 8 + wave; (void)gw; (void)lane

__device__ __forceinline__ void transpose_item(const float* W, int K, int N, bf16* WT, LAS float* scr, int item, int lane) {
    const int nblk = N / 32, kb = item / nblk, nb = item % nblk, k0 = 64 * kb, n0 = 32 * nb;
#pragma unroll 8
    for (int i = 0; i < 32; ++i) { const int kk = 2 * i + (lane >> 5); scr[kk * 33 + (lane & 31)] = W[(size_t)(k0 + kk) * N + n0 + (lane & 31)]; }
    asm volatile("s_waitcnt lgkmcnt(0)" ::: "memory");
    const int c = lane & 7;
#pragma unroll
    for (int j = 0; j < 4; ++j) { const int n = (lane >> 3) + 8 * j; const LAS float* s = scr + (8 * c) * 33 + n;
        u32x4 o; o.x = pk2(s[0 * 33], s[1 * 33]); o.y = pk2(s[2 * 33], s[3 * 33]); o.z = pk2(s[4 * 33], s[5 * 33]); o.w = pk2(s[6 * 33], s[7 * 33]);
        *(u32x4*)(WT + (size_t)(n0 + n) * K + k0 + 8 * c) = o; }
    asm volatile("s_waitcnt lgkmcnt(0)" ::: "memory");
}

__device__ __forceinline__ void prologue(const Params& p, LAS unsigned char* lds, int gw, int NGW, int wave, int lane) {
    unsigned char* ws = p.ws;
    LAS float* scr = (LAS float*)(lds + wave * 16384);
    constexpr int I_IN0 = 16 * 101, I_INR = 16 * 102, I_OUT = 16 * 32, I_UP = 16 * 128, I_DN = 64 * 32;
    constexpr int NITEMS = I_IN0 + 3 * I_INR + 4 * I_OUT + 4 * I_UP + 4 * I_DN;
    for (int it = gw; it < NITEMS; it += NGW) {
        int r = it;
        if (r < I_IN0) { transpose_item(p.in[5], 1024, 3232, (bf16*)(ws + WS_WIN), scr, r, lane); continue; } r -= I_IN0;
        if (r < 3 * I_INR) { const int l = r / I_INR; transpose_item(p.in[6] + (size_t)l * 1024 * 3264, 1024, 3264, (bf16*)(ws + WS_WIN) + (size_t)(l + 1) * NZ * 1024, scr, r % I_INR, lane); continue; } r -= 3 * I_INR;
        if (r < 4 * I_OUT) { const int l = r / I_OUT; transpose_item(p.in[22] + (size_t)l * 1024 * 1024, 1024, 1024, (bf16*)(ws + WS_WOUT) + (size_t)l * 1024 * 1024, scr, r % I_OUT, lane); continue; } r -= 4 * I_OUT;
        if (r < 4 * I_UP) { const int l = r / I_UP; transpose_item(p.in[23] + (size_t)l * 1024 * 4096, 1024, 4096, (bf16*)(ws + WS_WUP) + (size_t)l * 4096 * 1024, scr, r % I_UP, lane); continue; } r -= 4 * I_UP;
        { const int l = r / I_DN; transpose_item(p.in[24] + (size_t)l * 4096 * 1024, 4096, 1024, (bf16*)(ws + WS_WDN) + (size_t)l * 1024 * 4096, scr, r % I_DN, lane); }
    }
    {
        const int gt = gw * 64 + lane, NG = NGW * 64;
        const u32x4 z4 = {0u, 0u, 0u, 0u};
        for (int l = 0; l < 4; ++l) { const int r0 = (l == 0) ? 3232 : 3264; const int nvec = (NZ - r0) * 1024 / 8;
            u32x4* base = (u32x4*)((bf16*)(ws + WS_WIN) + ((size_t)l * NZ + r0) * 1024);
            for (int i = gt; i < nvec; i += NG) base[i] = z4; }
        bf16* LT = (bf16*)(ws + WS_LT);
        for (int i = gt; i < 4 * 512 * 192; i += NG) { const int l = i / (512 * 192), rem = i % (512 * 192), c = rem / 192, m = rem % 192; float v;
            if (m < 32) v = p.in[11][((size_t)l * 32 + m) * 512 + c];
            else if (m < 64) v = p.in[13][((size_t)l * 32 + (m - 32)) * 512 + c];
            else if (m < 160) v = p.in[16][((size_t)l * 96 + (m - 64)) * 512 + c];
            else v = (l > 0) ? p.in[15][((size_t)(l - 1) * 32 + (m - 160)) * 512 + c] : 0.f;
            LT[i] = (bf16)f2bf(v); }
    }
    const float* x = p.in[0]; const float* g = p.in[1]; bf16* XN = (bf16*)(ws + WS_XN);
    for (int row = gw; row < NT; row += NGW) {
        const f32x4* xr = (const f32x4*)(x + (size_t)row * DM) + lane; f32x4* orow = (f32x4*)(p.out + (size_t)row * DM) + lane;
        f32x4 v[4]; float s = 0.f;
#pragma unroll
        for (int j = 0; j < 4; ++j) { v[j] = xr[64 * j]; orow[64 * j] = v[j]; s += (v[j].x * v[j].x + v[j].y * v[j].y) + (v[j].z * v[j].z + v[j].w * v[j].w); }
        const float rstd = 1.0f / sqrtf(wave_sum(s) * (1.0f / DM) + 1e-6f);
        u32x2* o8 = (u32x2*)(XN + (size_t)row * DM) + lane;
#pragma unroll
        for (int j = 0; j < 4; ++j) { const f32x4 gg = ((const f32x4*)g)[lane + 64 * j]; u32x2 w; w.x = pk2(v[j].x * rstd * gg.x, v[j].y * rstd * gg.y); w.y = pk2(v[j].z * rstd * gg.z, v[j].w * rstd * gg.w); o8[64 * j] = w; }
    }
}

__device__ __forceinline__ void norm_phase(const bf16* Y, float* X, bf16* XN, const float* gpost, const float* gnext, int gw, int NGW, int lane) {
    f32x4 gp[4], gn[4];
#pragma unroll
    for (int k = 0; k < 2; ++k)
#pragma unroll
        for (int q = 0; q < 2; ++q) { gp[k * 2 + q] = ((const f32x4*)gpost)[k * 128 + lane * 2 + q]; gn[k * 2 + q] = gnext ? ((const f32x4*)gnext)[k * 128 + lane * 2 + q] : (f32x4){0.f, 0.f, 0.f, 0.f}; }
    int row = gw; if (row >= NT) return;
    u32x4 yw[2]; f32x4 xv[4];
#define NP_LOAD(r, YW, XV) do { const u32x4* yr_ = (const u32x4*)(Y + (size_t)(r) * DM); const f32x4* xr_ = (const f32x4*)(X + (size_t)(r) * DM); \
        YW[0] = yr_[lane]; YW[1] = yr_[64 + lane]; XV[0] = xr_[lane * 2]; XV[1] = xr_[lane * 2 + 1]; XV[2] = xr_[128 + lane * 2]; XV[3] = xr_[128 + lane * 2 + 1]; } while (0)
    NP_LOAD(row, yw, xv);
    while (true) {
        const int nrow = row + NGW; const bool more = nrow < NT;
        u32x4 nyw[2] = {yw[0], yw[1]}; f32x4 nxv[4] = {xv[0], xv[1], xv[2], xv[3]};
        if (more) NP_LOAD(nrow, nyw, nxv);
        float y[16]; float ss = 0.f;
#pragma unroll
        for (int k = 0; k < 2; ++k) { const u32x4 w = yw[k];
            y[k * 8 + 0] = bflo(w.x); y[k * 8 + 1] = bfhi(w.x); y[k * 8 + 2] = bflo(w.y); y[k * 8 + 3] = bfhi(w.y); y[k * 8 + 4] = bflo(w.z); y[k * 8 + 5] = bfhi(w.z); y[k * 8 + 6] = bflo(w.w); y[k * 8 + 7] = bfhi(w.w); }
#pragma unroll
        for (int e = 0; e < 16; ++e) ss += y[e] * y[e];
        const float rstd = 1.0f / sqrtf(wave_sum(ss) * (1.0f / DM) + 1e-6f);
        float xn[16]; float s2 = 0.f; f32x4* xr = (f32x4*)(X + (size_t)row * DM);
#pragma unroll
        for (int k = 0; k < 2; ++k)
#pragma unroll
            for (int q = 0; q < 2; ++q) { f32x4 xx = xv[k * 2 + q]; const f32x4 gg = gp[k * 2 + q];
#pragma unroll
                for (int e = 0; e < 4; ++e) { const float t = xx[e] + y[k * 8 + q * 4 + e] * rstd * gg[e]; xx[e] = t; xn[k * 8 + q * 4 + e] = t; s2 += t * t; }
                xr[k * 128 + lane * 2 + q] = xx; }
        if (gnext) {
            const float r2 = 1.0f / sqrtf(wave_sum(s2) * (1.0f / DM) + 1e-6f);
            u32x4* o = (u32x4*)(XN + (size_t)row * DM);
#pragma unroll
            for (int k = 0; k < 2; ++k) { const f32x4 g0 = gn[k * 2], g1 = gn[k * 2 + 1]; u32x4 w;
                w.x = pk2(xn[k * 8 + 0] * r2 * g0.x, xn[k * 8 + 1] * r2 * g0.y); w.y = pk2(xn[k * 8 + 2] * r2 * g0.z, xn[k * 8 + 3] * r2 * g0.w);
                w.z = pk2(xn[k * 8 + 4] * r2 * g1.x, xn[k * 8 + 5] * r2 * g1.y); w.w = pk2(xn[k * 8 + 6] * r2 * g1.z, xn[k * 8 + 7] * r2 * g1.w);
                o[k * 64 + lane] = w; }
        }
        if (!more) break;
        row = nrow; yw[0] = nyw[0]; yw[1] = nyw[1]; xv[0] = nxv[0]; xv[1] = nxv[1]; xv[2] = nxv[2]; xv[3] = nxv[3];
    }
}

__device__ __forceinline__ void post_phase(bf16* MIX, const bf16* YS, const bf16* GB, const bf16* VC, const float* BON, const float* again, const float* gnw, const float* gnb, int gw, int NGW, int lane) {
    const f32x4 ag0 = ((const f32x4*)again)[lane * 2], ag1 = ((const f32x4*)again)[lane * 2 + 1];
    const f32x4 w0 = ((const f32x4*)gnw)[lane * 2], w1 = ((const f32x4*)gnw)[lane * 2 + 1], b0 = ((const f32x4*)gnb)[lane * 2], b1 = ((const f32x4*)gnb)[lane * 2 + 1];
    const float gwv[8] = {w0.x, w0.y, w0.z, w0.w, w1.x, w1.y, w1.z, w1.w}, gbv[8] = {b0.x, b0.y, b0.z, b0.w, b1.x, b1.y, b1.z, b1.w};
    int row = gw; if (row >= NT) return;
    u32x4 mo, my, mv, mg; float mb;
#define PP_LOAD(r, MO, MY, MV, MG, MB) do { MO = ((const u32x4*)(MIX + (size_t)(r) * DM))[lane]; MY = ((const u32x4*)(YS + (size_t)(r) * 512))[lane]; MV = ((const u32x4*)(VC + (size_t)(r) * 512))[lane]; \
        MG = ((const u32x4*)(GB + (size_t)(r) * 512))[lane]; MB = BON[(size_t)(r) * 8 + (lane >> 3)]; } while (0)
    PP_LOAD(row, mo, my, mv, mg, mb);
    while (true) {
        const int nrow = row + NGW; const bool more = nrow < NT;
        u32x4 no = mo, ny = my, nv = mv, ng = mg; float nb = mb;
        if (more) PP_LOAD(nrow, no, ny, nv, ng, nb);
        u32x4* mrow = (u32x4*)(MIX + (size_t)row * DM);
        {
            const u32x4 w = mo; float o[8] = {bflo(w.x), bfhi(w.x), bflo(w.y), bfhi(w.y), bflo(w.z), bfhi(w.z), bflo(w.w), bfhi(w.w)}; float ss = 0.f;
#pragma unroll
            for (int e = 0; e < 8; ++e) ss += o[e] * o[e];
            const float rstd = 1.0f / sqrtf(wave_sum(ss) * (1.0f / 512.0f) + 1e-6f);
            u32x4 r;
            r.x = pk2(o[0] * rstd * ag0.x, o[1] * rstd * ag0.y); r.y = pk2(o[2] * rstd * ag0.z, o[3] * rstd * ag0.w); r.z = pk2(o[4] * rstd * ag1.x, o[5] * rstd * ag1.y); r.w = pk2(o[6] * rstd * ag1.z, o[7] * rstd * ag1.w);
            mrow[lane] = r;
        }
        {
            const u32x4 w = my; float y[8] = {bflo(w.x), bfhi(w.x), bflo(w.y), bfhi(w.y), bflo(w.z), bfhi(w.z), bflo(w.w), bfhi(w.w)};
            float s1 = 0.f;
#pragma unroll
            for (int e = 0; e < 8; ++e) s1 += y[e];
            s1 = rowsum8(s1);
            const float mean = s1 * (1.0f / 64.0f); float s2 = 0.f;
#pragma unroll
            for (int e = 0; e < 8; ++e) { y[e] -= mean; s2 += y[e] * y[e]; }
            s2 = rowsum8(s2);
            const float rs = 1.0f / sqrtf(s2 * (1.0f / 64.0f) + 64e-5f);
            const u32x4 vw = mv, gw4 = mg;
            const float v[8] = {bflo(vw.x), bfhi(vw.x), bflo(vw.y), bfhi(vw.y), bflo(vw.z), bfhi(vw.z), bflo(vw.w), bfhi(vw.w)};
            const float g[8] = {bflo(gw4.x), bfhi(gw4.x), bflo(gw4.y), bfhi(gw4.y), bflo(gw4.z), bfhi(gw4.z), bflo(gw4.w), bfhi(gw4.w)};
            const float bon = mb;
            float o[8];
#pragma unroll
            for (int e = 0; e < 8; ++e) o[e] = (y[e] * rs * gwv[e] + gbv[e] + bon * v[e]) * g[e];
            u32x4 r; r.x = pk2(o[0], o[1]); r.y = pk2(o[2], o[3]); r.z = pk2(o[4], o[5]); r.w = pk2(o[6], o[7]);
            mrow[64 + lane] = r;
        }
        if (!more) break;
        row = nrow; mo = no; my = ny; mv = nv; mg = ng; mb = nb;
    }
}

__device__ __forceinline__ void attn_unit(LAS unsigned char* lds, const bf16* Z, bf16* MIX, int unit, int wave, int lane) {
    const int b = unit >> 4, t0 = (unit & 15) * 256;
    LAS float* ACC = (LAS float*)lds;
    LAS float* ML = (LAS float*)(lds + 256 * 68 * 4);
    LAS unsigned char* VST = lds + 256 * 68 * 4 + 2048 + wave * 4096;
    const int li = lane & 15, quad = lane >> 4;
    const float C = 0.125f * 1.4426950408889634f;
    const size_t rowbase = (size_t)b * SEQ;
    for (int h = 0; h < 8; ++h) {
#pragma unroll 1
        for (int br = 0; br < 3; ++br) {
            const int lg = br * 2; const int L = SEQ >> lg;
#pragma unroll 1
            for (int u = 0; u < 2; ++u) {
                const int tu = wave * 2 + u;
                int r, i0;
                if (br == 0) { r = 0; i0 = t0 + tu * 16; } else if (br == 1) { r = tu & 3; i0 = (t0 >> 2) + (tu >> 2) * 16; } else { r = tu; i0 = t0 >> 4; }
                const int tq = ((i0 + li) << lg) + r;
                const bf16* qp = Z + (rowbase + tq) * NZ + ZQ + h * 64 + quad * 8;
                const bf16x8 q0 = *(const bf16x8*)qp, q1 = *(const bf16x8*)(qp + 32);
                f32x4 s[9];
#pragma unroll
                for (int kt = 0; kt < 9; ++kt) {
                    int ik = i0 - 128 + kt * 16 + li; ik = ik < 0 ? 0 : ik;
                    const bf16* kp = Z + (rowbase + (ik << lg) + r) * NZ + ZK + h * 64 + quad * 8;
                    const bf16x8 k0 = *(const bf16x8*)kp, k1 = *(const bf16x8*)(kp + 32);
                    f32x4 a = {0.f, 0.f, 0.f, 0.f};
                    a = __builtin_amdgcn_mfma_f32_16x16x32_bf16(k0, q0, a, 0, 0, 0);
                    a = __builtin_amdgcn_mfma_f32_16x16x32_bf16(k1, q1, a, 0, 0, 0);
                    s[kt] = a;
                }
                u32x4 vv[5][4];
#pragma unroll
                for (int cc = 0; cc < 5; ++cc)
#pragma unroll
                    for (int it = 0; it < 4; ++it) { const int idx = it * 64 + lane, rr = idx >> 3, c16 = idx & 7; int ik = i0 - 128 + cc * 32 + rr; ik = ik < 0 ? 0 : (ik > L - 1 ? L - 1 : ik);
                        vv[cc][it] = *(const u32x4*)(Z + (rowbase + (ik << lg) + r) * NZ + ZV + h * 64 + c16 * 8); }
                float mx = -1e30f;
#pragma unroll
                for (int kt = 0; kt < 9; ++kt)
#pragma unroll
                    for (int j = 0; j < 4; ++j) { const int key = kt * 16 + quad * 4 + j; const int dist = 128 + li - key; const int ik = i0 - 128 + key;
                        const bool valid = (dist >= 0) && (dist <= 128) && (ik >= 0);
                        const float sv = valid ? s[kt][j] : -1e30f; s[kt][j] = sv; mx = fmaxf(mx, sv); }
                mx = fmaxf(mx, __shfl_xor(mx, 16)); mx = fmaxf(mx, __shfl_xor(mx, 32));
                float lsum = 0.f;
#pragma unroll
                for (int kt = 0; kt < 9; ++kt)
#pragma unroll
                    for (int j = 0; j < 4; ++j) { const float pv = __builtin_amdgcn_exp2f((s[kt][j] - mx) * C); s[kt][j] = pv; lsum += pv; }
                lsum += __shfl_xor(lsum, 16); lsum += __shfl_xor(lsum, 32);
                f32x4 o[4];
#pragma unroll
                for (int dt = 0; dt < 4; ++dt) o[dt] = (f32x4){0.f, 0.f, 0.f, 0.f};
#pragma unroll
                for (int cc = 0; cc < 5; ++cc) {
                    asm volatile("s_waitcnt lgkmcnt(0)" ::: "memory");
#pragma unroll
                    for (int it = 0; it < 4; ++it) { const int idx = it * 64 + lane, rr = idx >> 3, c16 = idx & 7;
                        *(LAS u32x4*)(VST + rr * 128 + c16 * 16) = vv[cc][it]; }
                    asm volatile("s_waitcnt lgkmcnt(0)" ::: "memory");
                    bf16x8 pa;
                    { const f32x4 p0 = s[2 * cc]; const unsigned a0 = pk2(p0[0], p0[1]), a1 = pk2(p0[2], p0[3]); unsigned a2 = 0u, a3 = 0u;
                      if (cc < 4) { const f32x4 p1 = s[2 * cc + 1 < 9 ? 2 * cc + 1 : 8]; a2 = pk2(p1[0], p1[1]); a3 = pk2(p1[2], p1[3]); }
                      const u32x4 pw = {a0, a1, a2, a3}; pa = __builtin_bit_cast(bf16x8, pw); }
#pragma unroll
                    for (int dt = 0; dt < 4; ++dt) {
                        LAS unsigned char* ap = VST + (quad * 4 + (li >> 2)) * 128 + (dt * 16 + (li & 3) * 4) * 2;
                        const s16x4 b1 = __builtin_bit_cast(s16x4, __builtin_amdgcn_ds_read_tr16_b64_v4i16((LAS s16x4*)ap));
                        const s16x4 b2 = __builtin_bit_cast(s16x4, __builtin_amdgcn_ds_read_tr16_b64_v4i16((LAS s16x4*)(ap + 16 * 128)));
                        const bf16x8 vb = {b1[0], b1[1], b1[2], b1[3], b2[0], b2[1], b2[2], b2[3]};
                        o[dt] = __builtin_amdgcn_mfma_f32_16x16x32_bf16(pa, vb, o[dt], 0, 0, 0);
                    }
                }
#pragma unroll
                for (int j = 0; j < 4; ++j) {
                    const int qq = quad * 4 + j;
                    const float mr = __shfl(mx, qq), lr = __shfl(lsum, qq);
                    const int tl = (br == 0) ? tu * 16 + qq : (br == 1) ? ((((tu >> 2) * 16 + qq) << 2) + (tu & 3)) : qq * 16 + tu;
                    LAS float* arow = ACC + tl * 68;
                    if (br == 0) {
#pragma unroll
                        for (int dt = 0; dt < 4; ++dt) arow[dt * 16 + li] = o[dt][j];
                        if (li == 0) { ML[tl * 2] = mr; ML[tl * 2 + 1] = lr; }
                    } else {
                        const float m0 = ML[tl * 2], l0 = ML[tl * 2 + 1];
                        const float mn = fmaxf(m0, mr); const float a0 = __builtin_amdgcn_exp2f((m0 - mn) * C), a1 = __builtin_amdgcn_exp2f((mr - mn) * C);
                        const float ln = l0 * a0 + lr * a1;
                        float val[4];
#pragma unroll
                        for (int dt = 0; dt < 4; ++dt) val[dt] = arow[dt * 16 + li] * a0 + o[dt][j] * a1;
                        asm volatile("s_waitcnt lgkmcnt(0)" ::: "memory");
                        if (br == 1) {
#pragma unroll
                            for (int dt = 0; dt < 4; ++dt) arow[dt * 16 + li] = val[dt];
                            if (li == 0) { ML[tl * 2] = mn; ML[tl * 2 + 1] = ln; }
                        } else {
                            const float inv = 1.0f / ln; bf16* orow = MIX + (rowbase + t0 + tl) * DM + h * 64 + li;
#pragma unroll
                            for (int dt = 0; dt < 4; ++dt) orow[dt * 16] = (bf16)f2bf(val[dt] * inv);
                        }
                    }
                }
            }
            __syncthreads();
        }
    }
}

constexpr int TC = 32, NCH = SEQ / TC;
constexpr int SB_STRIDE = 49152, SC_RS = 0, SC_WW = 8192, SC_KS = 16384, SC_KK = 24576, SC_BV = 32768, SC_VS = 40960;
constexpr int ACT_PITCH = 400, SC_ACT = 2 * SB_STRIDE, SC_LTS = SC_ACT + 4 * 8 * ACT_PITCH, SC_MU = SC_LTS + 64 * ACT_PITCH, SC_INV = SC_MU + 1536, SC_CT = SC_INV + 128;
static_assert(SC_CT + 1536 <= LDS_BYTES, "scan LDS map");
typedef float f32x2 __attribute__((ext_vector_type(2)));
struct ScanVec { f32x4 w0, w1, k0, k1, b0, b1, x0, x1, r0, r1; float v; };
__device__ __forceinline__ ScanVec scan_load(LAS const unsigned char* buf, int t, int j0, int irow) {
    ScanVec s; const LAS float* W = (const LAS float*)(buf + SC_WW) + t * 64 + j0; const LAS float* K = (const LAS float*)(buf + SC_KK) + t * 64 + j0; const LAS float* B = (const LAS float*)(buf + SC_BV) + t * 64 + j0;
    const LAS float* X = (const LAS float*)(buf + SC_KS) + t * 64 + j0; const LAS float* R = (const LAS float*)(buf + SC_RS) + t * 64 + j0;
    s.w0 = *(const LAS f32x4*)W; s.w1 = *(const LAS f32x4*)(W + 4); s.k0 = *(const LAS f32x4*)K; s.k1 = *(const LAS f32x4*)(K + 4); s.b0 = *(const LAS f32x4*)B; s.b1 = *(const LAS f32x4*)(B + 4);
    s.x0 = *(const LAS f32x4*)X; s.x1 = *(const LAS f32x4*)(X + 4); s.r0 = *(const LAS f32x4*)R; s.r1 = *(const LAS f32x4*)(R + 4); s.v = ((const LAS float*)(buf + SC_VS))[t * 64 + irow];
    return s;
}
#define LO2(a) ((f32x2){(a).x, (a).y})
#define HI2(a) ((f32x2){(a).z, (a).w})
__device__ __forceinline__ void scan_unit(LAS unsigned char* lds, const Params& p, int layer, int unit, int tid, int wave, int lane) {
    const int chain = unit >> 1, hf = unit & 1, b = chain >> 3, h = chain & 7;
    unsigned char* ws = p.ws;
    const bf16* Z = (const bf16*)(ws + WS_Z); bf16* VF = (bf16*)(ws + WS_VF); bf16* YS = (bf16*)(ws + WS_YS); bf16* GB = (bf16*)(ws + WS_G); bf16* VC = (bf16*)(ws + WS_VC); float* BON = (float*)(ws + WS_BON);
    const bf16* LT = (const bf16*)(ws + WS_LT) + (size_t)layer * 512 * 192;
    const float* mu = p.in[7] + (size_t)layer * 1696; const float* mumv = (layer > 0) ? p.in[8] + (size_t)(layer - 1) * 32 : nullptr;
    const size_t rowbase = (size_t)b * SEQ;
    LAS float* MU = (LAS float*)(lds + SC_MU); LAS unsigned char* LTS = lds + SC_LTS;
    if (tid < 96) { const int cgp = tid, cat = cgp >> 4; const int zc = (cat < 3) ? ZR + cat * 512 + h * 64 + (cgp & 15) * 4 : ZXW + (cgp - 48) * 4;
        const bool ismv = zc >= ZMV; const float* src = ismv ? (mumv ? mumv + (zc - ZMV) : mu) : mu + (zc - ZR);
        f32x4 m4 = *(const f32x4*)src; if (ismv && !mumv) m4 = (f32x4){0.f, 0.f, 0.f, 0.f};
        *(LAS f32x4*)(MU + cgp * 4) = m4; }
    if (tid < 384) { const int arr = tid >> 6, c = tid & 63, gi = layer * 512 + h * 64 + c; float v;
        if (arr == 0) v = p.in[10][gi]; else if (arr == 1) v = p.in[12][gi]; else if (arr == 2) v = (layer > 0) ? p.in[14][(layer - 1) * 512 + h * 64 + c] : 0.f; else if (arr == 3) v = p.in[17][gi]; else if (arr == 4) v = p.in[18][gi]; else v = p.in[19][gi];
        ((LAS float*)(lds + SC_CT))[tid] = v; }
    for (int i = tid; i < 64 * 24; i += 512) { const int c = i / 24, ch = i % 24; *(LAS u32x4*)(LTS + c * ACT_PITCH + ch * 16) = *(const u32x4*)(LT + (size_t)(h * 64 + c) * 192 + ch * 8); }
    __syncthreads();
    if (wave < 4) {
        const int rl = wave * 8 + (lane >> 3), irow = hf * 32 + rl, q = lane & 7, j0 = q * 8;
        f32x2 S0 = {0.f, 0.f}, S1 = {0.f, 0.f}, S2 = {0.f, 0.f}, S3 = {0.f, 0.f}; float ykeep = 0.f;
        __syncthreads();
#pragma unroll 1
        for (int c = 0; c < NCH; ++c) {
            LAS const unsigned char* buf = lds + (c & 1) * SB_STRIDE;
            const int tch = c * TC;
            ScanVec cur = scan_load(buf, 0, j0, irow);
#pragma unroll
            for (int t = 0; t < TC; ++t) {
                ScanVec nx; if (t + 1 < TC) nx = scan_load(buf, t + 1, j0, irow); else nx = cur;
                f32x2 d = S0 * LO2(cur.k0); d = S1 * HI2(cur.k0) + d; d = S2 * LO2(cur.k1) + d; d = S3 * HI2(cur.k1) + d;
                float sa = rowsum8(d.x + d.y);
                const f32x2 v2 = {cur.v, cur.v}, sa2 = {sa, sa};
                S0 = S0 * LO2(cur.w0) + (v2 * LO2(cur.x0) - sa2 * LO2(cur.b0)); S1 = S1 * HI2(cur.w0) + (v2 * HI2(cur.x0) - sa2 * HI2(cur.b0));
                S2 = S2 * LO2(cur.w1) + (v2 * LO2(cur.x1) - sa2 * LO2(cur.b1)); S3 = S3 * HI2(cur.w1) + (v2 * HI2(cur.x1) - sa2 * HI2(cur.b1));
                f32x2 e = S0 * LO2(cur.r0); e = S1 * HI2(cur.r0) + e; e = S2 * LO2(cur.r1) + e; e = S3 * HI2(cur.r1) + e;
                const float y = rowsum8(e.x + e.y);
                ykeep = (q == (t & 7)) ? y : ykeep;
                if ((t & 7) == 7) YS[(rowbase + tch + (t & ~7) + q) * 512 + h * 64 + irow] = (bf16)f2bf(ykeep);
                cur = nx;
            }
            __syncthreads();
        }
    } else {
        const int pw = wave - 4, s = lane >> 3, q = lane & 7, li = lane & 15, quad = lane >> 4;
        LAS unsigned char* ACT = lds + SC_ACT + pw * 8 * ACT_PITCH; LAS float* INV = (LAS float*)(lds + SC_INV) + pw * 8;
        const LAS float* CT = (const LAS float*)(lds + SC_CT);
        u32x2 pc[12], pp[12]; u32x4 pvf[2];
        pvf[0] = (u32x4){0u, 0u, 0u, 0u}; pvf[1] = pvf[0];
#define PR_OFF(k) ((k) < 2 ? (ZR - ZKR) + (k) * 32 : (k) < 4 ? ((k) - 2) * 32 : (k) < 6 ? (ZVR - ZKR) + ((k) - 4) * 32 : ((k) - 6) * 32)
#define PR_ISSUE(tchv) do { const int tg = (tchv) + pw * 8 + s; const int tgp = tg > 0 ? tg - 1 : 0; \
        const bf16* c1 = Z + (rowbase + tg) * NZ + ZKR + h * 64 + q * 4; const bf16* c2 = Z + (rowbase + tg) * NZ + ZXW + q * 4; \
        const bf16* p1 = Z + (rowbase + tgp) * NZ + ZKR + h * 64 + q * 4; const bf16* p2 = Z + (rowbase + tgp) * NZ + ZXW + q * 4; \
        asm volatile("" : "+v"(c1), "+v"(c2), "+v"(p1), "+v"(p2)); \
        _Pragma("unroll") for (int k = 0; k < 12; ++k) { pc[k] = *(const __attribute__((address_space(1))) u32x2*)((k < 6 ? c1 : c2) + PR_OFF(k)); pp[k] = *(const __attribute__((address_space(1))) u32x2*)((k < 6 ? p1 : p2) + PR_OFF(k)); } \
        if (layer > 0) { pvf[0] = *(const u32x4*)(VF + (rowbase + (tchv) + pw * 8 + s) * 512 + h * 64 + q * 8); } } while (0)
        PR_ISSUE(0);
#pragma unroll 1
        for (int c = 0; c <= NCH; ++c) {
            if (c < NCH) {
                const int tch = c * TC;
                LAS unsigned char* buf = lds + (c & 1) * SB_STRIDE;
                LAS float* RS = (LAS float*)(buf + SC_RS); LAS float* WW = (LAS float*)(buf + SC_WW); LAS float* KS = (LAS float*)(buf + SC_KS); LAS float* KK = (LAS float*)(buf + SC_KK);
                LAS float* BV = (LAS float*)(buf + SC_BV); LAS float* VS = (LAS float*)(buf + SC_VS);
                const u32x4 cvf0 = pvf[0];
                const float pz = (tch + pw * 8 + s > 0) ? 1.0f : 0.0f;
                const int trow = pw * 8 + s;
#pragma unroll
                for (int k = 0; k < 12; ++k) {
                    const u32x2 cw = pc[k], pw2 = pp[k];
                    const f32x4 m4 = *(const LAS f32x4*)(MU + (k * 8 + q) * 4);
                    const float c0 = bflo(cw.x), c1 = bfhi(cw.x), c2 = bflo(cw.y), c3 = bfhi(cw.y), p0 = bflo(pw2.x) * pz, p1 = bfhi(pw2.x) * pz, p2 = bflo(pw2.y) * pz, p3 = bfhi(pw2.y) * pz;
                    f32x4 v = {c0 + (p0 - c0) * m4.x, c1 + (p1 - c1) * m4.y, c2 + (p2 - c2) * m4.z, c3 + (p3 - c3) * m4.w};
                    if (k < 2) *(LAS f32x4*)(RS + trow * 64 + (k * 8 + q) * 4) = v;
                    else if (k < 4) *(LAS f32x4*)(KS + trow * 64 + ((k - 2) * 8 + q) * 4) = v;
                    else if (k < 6) *(LAS f32x4*)(VS + trow * 64 + ((k - 4) * 8 + q) * 4) = v;
                    else {
                        const int ac = ((k - 6) * 8 + q) * 4;
                        if (k == 6) {
#pragma unroll
                            for (int e = 0; e < 4; ++e) v[e] = 1.0f - 2.0f * __builtin_amdgcn_rcpf(1.0f + __expf(2.0f * v[e])); }
                        else if (k >= 8 && k <= 10) {
#pragma unroll
                            for (int e = 0; e < 4; ++e) v[e] = __builtin_amdgcn_rcpf(1.0f + __expf(-v[e])); }
                        u32x2 w; w.x = pk2(v.x, v.y); w.y = pk2(v.z, v.w); *(LAS u32x2*)(ACT + s * ACT_PITCH + ac * 2) = w; }
                }
                if (c + 1 < NCH) PR_ISSUE(tch + TC);
                asm volatile("s_waitcnt lgkmcnt(0)" ::: "memory");
                { const f32x4 ka = *(const LAS f32x4*)(KS + trow * 64 + q * 8), kb = *(const LAS f32x4*)(KS + trow * 64 + q * 8 + 4); const f32x4 kc0 = *(const LAS f32x4*)(CT + 3 * 64 + q * 8), kc1 = *(const LAS f32x4*)(CT + 3 * 64 + q * 8 + 4); const float kkl[8] = {kc0.x, kc0.y, kc0.z, kc0.w, kc1.x, kc1.y, kc1.z, kc1.w};
                  float ss = ((ka.x * kkl[0]) * (ka.x * kkl[0]) + (ka.y * kkl[1]) * (ka.y * kkl[1])) + ((ka.z * kkl[2]) * (ka.z * kkl[2]) + (ka.w * kkl[3]) * (ka.w * kkl[3]));
                  ss += ((kb.x * kkl[4]) * (kb.x * kkl[4]) + (kb.y * kkl[5]) * (kb.y * kkl[5])) + ((kb.z * kkl[6]) * (kb.z * kkl[6]) + (kb.w * kkl[7]) * (kb.w * kkl[7]));
                  ss = rowsum8(ss);
                  if (q == 0) INV[s] = 1.0f / fmaxf(sqrtf(ss), 1e-12f); }
                asm volatile("s_waitcnt lgkmcnt(0)" ::: "memory");
                {
                    bf16x8 Af[6];
#pragma unroll
                    for (int ks = 0; ks < 6; ++ks) Af[ks] = *(const LAS bf16x8*)(ACT + (li & 7) * ACT_PITCH + ks * 64 + quad * 16);
                    asm volatile("s_waitcnt lgkmcnt(0)" ::: "memory");
                    LAS float* GT = (LAS float*)ACT;
                    const int lbase = (pw * 8 + (quad & 1) * 4) * 64 + li;
#pragma unroll
                    for (int ct = 0; ct < 4; ++ct) {
                        bf16x8 Bf[6];
#pragma unroll
                        for (int ks = 0; ks < 6; ++ks) Bf[ks] = *(const LAS bf16x8*)(LTS + (ct * 16 + li) * ACT_PITCH + ks * 64 + quad * 16);
                        const f32x4 z4 = {0.f, 0.f, 0.f, 0.f};
                        const f32x4 LW = __builtin_amdgcn_mfma_f32_16x16x32_bf16(Af[0], Bf[0], z4, 0, 0, 0);
                        const f32x4 AA = __builtin_amdgcn_mfma_f32_16x16x32_bf16(Af[1], Bf[1], z4, 0, 0, 0);
                        f32x4 G = __builtin_amdgcn_mfma_f32_16x16x32_bf16(Af[2], Bf[2], z4, 0, 0, 0);
                        G = __builtin_amdgcn_mfma_f32_16x16x32_bf16(Af[3], Bf[3], G, 0, 0, 0);
                        G = __builtin_amdgcn_mfma_f32_16x16x32_bf16(Af[4], Bf[4], G, 0, 0, 0);
                        const f32x4 VG = __builtin_amdgcn_mfma_f32_16x16x32_bf16(Af[5], Bf[5], z4, 0, 0, 0);
                        if (quad < 2) {
#pragma unroll
                            for (int j = 0; j < 4; ++j) { const int lo = lbase + j * 64 + ct * 16; WW[lo] = LW[j]; KK[lo] = AA[j]; BV[lo] = VG[j]; GT[((quad & 1) * 4 + j) * 64 + ct * 16 + li] = G[j]; }
                        }
                    }
                }
                asm volatile("s_waitcnt lgkmcnt(0)" ::: "memory");
                {
                    const LAS float* GT = (const LAS float*)ACT;
                    const int lo8 = trow * 64 + q * 8; const size_t go8 = (rowbase + tch + trow) * 512 + h * 64 + q * 8;
                    float r[8], k[8], v[8], lw[8], aa[8], vg[8], g[8], c_w0[8], c_a0[8], c_v0[8], c_kk[8], c_ka[8], c_rk[8];
#define LD8(dst, ptr) do { const f32x4 _a = *(const LAS f32x4*)(ptr), _b = *(const LAS f32x4*)((ptr) + 4); dst[0] = _a.x; dst[1] = _a.y; dst[2] = _a.z; dst[3] = _a.w; dst[4] = _b.x; dst[5] = _b.y; dst[6] = _b.z; dst[7] = _b.w; } while (0)
                    LD8(r, RS + lo8); LD8(k, KS + lo8); LD8(v, VS + lo8); LD8(lw, WW + lo8); LD8(aa, KK + lo8); LD8(vg, BV + lo8); LD8(g, GT + s * 64 + q * 8);
                    LD8(c_w0, CT + q * 8); LD8(c_a0, CT + 64 + q * 8); LD8(c_v0, CT + 128 + q * 8); LD8(c_kk, CT + 192 + q * 8); LD8(c_ka, CT + 256 + q * 8); LD8(c_rk, CT + 320 + q * 8);
                    const float invn = INV[s];
                    float vf[8];
                    { const u32x4 cv = cvf0; vf[0] = bflo(cv.x); vf[1] = bfhi(cv.x); vf[2] = bflo(cv.y); vf[3] = bfhi(cv.y); vf[4] = bflo(cv.z); vf[5] = bfhi(cv.z); vf[6] = bflo(cv.w); vf[7] = bfhi(cv.w); }
                    float ow[8], okm[8], okk[8], obv[8]; float bp = 0.f;
#pragma unroll
                    for (int e = 0; e < 8; ++e) {
                        const float sg = __builtin_amdgcn_rcpf(1.0f + __expf(-(c_w0[e] + lw[e])));
                        ow[e] = __expf(-0.6065306597126334f * sg);
                        const float a = __builtin_amdgcn_rcpf(1.0f + __expf(-(c_a0[e] + aa[e])));
                        okk[e] = k[e] * c_kk[e] * invn; okm[e] = k[e] * (1.0f + (a - 1.0f) * c_ka[e]); obv[e] = okk[e] * a;
                        if (layer > 0) { const float vgs = __builtin_amdgcn_rcpf(1.0f + __expf(-(c_v0[e] + vg[e]))); v[e] = v[e] + (vf[e] - v[e]) * vgs; }
                        bp += r[e] * okm[e] * c_rk[e];
                    }
#define ST8(ptr, src) do { *(LAS f32x4*)(ptr) = (f32x4){src[0], src[1], src[2], src[3]}; *(LAS f32x4*)((ptr) + 4) = (f32x4){src[4], src[5], src[6], src[7]}; } while (0)
                    ST8(WW + lo8, ow); ST8(KS + lo8, okm); ST8(KK + lo8, okk); ST8(BV + lo8, obv); ST8(VS + lo8, v);
                    bp = rowsum8(bp);
                    if (hf == 0) {
                        u32x4 gv, vv; gv.x = pk2(g[0], g[1]); gv.y = pk2(g[2], g[3]); gv.z = pk2(g[4], g[5]); gv.w = pk2(g[6], g[7]);
                        vv.x = pk2(v[0], v[1]); vv.y = pk2(v[2], v[3]); vv.z = pk2(v[4], v[5]); vv.w = pk2(v[6], v[7]);
                        *(u32x4*)(GB + go8) = gv; *(u32x4*)(VC + go8) = vv; if (layer == 0) *(u32x4*)(VF + go8) = vv;
                        if (q == 0) BON[(rowbase + tch + trow) * 8 + h] = bp;
                    }
                }
            }
            __syncthreads();
        }
    }
}

#ifdef MK_GEMM_TWICE
#define GEMM_AGAIN __syncthreads(); pg8::gemm_phase<decltype(E), pg8::StaticOrder, true, true>(lds, g, S, E, wave_s)
#else
#define GEMM_AGAIN
#endif
#ifdef MK_ATTN_TWICE
#define ATTN_CALL2 attn_unit(lds, Zb, XN, u - 128, wave, lane)
#else
#define ATTN_CALL2
#endif
#ifndef MK_NO_SCAN
#define SCAN_CALL scan_unit(lds, p, l, u, tid, wave, lane)
#else
#define SCAN_CALL
#endif
#ifndef MK_NO_ATTN
#define ATTN_CALL attn_unit(lds, Zb, XN, u - 128, wave, lane)
#else
#define ATTN_CALL
#endif
__global__ void __launch_bounds__(512, 2) mk_fwd(Params p) {
    extern __shared__ __attribute__((aligned(16))) unsigned char lds_raw[];
    LAS unsigned char* lds = (LAS unsigned char*)lds_raw;
    cg::grid_group grid = cg::this_grid();
    const int G = gridDim.x, NGW = G * 8;
    const int wave_s = __builtin_amdgcn_readfirstlane(threadIdx.x >> 6);
    unsigned char* ws = p.ws;
    bf16* XN = (bf16*)(ws + WS_XN); bf16* Zb = (bf16*)(ws + WS_Z); bf16* Hb = (bf16*)(ws + WS_H); bf16* Y1 = (bf16*)(ws + WS_Y1);
    int ph = 0;
#define PH_ON (ph >= p.ph_lo && ph < p.ph_hi)
#define PH_END do { if (ph + 1 < p.ph_hi) grid.sync(); } while (0)
    if (PH_ON) { MK_IDS; prologue(p, lds, gw, NGW, wave, lane); PH_END; } ++ph;
#pragma unroll 1
    for (int l = 0; l < DEPTH; ++l) {
        if (PH_ON) { pg8::Gemm g{XN, (const bf16*)(ws + WS_WIN) + (size_t)l * NZ * 1024, NT, NZ, 1024}; pg8::StaticOrder S; S.init(NT, NZ, G, (int)blockIdx.x);
            pg8::EpiAct<0> E{Zb, NZ}; pg8::gemm_phase<pg8::EpiAct<0>, pg8::StaticOrder, true, true>(lds, g, S, E, wave_s); GEMM_AGAIN; PH_END; } ++ph;
        if (PH_ON) { MK_IDS;
            for (int u = blockIdx.x; u < 128; u += G) { SCAN_CALL; __syncthreads(); }
            for (int u = (blockIdx.x >= 128 ? blockIdx.x : blockIdx.x + ((127 - blockIdx.x) / G + 1) * G); u < 256; u += G) { ATTN_CALL; __syncthreads(); ATTN_CALL2; __syncthreads(); }
#ifdef MK_P2_TWICE
            __syncthreads();
            for (int u = blockIdx.x; u < 128; u += G) { SCAN_CALL; __syncthreads(); }
            for (int u = (blockIdx.x >= 128 ? blockIdx.x : blockIdx.x + ((127 - blockIdx.x) / G + 1) * G); u < 256; u += G) { ATTN_CALL; __syncthreads(); ATTN_CALL2; __syncthreads(); }
#endif
            PH_END; } ++ph;
        if (PH_ON) { MK_IDS; post_phase(XN, (const bf16*)(ws + WS_YS), (const bf16*)(ws + WS_G), (const bf16*)(ws + WS_VC), (const float*)(ws + WS_BON), p.in[9] + l * 512, p.in[20] + l * 512, p.in[21] + l * 512, gw, NGW, lane); PH_END; } ++ph;
        if (PH_ON) { pg8::Gemm g{XN, (const bf16*)(ws + WS_WOUT) + (size_t)l * 1024 * 1024, NT, 1024, 1024}; pg8::StaticOrder S; S.init(NT, 1024, G, (int)blockIdx.x);
            pg8::EpiAct<0> E{Y1, 1024}; pg8::gemm_phase<pg8::EpiAct<0>, pg8::StaticOrder, true, true>(lds, g, S, E, wave_s); GEMM_AGAIN; PH_END; } ++ph;
        if (PH_ON) { MK_IDS; norm_phase(Y1, p.out, XN, p.in[2] + l * 1024, p.in[3] + l * 1024, gw, NGW, lane); PH_END; } ++ph;
        if (PH_ON) { pg8::Gemm g{XN, (const bf16*)(ws + WS_WUP) + (size_t)l * 4096 * 1024, NT, DFF, 1024}; pg8::StaticOrder S; S.init(NT, DFF, G, (int)blockIdx.x);
            pg8::EpiAct<1> E{Hb, DFF}; pg8::gemm_phase<pg8::EpiAct<1>, pg8::StaticOrder, true, true>(lds, g, S, E, wave_s); GEMM_AGAIN; PH_END; } ++ph;
        if (PH_ON) { pg8::Gemm g{Hb, (const bf16*)(ws + WS_WDN) + (size_t)l * 1024 * 4096, NT, 1024, DFF}; pg8::StaticOrder S; S.init(NT, 1024, G, (int)blockIdx.x);
            pg8::EpiAct<0> E{XN, 1024}; pg8::gemm_phase<pg8::EpiAct<0>, pg8::StaticOrder, true, true>(lds, g, S, E, wave_s); GEMM_AGAIN; PH_END; } ++ph;
        if (PH_ON) { MK_IDS; norm_phase(XN, p.out, XN, p.in[4] + l * 1024, (l + 1 < DEPTH) ? p.in[1] + (l + 1) * 1024 : nullptr, gw, NGW, lane); PH_END; } ++ph;
    }
}
constexpr int N_PHASES = 1 + 8 * DEPTH;

extern "C" void kernel_launch(void* const* d_in, const int* in_sizes, int n_in, void* d_out, int out_size, void* d_ws, size_t ws_size, hipStream_t stream) {
    static int grid = 0;
    if (grid == 0) {
        if (n_in != 25 || out_size != NT * DM || ws_size < WS_END) { fprintf(stderr, "kernel_launch: unexpected sizes n_in=%d out=%d ws=%zu\n", n_in, out_size, ws_size); grid = -1; return; }
        int dev = 0, cus = 0, per_cu = 0;
        hipGetDevice(&dev); hipDeviceGetAttribute(&cus, hipDeviceAttributeMultiprocessorCount, dev);
        if (hipFuncSetAttribute((const void*)mk_fwd, hipFuncAttributeMaxDynamicSharedMemorySize, LDS_BYTES) != hipSuccess) { fprintf(stderr, "kernel_launch: hipFuncSetAttribute failed\n"); grid = -1; return; }
        if (hipOccupancyMaxActiveBlocksPerMultiprocessor(&per_cu, (const void*)mk_fwd, 512, LDS_BYTES) != hipSuccess || per_cu < 1) { fprintf(stderr, "kernel_launch: occupancy query gave %d\n", per_cu); per_cu = 1; }
        (void)hipGetLastError();
        grid = cus * per_cu;
        fprintf(stderr, "kernel_launch: grid %d (cus %d x %d)\n", grid, cus, per_cu);
    }
    if (grid < 0) return;
    Params p{};
    for (int i = 0; i < 25; ++i) p.in[i] = (const float*)d_in[i];
    p.out = (float*)d_out; p.ws = (unsigned char*)d_ws;
#if MK_MULTI
    for (int ph = 0; ph < N_PHASES; ++ph) { p.ph_lo = ph; p.ph_hi = ph + 1; int reps = 1;
#ifdef MK_REP_P2
        if (ph >= 1 && ((ph - 1) % 8) == 1) reps = 2;
#endif
#ifdef MK_REP_P0
        if (ph == 0) reps = 2;
#endif
        for (int r = 0; r < reps; ++r) hipLaunchKernelGGL(mk_fwd, dim3(grid), dim3(512), LDS_BYTES, stream, p); }
#else
    p.ph_lo = 0; p.ph_hi = N_PHASES;
    void* args[] = {&p};
    hipError_t e = hipLaunchCooperativeKernel((const void*)mk_fwd, dim3(grid), dim3(512), args, LDS_BYTES, stream);
    if (e != hipSuccess) fprintf(stderr, "kernel_launch: cooperative launch failed: %s (grid %d)\n", hipGetErrorString(e), grid);
#endif
}
```

```cpp
#include <hip/hip_runtime.h>
#include <hip/hip_cooperative_groups.h>
#include <cstdio>
#include <cstdint>
namespace cg = cooperative_groups;
#ifndef MK_MULTI
#define MK_MULTI 0
#endif
namespace pg8 {
#define PG8_LAS __attribute__((address_space(3)))
typedef unsigned short bf16_t;
typedef short bf16x8 __attribute__((ext_vector_type(8)));
typedef float f32x4 __attribute__((ext_vector_type(4)));
typedef unsigned u32x4 __attribute__((ext_vector_type(4)));
constexpr int BM = 256, BK = 64, HALF = 128, HTB = HALF * BK * 2  , STAGE_BYTES = 8 * HTB, NXCD = 8, WGM = 8;

__host__ __device__ __forceinline__ int lds_byte(int r, int c) { const int st = (r >> 4) * 2 + (c >> 5), rr = r & 15, cc = c & 31, ob = rr * 64 + cc * 2; return st * 1024 + (ob ^ (((ob >> 9) & 1) << 5)); }
__host__ __device__ __forceinline__ void stage_rc(int b, int& R, int& C) { const int st = b / 1024, sb = b % 1024, swz = sb ^ (((sb >> 9) & 1) << 5); R = (st >> 1) * 16 + swz / 64; C = (st & 1) * 32 + (swz % 64) / 2; }
__host__ __device__ __forceinline__ int perm32(int rho) { const int n = rho >> 4, i = rho & 15; return 8 * (i >> 2) + 4 * n + (i & 3); }

struct Unit { int pm, pn; };
struct Gemm { const bf16_t* A; const bf16_t* Bt; int M, N, K; };
struct StaticOrder {
    int nM, nN, nwg, G, c;
    __host__ __device__ void init(int M, int N, int G_, int c_) { nM = M / BM; nN = N / BM; nwg = nM * nN; G = G_; c = c_; }
    __host__ __device__ bool next(int i, Unit& u) const {
        const long L = (long)i * G + c; if (L >= nwg) return false;
        int wgid = (int)L; { const int q = nwg / NXCD, r = nwg % NXCD, xcd = wgid % NXCD, off = wgid / NXCD; wgid = (xcd < r ? xcd * (q + 1) : r * (q + 1) + (xcd - r) * q) + off; }
        const int nig = WGM * nN, gid = wgid / nig, fm = gid * WGM, gsz = (nM - fm) < WGM ? (nM - fm) : WGM;
        u.pm = fm + ((wgid % nig) % gsz); u.pn = (wgid % nig) / gsz; return true;
    }
    __device__ __forceinline__ void a_ready(const Unit&) const {}
    __device__ __forceinline__ void done(const Unit&) const {}
};
__device__ __forceinline__ unsigned cvt_pk_bf16(float lo, float hi) { unsigned r; asm volatile("v_cvt_pk_bf16_f32 %0, %1, %2" : "=v"(r) : "v"(lo), "v"(hi)); return r; }
typedef float f32x2 __attribute__((ext_vector_type(2)));
__device__ __forceinline__ int mk_tid(const int w) { unsigned m = ~0u; asm volatile("" : "+s"(m)); const int l = __builtin_amdgcn_mbcnt_hi(m, __builtin_amdgcn_mbcnt_lo(m, 0u)); int t = w * 64 + l; asm volatile("" : "+v"(t)); return t; }
template <int ACT> struct EpiAct {
    static constexpr bool PERM = true, AFTER_DRAIN = false;
    bf16_t* O; int ldc;
    __device__ __forceinline__ void operator()(const f32x4 (&acc)[2][2][4][2], const Unit& u, int wr, int wc, int fr, int fq) const {
        const int row0 = u.pm * BM + wr * 64 + fr; const int col0 = u.pn * BM + wc * 32 + 8 * fq;
#pragma unroll
        for (int ai = 0; ai < 2; ++ai)
#pragma unroll
            for (int m = 0; m < 4; ++m) { bf16_t* rowp = O + (size_t)(row0 + ai * HALF + m * 16) * ldc + col0;
#pragma unroll
                for (int bj = 0; bj < 2; ++bj) { f32x4 v0 = acc[ai][bj][m][0], v1 = acc[ai][bj][m][1];
                    if (ACT == 1) {
#pragma unroll
                        for (int e = 0; e < 4; ++e) { float a = v0[e] > 0.f ? v0[e] : 0.f, b = v1[e] > 0.f ? v1[e] : 0.f; v0[e] = a * a; v1[e] = b * b; } }
                    u32x4 w; w.x = cvt_pk_bf16(v0[0], v0[1]); w.y = cvt_pk_bf16(v0[2], v0[3]); w.z = cvt_pk_bf16(v1[0], v1[1]); w.w = cvt_pk_bf16(v1[2], v1[3]);
                    *(u32x4*)(rowp + bj * HALF) = w; } }
    }
};
template <class Epi, class Sched, bool ALIGN_EPI = false, bool SP2 = false>
__device__ __forceinline__ void gemm_phase(PG8_LAS unsigned char* lds, const Gemm g, const Sched& S, const Epi& E, const int wave_s) {
    const int tid = mk_tid(wave_s), wid = __builtin_amdgcn_readfirstlane(tid >> 6), lane = tid & 63, wr = wid >> 2, wc = wid & 3, fr = lane & 15, fq = lane >> 4;
    const int K = g.K, nt = K / BK;
    unsigned voffA[2], voffB[2];
#pragma unroll
    for (int i = 0; i < 2; ++i) { int R, C; stage_rc(tid * 16 + i * 8192, R, C); const int Rb = Epi::PERM ? ((R & ~31) + perm32(R & 31)) : R;
        voffA[i] = (unsigned)(R * K + C) * 2u; voffB[i] = (unsigned)(Rb * K + C) * 2u; }
    const size_t kstep = (size_t)(BK * 2);
    const size_t hstep = (size_t)HALF * K * 2;
    const size_t tstep = 2 * hstep;
    const unsigned ldsw = (unsigned)wid * 1024u;
    const int aoff = lds_byte(wr * 64 + fr, fq * 8), boff = lds_byte(wc * 32 + fr, fq * 8);
#define PG8_SA(b, h) (((b) * 2 + (h)) * HTB)
#define PG8_SB(b, h) ((4 + (b) * 2 + (h)) * HTB)
#define PG8_STAGE(bufoff, gbase, voff) do { _Pragma("unroll") for (int _i = 0; _i < 2; ++_i) \
        __builtin_amdgcn_global_load_lds((const unsigned*)((const char*)(gbase) + (voff)[_i]), (PG8_LAS unsigned*)(lds + (bufoff) + ldsw + _i * 8192), 16, 0, 0); } while (0)
#define PG8_LDA(dst, b, h) do { _Pragma("unroll") for (int m = 0; m < 4; ++m) _Pragma("unroll") for (int k = 0; k < 2; ++k) dst[m][k] = *(const PG8_LAS bf16x8*)(lds + PG8_SA(b, h) + aoff + m * 2048 + k * 1024); } while (0)
#define PG8_LDB(dst, b, h) do { _Pragma("unroll") for (int n = 0; n < 2; ++n) _Pragma("unroll") for (int k = 0; k < 2; ++k) dst[n][k] = *(const PG8_LAS bf16x8*)(lds + PG8_SB(b, h) + boff + n * 2048 + k * 1024); } while (0)
#define PG8_MMA(ai, bj, At, Bt) do { __builtin_amdgcn_s_setprio(1); _Pragma("unroll") for (int m = 0; m < 4; ++m) _Pragma("unroll") for (int n = 0; n < 2; ++n) _Pragma("unroll") for (int k = 0; k < 2; ++k) \
        acc[ai][bj][m][n] = __builtin_amdgcn_mfma_f32_16x16x32_bf16(Bt[n][k], At[m][k], acc[ai][bj][m][n], 0, 0, 0); __builtin_amdgcn_s_setprio(0); } while (0)
#define PG8_WAIT_V(n) asm volatile("s_waitcnt vmcnt(" #n ")" ::: "memory")
#define PG8_WAIT_L(n) asm volatile("s_waitcnt lgkmcnt(" #n ")" ::: "memory")
#define PG8_BAR __builtin_amdgcn_s_barrier()
#define PG8_SCHED __builtin_amdgcn_sched_barrier(0)
    Unit cur, nxt; int ui = 0;
    if (!S.next(0, cur)) return;
    f32x4 acc[2][2][4][2];
#pragma unroll
    for (int a = 0; a < 2; ++a)
#pragma unroll
        for (int b = 0; b < 2; ++b)
#pragma unroll
            for (int m = 0; m < 4; ++m)
#pragma unroll
                for (int n = 0; n < 2; ++n) acc[a][b][m][n] = (f32x4){0.f, 0.f, 0.f, 0.f};
    bf16x8 At[4][2], B0[2][2], B1[2][2];
    const char* cA = (const char*)g.A + (size_t)cur.pm * tstep; const char* cB = (const char*)g.Bt + (size_t)cur.pn * tstep;
    S.a_ready(cur);
    if constexpr (SP2) {
        PG8_STAGE(PG8_SB(0, 0), cB, voffB); PG8_STAGE(PG8_SB(0, 1), cB + hstep, voffB); PG8_STAGE(PG8_SA(0, 0), cA, voffA); PG8_STAGE(PG8_SA(0, 1), cA + hstep, voffA);
        if (wr == 1) PG8_BAR;
        PG8_WAIT_V(2); PG8_BAR;
        PG8_STAGE(PG8_SB(1, 0), cB + kstep, voffB); PG8_STAGE(PG8_SA(1, 0), cA + kstep, voffA); PG8_STAGE(PG8_SB(1, 1), cB + hstep + kstep, voffB);
        PG8_WAIT_V(6); PG8_BAR;
    } else {
        PG8_STAGE(PG8_SB(0, 0), cB, voffB); PG8_STAGE(PG8_SA(0, 0), cA, voffA); PG8_STAGE(PG8_SB(0, 1), cB + hstep, voffB); PG8_STAGE(PG8_SA(0, 1), cA + hstep, voffA);
        if (wr == 1) PG8_BAR;
        PG8_WAIT_V(4); PG8_BAR;
        PG8_STAGE(PG8_SB(1, 0), cB + kstep, voffB); PG8_STAGE(PG8_SA(1, 0), cA + kstep, voffA); PG8_STAGE(PG8_SB(1, 1), cB + hstep + kstep, voffB);
        PG8_WAIT_V(6); PG8_BAR;
    }
    for (;;) {
        const bool has_next = S.next(ui + 1, nxt);
        const char* nA = has_next ? (const char*)g.A + (size_t)nxt.pm * tstep : cA; const char* nB = has_next ? (const char*)g.Bt + (size_t)nxt.pn * tstep : cB;
        for (int t = 0; t < nt; t += 2) {
            const bool last = (t == nt - 2);
            const char* a1 = cA + (size_t)(t + 1) * kstep;
            const char* a2 = last ? nA : cA + (size_t)(t + 2) * kstep; const char* b2 = last ? nB : cB + (size_t)(t + 2) * kstep;
            const char* a3 = a2 + kstep; const char* b3 = b2 + kstep;
            if (last && has_next) S.a_ready(nxt);
            if constexpr (SP2) {
            PG8_LDB(B0, 0, 0); PG8_LDB(B1, 0, 1); PG8_SCHED; PG8_LDA(At, 0, 0); PG8_STAGE(PG8_SA(1, 1), a1 + hstep, voffA);
            PG8_WAIT_V(8); PG8_WAIT_L(0); PG8_BAR; PG8_MMA(0, 0, At, B0); PG8_MMA(0, 1, At, B1); PG8_BAR; PG8_SCHED;
            PG8_LDA(At, 0, 1); PG8_STAGE(PG8_SB(0, 0), b2, voffB); PG8_STAGE(PG8_SB(0, 1), b2 + hstep, voffB); PG8_STAGE(PG8_SA(0, 0), a2, voffA);
            PG8_WAIT_V(8); PG8_WAIT_L(0); PG8_BAR; PG8_MMA(1, 0, At, B0); PG8_MMA(1, 1, At, B1); PG8_BAR; PG8_SCHED;
            PG8_LDB(B0, 1, 0); PG8_LDB(B1, 1, 1); PG8_SCHED; PG8_LDA(At, 1, 0); PG8_STAGE(PG8_SA(0, 1), a2 + hstep, voffA);
            PG8_WAIT_V(8); PG8_WAIT_L(0); PG8_BAR; PG8_MMA(0, 0, At, B0); PG8_MMA(0, 1, At, B1); PG8_BAR; PG8_SCHED;
            PG8_LDA(At, 1, 1); PG8_STAGE(PG8_SB(1, 0), b3, voffB); PG8_STAGE(PG8_SB(1, 1), b3 + hstep, voffB); PG8_STAGE(PG8_SA(1, 0), a3, voffA);
            PG8_WAIT_V(8); PG8_WAIT_L(0); PG8_BAR; PG8_MMA(1, 0, At, B0); PG8_MMA(1, 1, At, B1); PG8_BAR; PG8_SCHED;
            } else {
            PG8_LDB(B0, 0, 0); PG8_SCHED; PG8_LDA(At, 0, 0); PG8_STAGE(PG8_SA(1, 1), a1 + hstep, voffA);
            PG8_WAIT_L(8); PG8_BAR; PG8_WAIT_L(0); PG8_MMA(0, 0, At, B0); PG8_BAR; PG8_SCHED;
            PG8_LDB(B1, 0, 1); PG8_STAGE(PG8_SB(0, 0), b2, voffB);
            PG8_BAR; PG8_WAIT_L(0); PG8_MMA(0, 1, At, B1); PG8_BAR;
            PG8_LDA(At, 0, 1); PG8_STAGE(PG8_SA(0, 0), a2, voffA);
            PG8_BAR; PG8_WAIT_L(0); PG8_MMA(1, 0, At, B0); PG8_BAR; PG8_SCHED;
            PG8_STAGE(PG8_SB(0, 1), b2 + hstep, voffB);
            PG8_WAIT_V(6); PG8_BAR; PG8_MMA(1, 1, At, B1); PG8_BAR;
            PG8_LDB(B0, 1, 0); PG8_SCHED; PG8_LDA(At, 1, 0); PG8_STAGE(PG8_SA(0, 1), a2 + hstep, voffA);
            PG8_WAIT_L(8); PG8_BAR; PG8_WAIT_L(0); PG8_MMA(0, 0, At, B0); PG8_BAR; PG8_SCHED;
            PG8_LDB(B1, 1, 1); PG8_STAGE(PG8_SB(1, 0), b3, voffB);
            PG8_BAR; PG8_WAIT_L(0); PG8_MMA(0, 1, At, B1); PG8_BAR;
            PG8_LDA(At, 1, 1); PG8_STAGE(PG8_SA(1, 0), a3, voffA);
            PG8_BAR; PG8_WAIT_L(0); PG8_MMA(1, 0, At, B0); PG8_BAR; PG8_SCHED;
            PG8_STAGE(PG8_SB(1, 1), b3 + hstep, voffB);
            PG8_WAIT_V(6); PG8_BAR; PG8_MMA(1, 1, At, B1); PG8_BAR;
            }
        }
        if constexpr (ALIGN_EPI) { if (wr == 0) PG8_BAR; }
        if constexpr (!Epi::AFTER_DRAIN) { E(acc, cur, wr, wc, fr, fq); S.done(cur); }
        if (!has_next) break;
#pragma unroll
        for (int a = 0; a < 2; ++a)
#pragma unroll
            for (int b = 0; b < 2; ++b)
#pragma unroll
                for (int m = 0; m < 4; ++m)
#pragma unroll
                    for (int n = 0; n < 2; ++n) acc[a][b][m][n] = (f32x4){0.f, 0.f, 0.f, 0.f};
        cur = nxt; cA = nA; cB = nB; ++ui;
        if constexpr (ALIGN_EPI) { if (wr == 1) PG8_BAR; }
    }
    PG8_WAIT_V(0);
    if constexpr (!ALIGN_EPI) { if (wr == 0) PG8_BAR; }
    PG8_BAR;
    if constexpr (Epi::AFTER_DRAIN) { E.fused(acc, cur, wr, wc, fr, fq, lds, wid, lane); S.done(cur); }
#undef PG8_SA
#undef PG8_SB
#undef PG8_STAGE
#undef PG8_LDA
#undef PG8_LDB
#undef PG8_MMA
#undef PG8_WAIT_V
#undef PG8_WAIT_L
#undef PG8_BAR
#undef PG8_SCHED
}
}
constexpr int NB = 8, SEQ = 4096, DM = 1024, NT = NB * SEQ, DEPTH = 4, DFF = 4096;
constexpr int NZ = 3328;
constexpr int ZQ = 0, ZK = 512, ZV = 1024, ZR = 1536, ZKR = 2048, ZVR = 2560, ZXW = 3072, ZMV = 3232;
constexpr size_t MiB = 1u << 20;
constexpr size_t WS_WIN = 1 * MiB, WS_WOUT = 27 * MiB, WS_WUP = 35 * MiB, WS_WDN = 67 * MiB, WS_LT = 99 * MiB;
constexpr size_t WS_XN = 100 * MiB, WS_VF = 164 * MiB, WS_BON = 196 * MiB, WS_BIG = 198 * MiB;
constexpr size_t WS_Z = WS_BIG, WS_YS = 406 * MiB, WS_G = 438 * MiB, WS_VC = 470 * MiB, WS_H = WS_BIG, WS_Y1 = WS_BIG, WS_END = 502 * MiB;
constexpr int LDS_BYTES = 147456;

#define LAS __attribute__((address_space(3)))
typedef unsigned short bf16;
typedef float f32x4 __attribute__((ext_vector_type(4)));
typedef unsigned u32x4 __attribute__((ext_vector_type(4)));
typedef unsigned u32x2 __attribute__((ext_vector_type(2)));
typedef short bf16x8 __attribute__((ext_vector_type(8)));
typedef short s16x4 __attribute__((ext_vector_type(4)));

__device__ __forceinline__ float bf2f(unsigned u) { return __uint_as_float(u << 16); }
__device__ __forceinline__ float bflo(unsigned u) { return __uint_as_float(u << 16); }
__device__ __forceinline__ float bfhi(unsigned u) { return __uint_as_float(u & 0xffff0000u); }
__device__ __forceinline__ unsigned f2bf(float f) { unsigned u = __float_as_uint(f); return (u + 0x7fffu + ((u >> 16) & 1u)) >> 16; }
__device__ __forceinline__ unsigned pk2(float lo, float hi) { return f2bf(lo) | (f2bf(hi) << 16); }
__device__ __forceinline__ float dppf(float v, const int ctrl_sel) {
    int r;
    if (ctrl_sel == 0) r = __builtin_amdgcn_update_dpp(0, __float_as_int(v), 0xB1, 0xF, 0xF, false);
    else if (ctrl_sel == 1) r = __builtin_amdgcn_update_dpp(0, __float_as_int(v), 0x4E, 0xF, 0xF, false);
    else if (ctrl_sel == 2) r = __builtin_amdgcn_update_dpp(0, __float_as_int(v), 0x141, 0xF, 0xF, false);
    else r = __builtin_amdgcn_update_dpp(0, __float_as_int(v), 0x140, 0xF, 0xF, false);
    return __int_as_float(r);
}
__device__ __forceinline__ float rowsum8(float v) { v += dppf(v, 0); v += dppf(v, 1); v += dppf(v, 2); return v; }
__device__ __forceinline__ float rowsum16(float v) { v += dppf(v, 0); v += dppf(v, 1); v += dppf(v, 2); v += dppf(v, 3); return v; }
__device__ __forceinline__ float wave_sum(float v) {
    v = rowsum16(v);
    const int iv = __float_as_int(v);
    return (__int_as_float(__builtin_amdgcn_readlane(iv, 0)) + __int_as_float(__builtin_amdgcn_readlane(iv, 16))) + (__int_as_float(__builtin_amdgcn_readlane(iv, 32)) + __int_as_float(__builtin_amdgcn_readlane(iv, 48)));
}
__device__ __forceinline__ float sigmoidf_(float x) { return 1.0f / (1.0f + __expf(-x)); }

struct Params { const float* in[25]; float* out; unsigned char* ws; int ph_lo, ph_hi; };
#define RLX_AGENT __ATOMIC_RELAXED, __HIP_MEMORY_SCOPE_AGENT
#define XB_TMO      128
#define XB_XCNT(j)  (256  + 64 * (j))
#define XB_XSUB(j)  (1280 + 64 * (j))
#define XB_XGEN(j)  (2304 + 64 * (j))
#define XB_TOP      3328
#define XB_TOPGEN   3392
#define XCD_BAR_WORDS 3456
#define XB_SPIN_CAP (1u << 18)

__device__ __forceinline__ unsigned xb_ld(unsigned* p)              { return __hip_atomic_load(p, __ATOMIC_RELAXED, __HIP_MEMORY_SCOPE_AGENT); }
__device__ __forceinline__ unsigned xb_add(unsigned* p, unsigned v) { return __hip_atomic_fetch_add(p, v, __ATOMIC_RELAXED, __HIP_MEMORY_SCOPE_AGENT); }
__device__ __forceinline__ unsigned xb_xcc_id() { return (unsigned)__builtin_amdgcn_s_getreg((3 << 11) | 20) & 0xFu; }
#define XB_SPIN(cond, bar) do { unsigned _sp = 0; while (cond) { __builtin_amdgcn_s_sleep(1); \
    if ((++_sp & 255u) == 0u) { if (xb_ld(&(bar)[XB_TMO])) break; if (_sp > XB_SPIN_CAP) { atomicAdd(&(bar)[XB_TMO], 1u); break; } } } } while (0)

struct XcdBarrier {
    unsigned* bar; unsigned x;
    volatile LAS unsigned* st;
};

__device__ __forceinline__ XcdBarrier xcd_barrier_post(unsigned* bar, volatile LAS unsigned* st) {
    XcdBarrier b; b.bar = bar; b.x = xb_xcc_id(); b.st = st;
    if (threadIdx.x == 0) (void)xb_add(&bar[XB_XCNT(b.x)], 1u);
    return b;
}
__device__ __forceinline__ void xcd_barrier_complete(unsigned* bar, unsigned x, unsigned& nloc, unsigned& nx) {
    const unsigned G = gridDim.x * gridDim.y * gridDim.z;
    unsigned sum, cnt, mine, sp = 0u;
    for (;;) {
        sum = 0u; cnt = 0u; mine = 0u;
#pragma unroll
        for (unsigned j = 0; j < 16; ++j) { const unsigned c = xb_ld(&bar[XB_XCNT(j)]); sum += c; cnt += (c > 0u) ? 1u : 0u; mine = (j == x) ? c : mine; }
        if (sum == G) break;
        __builtin_amdgcn_s_sleep(1);
        if ((++sp & 255u) == 0u) { if (xb_ld(&bar[XB_TMO])) break; if (sp > XB_SPIN_CAP) { atomicAdd(&bar[XB_TMO], 1u); break; } }
    }
    nloc = mine > 0u ? mine : 1u; nx = cnt > 0u ? cnt : 1u;
}

__device__ __forceinline__ void xcd_barrier(const XcdBarrier& b) {
    asm volatile("s_waitcnt vmcnt(0)" ::: "memory");
    __syncthreads();
    if (threadIdx.x == 0) {
        unsigned* bar = b.bar;
        __builtin_amdgcn_s_waitcnt(0);
        unsigned nloc = b.st[0], nx = b.st[1];
        if (nloc == 0u) { xcd_barrier_complete(bar, b.x, nloc, nx); b.st[0] = nloc; b.st[1] = nx; }
        const unsigned old = xb_add(&bar[XB_XSUB(b.x)], 1u);
        const unsigned gen = old / nloc;
        if (old + 1u == (gen + 1u) * nloc) {
            __builtin_amdgcn_fence(__ATOMIC_RELEASE, "agent");
            asm volatile("s_waitcnt vmcnt(0)" ::: "memory");
            const unsigned og = xb_add(&bar[XB_TOP], 1u);
            const unsigned tg = og / nx;
            if (og + 1u == (tg + 1u) * nx) xb_add(&bar[XB_TOPGEN], 1u);
            else XB_SPIN(xb_ld(&bar[XB_TOPGEN]) == tg, bar);
            __builtin_amdgcn_fence(__ATOMIC_ACQUIRE, "agent");
            xb_add(&bar[XB_XGEN(b.x)], 1u);
            asm volatile("s_waitcnt vmcnt(0)" ::: "memory");
        } else {
            XB_SPIN(xb_ld(&bar[XB_XGEN(b.x)]) == gen, bar);
            __builtin_amdgcn_fence(__ATOMIC_ACQUIRE, "agent");
            asm volatile("s_waitcnt vmcnt(0)" ::: "memory");
        }
    }
    __syncthreads();
}

#define MK_IDS const int tid = pg8::mk_tid(wave_s), lane = tid & 63, wave = __builtin_amdgcn_readfirstlane(tid >> 6); const int gw = blockIdx.x * 8 + wave; (void)gw; (void)lane

__device__ __forceinline__ void transpose_item(const float* W, int K, int N, bf16* WT, LAS float* scr, int item, int lane) {
    const int nblk = N / 32, kb = item / nblk, nb = item % nblk, k0 = 64 * kb, n0 = 32 * nb;
#pragma unroll 8
    for (int i = 0; i < 32; ++i) { const int kk = 2 * i + (lane >> 5); scr[kk * 33 + (lane & 31)] = W[(size_t)(k0 + kk) * N + n0 + (lane & 31)]; }
    asm volatile("s_waitcnt lgkmcnt(0)" ::: "memory");
    const int c = lane & 7;
#pragma unroll
    for (int j = 0; j < 4; ++j) { const int n = (lane >> 3) + 8 * j; const LAS float* s = scr + (8 * c) * 33 + n;
        u32x4 o; o.x = pk2(s[0 * 33], s[1 * 33]); o.y = pk2(s[2 * 33], s[3 * 33]); o.z = pk2(s[4 * 33], s[5 * 33]); o.w = pk2(s[6 * 33], s[7 * 33]);
        *(u32x4*)(WT + (size_t)(n0 + n) * K + k0 + 8 * c) = o; }
    asm volatile("s_waitcnt lgkmcnt(0)" ::: "memory");
}

__device__ __forceinline__ void prologue(const Params& p, LAS unsigned char* lds, int gw, int NGW, int wave, int lane) {
    unsigned char* ws = p.ws;
    LAS float* scr = (LAS float*)(lds + wave * 16384);
    constexpr int I_IN0 = 16 * 101, I_INR = 16 * 102, I_OUT = 16 * 32, I_UP = 16 * 128, I_DN = 64 * 32;
    constexpr int NITEMS = I_IN0 + 3 * I_INR + 4 * I_OUT + 4 * I_UP + 4 * I_DN;
    for (int it = gw; it < NITEMS; it += NGW) {
        int r = it;
        if (r < I_IN0) { transpose_item(p.in[5], 1024, 3232, (bf16*)(ws + WS_WIN), scr, r, lane); continue; } r -= I_IN0;
        if (r < 3 * I_INR) { const int l = r / I_INR; transpose_item(p.in[6] + (size_t)l * 1024 * 3264, 1024, 3264, (bf16*)(ws + WS_WIN) + (size_t)(l + 1) * NZ * 1024, scr, r % I_INR, lane); continue; } r -= 3 * I_INR;
        if (r < 4 * I_OUT) { const int l = r / I_OUT; transpose_item(p.in[22] + (size_t)l * 1024 * 1024, 1024, 1024, (bf16*)(ws + WS_WOUT) + (size_t)l * 1024 * 1024, scr, r % I_OUT, lane); continue; } r -= 4 * I_OUT;
        if (r < 4 * I_UP) { const int l = r / I_UP; transpose_item(p.in[23] + (size_t)l * 1024 * 4096, 1024, 4096, (bf16*)(ws + WS_WUP) + (size_t)l * 4096 * 1024, scr, r % I_UP, lane); continue; } r -= 4 * I_UP;
        { const int l = r / I_DN; transpose_item(p.in[24] + (size_t)l * 4096 * 1024, 4096, 1024, (bf16*)(ws + WS_WDN) + (size_t)l * 1024 * 4096, scr, r % I_DN, lane); }
    }
    {
        const int gt = gw * 64 + lane, NG = NGW * 64;
        const u32x4 z4 = {0u, 0u, 0u, 0u};
        for (int l = 0; l < 4; ++l) { const int r0 = (l == 0) ? 3232 : 3264; const int nvec = (NZ - r0) * 1024 / 8;
            u32x4* base = (u32x4*)((bf16*)(ws + WS_WIN) + ((size_t)l * NZ + r0) * 1024);
            for (int i = gt; i < nvec; i += NG) base[i] = z4; }
        bf16* LT = (bf16*)(ws + WS_LT);
        for (int i = gt; i < 4 * 512 * 192; i += NG) { const int l = i / (512 * 192), rem = i % (512 * 192), c = rem / 192, m = rem % 192; float v;
            if (m < 32) v = p.in[11][((size_t)l * 32 + m) * 512 + c];
            else if (m < 64) v = p.in[13][((size_t)l * 32 + (m - 32)) * 512 + c];
            else if (m < 160) v = p.in[16][((size_t)l * 96 + (m - 64)) * 512 + c];
            else v = (l > 0) ? p.in[15][((size_t)(l - 1) * 32 + (m - 160)) * 512 + c] : 0.f;
            LT[i] = (bf16)f2bf(v); }
    }
    const float* x = p.in[0]; const float* g = p.in[1]; bf16* XN = (bf16*)(ws + WS_XN);
    for (int row = gw; row < NT; row += NGW) {
        const f32x4* xr = (const f32x4*)(x + (size_t)row * DM) + lane; f32x4* orow = (f32x4*)(p.out + (size_t)row * DM) + lane;
        f32x4 v[4]; float s = 0.f;
#pragma unroll
        for (int j = 0; j < 4; ++j) { v[j] = xr[64 * j]; orow[64 * j] = v[j]; s += (v[j].x * v[j].x + v[j].y * v[j].y) + (v[j].z * v[j].z + v[j].w * v[j].w); }
        const float rstd = 1.0f / sqrtf(wave_sum(s) * (1.0f / DM) + 1e-6f);
        u32x2* o8 = (u32x2*)(XN + (size_t)row * DM) + lane;
#pragma unroll
        for (int j = 0; j < 4; ++j) { const f32x4 gg = ((const f32x4*)g)[lane + 64 * j]; u32x2 w; w.x = pk2(v[j].x * rstd * gg.x, v[j].y * rstd * gg.y); w.y = pk2(v[j].z * rstd * gg.z, v[j].w * rstd * gg.w); o8[64 * j] = w; }
    }
}

__device__ __forceinline__ void norm_phase(const bf16* Y, float* X, bf16* XN, const float* gpost, const float* gnext, int gw, int NGW, int lane) {
    f32x4 gp[4], gn[4];
#pragma unroll
    for (int k = 0; k < 2; ++k)
#pragma unroll
        for (int q = 0; q < 2; ++q) { gp[k * 2 + q] = ((const f32x4*)gpost)[k * 128 + lane * 2 + q]; gn[k * 2 + q] = gnext ? ((const f32x4*)gnext)[k * 128 + lane * 2 + q] : (f32x4){0.f, 0.f, 0.f, 0.f}; }
    int row = gw; if (row >= NT) return;
    u32x4 yw[2]; f32x4 xv[4];
#define NP_LOAD(r, YW, XV) do { const u32x4* yr_ = (const u32x4*)(Y + (size_t)(r) * DM); const f32x4* xr_ = (const f32x4*)(X + (size_t)(r) * DM); \
        YW[0] = yr_[lane]; YW[1] = yr_[64 + lane]; XV[0] = xr_[lane * 2]; XV[1] = xr_[lane * 2 + 1]; XV[2] = xr_[128 + lane * 2]; XV[3] = xr_[128 + lane * 2 + 1]; } while (0)
    NP_LOAD(row, yw, xv);
    while (true) {
        const int nrow = row + NGW; const bool more = nrow < NT;
        u32x4 nyw[2] = {yw[0], yw[1]}; f32x4 nxv[4] = {xv[0], xv[1], xv[2], xv[3]};
        if (more) NP_LOAD(nrow, nyw, nxv);
        float y[16]; float ss = 0.f;
#pragma unroll
        for (int k = 0; k < 2; ++k) { const u32x4 w = yw[k];
            y[k * 8 + 0] = bflo(w.x); y[k * 8 + 1] = bfhi(w.x); y[k * 8 + 2] = bflo(w.y); y[k * 8 + 3] = bfhi(w.y); y[k * 8 + 4] = bflo(w.z); y[k * 8 + 5] = bfhi(w.z); y[k * 8 + 6] = bflo(w.w); y[k * 8 + 7] = bfhi(w.w); }
#pragma unroll
        for (int e = 0; e < 16; ++e) ss += y[e] * y[e];
        const float rstd = 1.0f / sqrtf(wave_sum(ss) * (1.0f / DM) + 1e-6f);
        float xn[16]; float s2 = 0.f; f32x4* xr = (f32x4*)(X + (size_t)row * DM);
#pragma unroll
        for (int k = 0; k < 2; ++k)
#pragma unroll
            for (int q = 0; q < 2; ++q) { f32x4 xx = xv[k * 2 + q]; const f32x4 gg = gp[k * 2 + q];
#pragma unroll
                for (int e = 0; e < 4; ++e) { const float t = xx[e] + y[k * 8 + q * 4 + e] * rstd * gg[e]; xx[e] = t; xn[k * 8 + q * 4 + e] = t; s2 += t * t; }
                xr[k * 128 + lane * 2 + q] = xx; }
        if (gnext) {
            const float r2 = 1.0f / sqrtf(wave_sum(s2) * (1.0f / DM) + 1e-6f);
            u32x4* o = (u32x4*)(XN + (size_t)row * DM);
#pragma unroll
            for (int k = 0; k < 2; ++k) { const f32x4 g0 = gn[k * 2], g1 = gn[k * 2 + 1]; u32x4 w;
                w.x = pk2(xn[k * 8 + 0] * r2 * g0.x, xn[k * 8 + 1] * r2 * g0.y); w.y = pk2(xn[k * 8 + 2] * r2 * g0.z, xn[k * 8 + 3] * r2 * g0.w);
                w.z = pk2(xn[k * 8 + 4] * r2 * g1.x, xn[k * 8 + 5] * r2 * g1.y); w.w = pk2(xn[k * 8 + 6] * r2 * g1.z, xn[k * 8 + 7] * r2 * g1.w);
                o[k * 64 + lane] = w; }
        }
        if (!more) break;
        row = nrow; yw[0] = nyw[0]; yw[1] = nyw[1]; xv[0] = nxv[0]; xv[1] = nxv[1]; xv[2] = nxv[2]; xv[3] = nxv[3];
    }
}

__device__ __forceinline__ void post_phase(bf16* MIX, const bf16* YS, const bf16* GB, const bf16* VC, const float* BON, const float* again, const float* gnw, const float* gnb, int gw, int NGW, int lane) {
    const f32x4 ag0 = ((const f32x4*)again)[lane * 2], ag1 = ((const f32x4*)again)[lane * 2 + 1];
    const f32x4 w0 = ((const f32x4*)gnw)[lane * 2], w1 = ((const f32x4*)gnw)[lane * 2 + 1], b0 = ((const f32x4*)gnb)[lane * 2], b1 = ((const f32x4*)gnb)[lane * 2 + 1];
    const float gwv[8] = {w0.x, w0.y, w0.z, w0.w, w1.x, w1.y, w1.z, w1.w}, gbv[8] = {b0.x, b0.y, b0.z, b0.w, b1.x, b1.y, b1.z, b1.w};
    int row = gw; if (row >= NT) return;
    u32x4 mo, my, mv, mg; float mb;
#define PP_LOAD(r, MO, MY, MV, MG, MB) do { MO = ((const u32x4*)(MIX + (size_t)(r) * DM))[lane]; MY = ((const u32x4*)(YS + (size_t)(r) * 512))[lane]; MV = ((const u32x4*)(VC + (size_t)(r) * 512))[lane]; \
        MG = ((const u32x4*)(GB + (size_t)(r) * 512))[lane]; MB = BON[(size_t)(r) * 8 + (lane >> 3)]; } while (0)
    PP_LOAD(row, mo, my, mv, mg, mb);
    while (true) {
        const int nrow = row + NGW; const bool more = nrow < NT;
        u32x4 no = mo, ny = my, nv = mv, ng = mg; float nb = mb;
        if (more) PP_LOAD(nrow, no, ny, nv, ng, nb);
        u32x4* mrow = (u32x4*)(MIX + (size_t)row * DM);
        {
            const u32x4 w = mo; float o[8] = {bflo(w.x), bfhi(w.x), bflo(w.y), bfhi(w.y), bflo(w.z), bfhi(w.z), bflo(w.w), bfhi(w.w)}; float ss = 0.f;
#pragma unroll
            for (int e = 0; e < 8; ++e) ss += o[e] * o[e];
            const float rstd = 1.0f / sqrtf(wave_sum(ss) * (1.0f / 512.0f) + 1e-6f);
            u32x4 r;
            r.x = pk2(o[0] * rstd * ag0.x, o[1] * rstd * ag0.y); r.y = pk2(o[2] * rstd * ag0.z, o[3] * rstd * ag0.w); r.z = pk2(o[4] * rstd * ag1.x, o[5] * rstd * ag1.y); r.w = pk2(o[6] * rstd * ag1.z, o[7] * rstd * ag1.w);
            mrow[lane] = r;
        }
        {
            const u32x4 w = my; float y[8] = {bflo(w.x), bfhi(w.x), bflo(w.y), bfhi(w.y), bflo(w.z), bfhi(w.z), bflo(w.w), bfhi(w.w)};
            float s1 = 0.f;
#pragma unroll
            for (int e = 0; e < 8; ++e) s1 += y[e];
            s1 = rowsum8(s1);
            const float mean = s1 * (1.0f / 64.0f); float s2 = 0.f;
#pragma unroll
            for (int e = 0; e < 8; ++e) { y[e] -= mean; s2 += y[e] * y[e]; }
            s2 = rowsum8(s2);
            const float rs = 1.0f / sqrtf(s2 * (1.0f / 64.0f) + 64e-5f);
            const u32x4 vw = mv, gw4 = mg;
            const float v[8] = {bflo(vw.x), bfhi(vw.x), bflo(vw.y), bfhi(vw.y), bflo(vw.z), bfhi(vw.z), bflo(vw.w), bfhi(vw.w)};
            const float g[8] = {bflo(gw4.x), bfhi(gw4.x), bflo(gw4.y), bfhi(gw4.y), bflo(gw4.z), bfhi(gw4.z), bflo(gw4.w), bfhi(gw4.w)};
            const float bon = mb;
            float o[8];
#pragma unroll
            for (int e = 0; e < 8; ++e) o[e] = (y[e] * rs * gwv[e] + gbv[e] + bon * v[e]) * g[e];
            u32x4 r; r.x = pk2(o[0], o[1]); r.y = pk2(o[2], o[3]); r.z = pk2(o[4], o[5]); r.w = pk2(o[6], o[7]);
            mrow[64 + lane] = r;
        }
        if (!more) break;
        row = nrow; mo = no; my = ny; mv = nv; mg = ng; mb = nb;
    }
}

__device__ __forceinline__ void attn_unit(LAS unsigned char* lds, const bf16* Z, bf16* MIX, int unit, int wave, int lane) {
    const int b = unit >> 4, t0 = (unit & 15) * 256;
    LAS float* ACC = (LAS float*)lds;
    LAS float* ML = (LAS float*)(lds + 256 * 68 * 4);
    LAS unsigned char* VST = lds + 256 * 68 * 4 + 2048 + wave * 4096;
    const int li = lane & 15, quad = lane >> 4;
    const float C = 0.125f * 1.4426950408889634f;
    const size_t rowbase = (size_t)b * SEQ;
    for (int h = 0; h < 8; ++h) {
#pragma unroll 1
        for (int br = 0; br < 3; ++br) {
            const int lg = br * 2; const int L = SEQ >> lg;
#pragma unroll 1
            for (int u = 0; u < 2; ++u) {
                const int tu = wave * 2 + u;
                int r, i0;
                if (br == 0) { r = 0; i0 = t0 + tu * 16; } else if (br == 1) { r = tu & 3; i0 = (t0 >> 2) + (tu >> 2) * 16; } else { r = tu; i0 = t0 >> 4; }
                const int tq = ((i0 + li) << lg) + r;
                const bf16* qp = Z + (rowbase + tq) * NZ + ZQ + h * 64 + quad * 8;
                const bf16x8 q0 = *(const bf16x8*)qp, q1 = *(const bf16x8*)(qp + 32);
                f32x4 s[9];
#pragma unroll
                for (int kt = 0; kt < 9; ++kt) {
                    int ik = i0 - 128 + kt * 16 + li; ik = ik < 0 ? 0 : ik;
                    const bf16* kp = Z + (rowbase + (ik << lg) + r) * NZ + ZK + h * 64 + quad * 8;
                    const bf16x8 k0 = *(const bf16x8*)kp, k1 = *(const bf16x8*)(kp + 32);
                    f32x4 a = {0.f, 0.f, 0.f, 0.f};
                    a = __builtin_amdgcn_mfma_f32_16x16x32_bf16(k0, q0, a, 0, 0, 0);
                    a = __builtin_amdgcn_mfma_f32_16x16x32_bf16(k1, q1, a, 0, 0, 0);
                    s[kt] = a;
                }
                u32x4 vv[5][4];
#pragma unroll
                for (int cc = 0; cc < 5; ++cc)
#pragma unroll
                    for (int it = 0; it < 4; ++it) { const int idx = it * 64 + lane, rr = idx >> 3, c16 = idx & 7; int ik = i0 - 128 + cc * 32 + rr; ik = ik < 0 ? 0 : (ik > L - 1 ? L - 1 : ik);
                        vv[cc][it] = *(const u32x4*)(Z + (rowbase + (ik << lg) + r) * NZ + ZV + h * 64 + c16 * 8); }
                float mx = -1e30f;
#pragma unroll
                for (int kt = 0; kt < 9; ++kt)
#pragma unroll
                    for (int j = 0; j < 4; ++j) { const int key = kt * 16 + quad * 4 + j; const int dist = 128 + li - key; const int ik = i0 - 128 + key;
                        const bool valid = (dist >= 0) && (dist <= 128) && (ik >= 0);
                        const float sv = valid ? s[kt][j] : -1e30f; s[kt][j] = sv; mx = fmaxf(mx, sv); }
                mx = fmaxf(mx, __shfl_xor(mx, 16)); mx = fmaxf(mx, __shfl_xor(mx, 32));
                float lsum = 0.f;
#pragma unroll
                for (int kt = 0; kt < 9; ++kt)
#pragma unroll
                    for (int j = 0; j < 4; ++j) { const float pv = __builtin_amdgcn_exp2f((s[kt][j] - mx) * C); s[kt][j] = pv; lsum += pv; }
                lsum += __shfl_xor(lsum, 16); lsum += __shfl_xor(lsum, 32);
                f32x4 o[4];
#pragma unroll
                for (int dt = 0; dt < 4; ++dt) o[dt] = (f32x4){0.f, 0.f, 0.f, 0.f};
#pragma unroll
                for (int cc = 0; cc < 5; ++cc) {
                    asm volatile("s_waitcnt lgkmcnt(0)" ::: "memory");
#pragma unroll
                    for (int it = 0; it < 4; ++it) { const int idx = it * 64 + lane, rr = idx >> 3, c16 = idx & 7;
                        *(LAS u32x4*)(VST + rr * 128 + c16 * 16) = vv[cc][it]; }
                    asm volatile("s_waitcnt lgkmcnt(0)" ::: "memory");
                    bf16x8 pa;
                    { const f32x4 p0 = s[2 * cc]; const unsigned a0 = pk2(p0[0], p0[1]), a1 = pk2(p0[2], p0[3]); unsigned a2 = 0u, a3 = 0u;
                      if (cc < 4) { const f32x4 p1 = s[2 * cc + 1 < 9 ? 2 * cc + 1 : 8]; a2 = pk2(p1[0], p1[1]); a3 = pk2(p1[2], p1[3]); }
                      const u32x4 pw = {a0, a1, a2, a3}; pa = __builtin_bit_cast(bf16x8, pw); }
#pragma unroll
                    for (int dt = 0; dt < 4; ++dt) {
                        LAS unsigned char* ap = VST + (quad * 4 + (li >> 2)) * 128 + (dt * 16 + (li & 3) * 4) * 2;
                        const s16x4 b1 = __builtin_bit_cast(s16x4, __builtin_amdgcn_ds_read_tr16_b64_v4i16((LAS s16x4*)ap));
                        const s16x4 b2 = __builtin_bit_cast(s16x4, __builtin_amdgcn_ds_read_tr16_b64_v4i16((LAS s16x4*)(ap + 16 * 128)));
                        const bf16x8 vb = {b1[0], b1[1], b1[2], b1[3], b2[0], b2[1], b2[2], b2[3]};
                        o[dt] = __builtin_amdgcn_mfma_f32_16x16x32_bf16(pa, vb, o[dt], 0, 0, 0);
                    }
                }
#pragma unroll
                for (int j = 0; j < 4; ++j) {
                    const int qq = quad * 4 + j;
                    const float mr = __shfl(mx, qq), lr = __shfl(lsum, qq);
                    const int tl = (br == 0) ? tu * 16 + qq : (br == 1) ? ((((tu >> 2) * 16 + qq) << 2) + (tu & 3)) : qq * 16 + tu;
                    LAS float* arow = ACC + tl * 68;
                    if (br == 0) {
#pragma unroll
                        for (int dt = 0; dt < 4; ++dt) arow[dt * 16 + li] = o[dt][j];
                        if (li == 0) { ML[tl * 2] = mr; ML[tl * 2 + 1] = lr; }
                    } else {
                        const float m0 = ML[tl * 2], l0 = ML[tl * 2 + 1];
                        const float mn = fmaxf(m0, mr); const float a0 = __builtin_amdgcn_exp2f((m0 - mn) * C), a1 = __builtin_amdgcn_exp2f((mr - mn) * C);
                        const float ln = l0 * a0 + lr * a1;
                        float val[4];
#pragma unroll
                        for (int dt = 0; dt < 4; ++dt) val[dt] = arow[dt * 16 + li] * a0 + o[dt][j] * a1;
                        asm volatile("s_waitcnt lgkmcnt(0)" ::: "memory");
                        if (br == 1) {
#pragma unroll
                            for (int dt = 0; dt < 4; ++dt) arow[dt * 16 + li] = val[dt];
                            if (li == 0) { ML[tl * 2] = mn; ML[tl * 2 + 1] = ln; }
                        } else {
                            const float inv = 1.0f / ln; bf16* orow = MIX + (rowbase + t0 + tl) * DM + h * 64 + li;
#pragma unroll
                            for (int dt = 0; dt < 4; ++dt) orow[dt * 16] = (bf16)f2bf(val[dt] * inv);
                        }
                    }
                }
            }
            __syncthreads();
        }
    }
}

constexpr int TC = 32, NCH = SEQ / TC;
constexpr int SB_STRIDE = 49152, SC_RS = 0, SC_WW = 8192, SC_KS = 16384, SC_KK = 24576, SC_BV = 32768, SC_VS = 40960;
constexpr int ACT_PITCH = 400, SC_ACT = 2 * SB_STRIDE, SC_LTS = SC_ACT + 4 * 8 * ACT_PITCH, SC_MU = SC_LTS + 64 * ACT_PITCH, SC_INV = SC_MU + 1536, SC_CT = SC_INV + 128;
static_assert(SC_CT + 1536 <= LDS_BYTES, "scan LDS map");
typedef float f32x2 __attribute__((ext_vector_type(2)));
struct ScanVec { f32x4 w0, w1, k0, k1, b0, b1, x0, x1, r0, r1; float v; };
__device__ __forceinline__ ScanVec scan_load(LAS const unsigned char* buf, int t, int j0, int irow) {
    ScanVec s; const LAS float* W = (const LAS float*)(buf + SC_WW) + t * 64 + j0; const LAS float* K = (const LAS float*)(buf + SC_KK) + t * 64 + j0; const LAS float* B = (const LAS float*)(buf + SC_BV) + t * 64 + j0;
    const LAS float* X = (const LAS float*)(buf + SC_KS) + t * 64 + j0; const LAS float* R = (const LAS float*)(buf + SC_RS) + t * 64 + j0;
    s.w0 = *(const LAS f32x4*)W; s.w1 = *(const LAS f32x4*)(W + 4); s.k0 = *(const LAS f32x4*)K; s.k1 = *(const LAS f32x4*)(K + 4); s.b0 = *(const LAS f32x4*)B; s.b1 = *(const LAS f32x4*)(B + 4);
    s.x0 = *(const LAS f32x4*)X; s.x1 = *(const LAS f32x4*)(X + 4); s.r0 = *(const LAS f32x4*)R; s.r1 = *(const LAS f32x4*)(R + 4); s.v = ((const LAS float*)(buf + SC_VS))[t * 64 + irow];
    return s;
}
#define LO2(a) ((f32x2){(a).x, (a).y})
#define HI2(a) ((f32x2){(a).z, (a).w})
__device__ __forceinline__ void scan_unit(LAS unsigned char* lds, const Params& p, int layer, int unit, int tid, int wave, int lane) {
    const int chain = unit >> 1, hf = unit & 1, b = chain >> 3, h = chain & 7;
    unsigned char* ws = p.ws;
    const bf16* Z = (const bf16*)(ws + WS_Z); bf16* VF = (bf16*)(ws + WS_VF); bf16* YS = (bf16*)(ws + WS_YS); bf16* GB = (bf16*)(ws + WS_G); bf16* VC = (bf16*)(ws + WS_VC); float* BON = (float*)(ws + WS_BON);
    const bf16* LT = (const bf16*)(ws + WS_LT) + (size_t)layer * 512 * 192;
    const float* mu = p.in[7] + (size_t)layer * 1696; const float* mumv = (layer > 0) ? p.in[8] + (size_t)(layer - 1) * 32 : nullptr;
    const size_t rowbase = (size_t)b * SEQ;
    LAS float* MU = (LAS float*)(lds + SC_MU); LAS unsigned char* LTS = lds + SC_LTS;
    if (tid < 96) { const int cgp = tid, cat = cgp >> 4; const int zc = (cat < 3) ? ZR + cat * 512 + h * 64 + (cgp & 15) * 4 : ZXW + (cgp - 48) * 4;
        const bool ismv = zc >= ZMV; const float* src = ismv ? (mumv ? mumv + (zc - ZMV) : mu) : mu + (zc - ZR);
        f32x4 m4 = *(const f32x4*)src; if (ismv && !mumv) m4 = (f32x4){0.f, 0.f, 0.f, 0.f};
        *(LAS f32x4*)(MU + cgp * 4) = m4; }
    if (tid < 384) { const int arr = tid >> 6, c = tid & 63, gi = layer * 512 + h * 64 + c; float v;
        if (arr == 0) v = p.in[10][gi]; else if (arr == 1) v = p.in[12][gi]; else if (arr == 2) v = (layer > 0) ? p.in[14][(layer - 1) * 512 + h * 64 + c] : 0.f; else if (arr == 3) v = p.in[17][gi]; else if (arr == 4) v = p.in[18][gi]; else v = p.in[19][gi];
        ((LAS float*)(lds + SC_CT))[tid] = v; }
    for (int i = tid; i < 64 * 24; i += 512) { const int c = i / 24, ch = i % 24; *(LAS u32x4*)(LTS + c * ACT_PITCH + ch * 16) = *(const u32x4*)(LT + (size_t)(h * 64 + c) * 192 + ch * 8); }
    __syncthreads();
    if (wave < 4) {
        const int rl = wave * 8 + (lane >> 3), irow = hf * 32 + rl, q = lane & 7, j0 = q * 8;
        f32x2 S0 = {0.f, 0.f}, S1 = {0.f, 0.f}, S2 = {0.f, 0.f}, S3 = {0.f, 0.f}; float ykeep = 0.f;
        __syncthreads();
#pragma unroll 1
        for (int c = 0; c < NCH; ++c) {
            LAS const unsigned char* buf = lds + (c & 1) * SB_STRIDE;
            const int tch = c * TC;
            ScanVec cur = scan_load(buf, 0, j0, irow);
#pragma unroll
            for (int t = 0; t < TC; ++t) {
                ScanVec nx; if (t + 1 < TC) nx = scan_load(buf, t + 1, j0, irow); else nx = cur;
                f32x2 d = S0 * LO2(cur.k0); d = S1 * HI2(cur.k0) + d; d = S2 * LO2(cur.k1) + d; d = S3 * HI2(cur.k1) + d;
                float sa = rowsum8(d.x + d.y);
                const f32x2 v2 = {cur.v, cur.v}, sa2 = {sa, sa};
                S0 = S0 * LO2(cur.w0) + (v2 * LO2(cur.x0) - sa2 * LO2(cur.b0)); S1 = S1 * HI2(cur.w0) + (v2 * HI2(cur.x0) - sa2 * HI2(cur.b0));
                S2 = S2 * LO2(cur.w1) + (v2 * LO2(cur.x1) - sa2 * LO2(cur.b1)); S3 = S3 * HI2(cur.w1) + (v2 * HI2(cur.x1) - sa2 * HI2(cur.b1));
                f32x2 e = S0 * LO2(cur.r0); e = S1 * HI2(cur.r0) + e; e = S2 * LO2(cur.r1) + e; e = S3 * HI2(cur.r1) + e;
                const float y = rowsum8(e.x + e.y);
                ykeep = (q == (t & 7)) ? y : ykeep;
                if ((t & 7) == 7) YS[(rowbase + tch + (t & ~7) + q) * 512 + h * 64 + irow] = (bf16)f2bf(ykeep);
                cur = nx;
            }
            __syncthreads();
        }
    } else {
        const int pw = wave - 4, s = lane >> 3, q = lane & 7, li = lane & 15, quad = lane >> 4;
        LAS unsigned char* ACT = lds + SC_ACT + pw * 8 * ACT_PITCH; LAS float* INV = (LAS float*)(lds + SC_INV) + pw * 8;
        const LAS float* CT = (const LAS float*)(lds + SC_CT);
        u32x2 pc[12], pp[12]; u32x4 pvf[2];
        pvf[0] = (u32x4){0u, 0u, 0u, 0u}; pvf[1] = pvf[0];
#define PR_OFF(k) ((k) < 2 ? (ZR - ZKR) + (k) * 32 : (k) < 4 ? ((k) - 2) * 32 : (k) < 6 ? (ZVR - ZKR) + ((k) - 4) * 32 : ((k) - 6) * 32)
#define PR_ISSUE(tchv) do { const int tg = (tchv) + pw * 8 + s; const int tgp = tg > 0 ? tg - 1 : 0; \
        const bf16* c1 = Z + (rowbase + tg) * NZ + ZKR + h * 64 + q * 4; const bf16* c2 = Z + (rowbase + tg) * NZ + ZXW + q * 4; \
        const bf16* p1 = Z + (rowbase + tgp) * NZ + ZKR + h * 64 + q * 4; const bf16* p2 = Z + (rowbase + tgp) * NZ + ZXW + q * 4; \
        asm volatile("" : "+v"(c1), "+v"(c2), "+v"(p1), "+v"(p2)); \
        _Pragma("unroll") for (int k = 0; k < 12; ++k) { pc[k] = *(const __attribute__((address_space(1))) u32x2*)((k < 6 ? c1 : c2) + PR_OFF(k)); pp[k] = *(const __attribute__((address_space(1))) u32x2*)((k < 6 ? p1 : p2) + PR_OFF(k)); } \
        if (layer > 0) { pvf[0] = *(const u32x4*)(VF + (rowbase + (tchv) + pw * 8 + s) * 512 + h * 64 + q * 8); } } while (0)
        PR_ISSUE(0);
#pragma unroll 1
        for (int c = 0; c <= NCH; ++c) {
            if (c < NCH) {
                const int tch = c * TC;
                LAS unsigned char* buf = lds + (c & 1) * SB_STRIDE;
                LAS float* RS = (LAS float*)(buf + SC_RS); LAS float* WW = (LAS float*)(buf + SC_WW); LAS float* KS = (LAS float*)(buf + SC_KS); LAS float* KK = (LAS float*)(buf + SC_KK);
                LAS float* BV = (LAS float*)(buf + SC_BV); LAS float* VS = (LAS float*)(buf + SC_VS);
                const u32x4 cvf0 = pvf[0];
                const float pz = (tch + pw * 8 + s > 0) ? 1.0f : 0.0f;
                const int trow = pw * 8 + s;
#pragma unroll
                for (int k = 0; k < 12; ++k) {
                    const u32x2 cw = pc[k], pw2 = pp[k];
                    const f32x4 m4 = *(const LAS f32x4*)(MU + (k * 8 + q) * 4);
                    const float c0 = bflo(cw.x), c1 = bfhi(cw.x), c2 = bflo(cw.y), c3 = bfhi(cw.y), p0 = bflo(pw2.x) * pz, p1 = bfhi(pw2.x) * pz, p2 = bflo(pw2.y) * pz, p3 = bfhi(pw2.y) * pz;
                    f32x4 v = {c0 + (p0 - c0) * m4.x, c1 + (p1 - c1) * m4.y, c2 + (p2 - c2) * m4.z, c3 + (p3 - c3) * m4.w};
                    if (k < 2) *(LAS f32x4*)(RS + trow * 64 + (k * 8 + q) * 4) = v;
                    else if (k < 4) *(LAS f32x4*)(KS + trow * 64 + ((k - 2) * 8 + q) * 4) = v;
                    else if (k < 6) *(LAS f32x4*)(VS + trow * 64 + ((k - 4) * 8 + q) * 4) = v;
                    else {
                        const int ac = ((k - 6) * 8 + q) * 4;
                        if (k == 6) {
#pragma unroll
                            for (int e = 0; e < 4; ++e) v[e] = 1.0f - 2.0f * __builtin_amdgcn_rcpf(1.0f + __expf(2.0f * v[e])); }
                        else if (k >= 8 && k <= 10) {
#pragma unroll
                            for (int e = 0; e < 4; ++e) v[e] = __builtin_amdgcn_rcpf(1.0f + __expf(-v[e])); }
                        u32x2 w; w.x = pk2(v.x, v.y); w.y = pk2(v.z, v.w); *(LAS u32x2*)(ACT + s * ACT_PITCH + ac * 2) = w; }
                }
                if (c + 1 < NCH) PR_ISSUE(tch + TC);
                asm volatile("s_waitcnt lgkmcnt(0)" ::: "memory");
                { const f32x4 ka = *(const LAS f32x4*)(KS + trow * 64 + q * 8), kb = *(const LAS f32x4*)(KS + trow * 64 + q * 8 + 4); const f32x4 kc0 = *(const LAS f32x4*)(CT + 3 * 64 + q * 8), kc1 = *(const LAS f32x4*)(CT + 3 * 64 + q * 8 + 4); const float kkl[8] = {kc0.x, kc0.y, kc0.z, kc0.w, kc1.x, kc1.y, kc1.z, kc1.w};
                  float ss = ((ka.x * kkl[0]) * (ka.x * kkl[0]) + (ka.y * kkl[1]) * (ka.y * kkl[1])) + ((ka.z * kkl[2]) * (ka.z * kkl[2]) + (ka.w * kkl[3]) * (ka.w * kkl[3]));
                  ss += ((kb.x * kkl[4]) * (kb.x * kkl[4]) + (kb.y * kkl[5]) * (kb.y * kkl[5])) + ((kb.z * kkl[6]) * (kb.z * kkl[6]) + (kb.w * kkl[7]) * (kb.w * kkl[7]));
                  ss = rowsum8(ss);
                  if (q == 0) INV[s] = 1.0f / fmaxf(sqrtf(ss), 1e-12f); }
                asm volatile("s_waitcnt lgkmcnt(0)" ::: "memory");
                {
                    bf16x8 Af[6];
#pragma unroll
                    for (int ks = 0; ks < 6; ++ks) Af[ks] = *(const LAS bf16x8*)(ACT + (li & 7) * ACT_PITCH + ks * 64 + quad * 16);
                    asm volatile("s_waitcnt lgkmcnt(0)" ::: "memory");
                    LAS float* GT = (LAS float*)ACT;
                    const int lbase = (pw * 8 + (quad & 1) * 4) * 64 + li;
#pragma unroll
                    for (int ct = 0; ct < 4; ++ct) {
                        bf16x8 Bf[6];
#pragma unroll
                        for (int ks = 0; ks < 6; ++ks) Bf[ks] = *(const LAS bf16x8*)(LTS + (ct * 16 + li) * ACT_PITCH + ks * 64 + quad * 16);
                        const f32x4 z4 = {0.f, 0.f, 0.f, 0.f};
                        const f32x4 LW = __builtin_amdgcn_mfma_f32_16x16x32_bf16(Af[0], Bf[0], z4, 0, 0, 0);
                        const f32x4 AA = __builtin_amdgcn_mfma_f32_16x16x32_bf16(Af[1], Bf[1], z4, 0, 0, 0);
                        f32x4 G = __builtin_amdgcn_mfma_f32_16x16x32_bf16(Af[2], Bf[2], z4, 0, 0, 0);
                        G = __builtin_amdgcn_mfma_f32_16x16x32_bf16(Af[3], Bf[3], G, 0, 0, 0);
                        G = __builtin_amdgcn_mfma_f32_16x16x32_bf16(Af[4], Bf[4], G, 0, 0, 0);
                        const f32x4 VG = __builtin_amdgcn_mfma_f32_16x16x32_bf16(Af[5], Bf[5], z4, 0, 0, 0);
                        if (quad < 2) {
#pragma unroll
                            for (int j = 0; j < 4; ++j) { const int lo = lbase + j * 64 + ct * 16; WW[lo] = LW[j]; KK[lo] = AA[j]; BV[lo] = VG[j]; GT[((quad & 1) * 4 + j) * 64 + ct * 16 + li] = G[j]; }
                        }
                    }
                }
                asm volatile("s_waitcnt lgkmcnt(0)" ::: "memory");
                {
                    const LAS float* GT = (const LAS float*)ACT;
                    const int lo8 = trow * 64 + q * 8; const size_t go8 = (rowbase + tch + trow) * 512 + h * 64 + q * 8;
                    float r[8], k[8], v[8], lw[8], aa[8], vg[8], g[8], c_w0[8], c_a0[8], c_v0[8], c_kk[8], c_ka[8], c_rk[8];
#define LD8(dst, ptr) do { const f32x4 _a = *(const LAS f32x4*)(ptr), _b = *(const LAS f32x4*)((ptr) + 4); dst[0] = _a.x; dst[1] = _a.y; dst[2] = _a.z; dst[3] = _a.w; dst[4] = _b.x; dst[5] = _b.y; dst[6] = _b.z; dst[7] = _b.w; } while (0)
                    LD8(r, RS + lo8); LD8(k, KS + lo8); LD8(v, VS + lo8); LD8(lw, WW + lo8); LD8(aa, KK + lo8); LD8(vg, BV + lo8); LD8(g, GT + s * 64 + q * 8);
                    LD8(c_w0, CT + q * 8); LD8(c_a0, CT + 64 + q * 8); LD8(c_v0, CT + 128 + q * 8); LD8(c_kk, CT + 192 + q * 8); LD8(c_ka, CT + 256 + q * 8); LD8(c_rk, CT + 320 + q * 8);
                    const float invn = INV[s];
                    float vf[8];
                    { const u32x4 cv = cvf0; vf[0] = bflo(cv.x); vf[1] = bfhi(cv.x); vf[2] = bflo(cv.y); vf[3] = bfhi(cv.y); vf[4] = bflo(cv.z); vf[5] = bfhi(cv.z); vf[6] = bflo(cv.w); vf[7] = bfhi(cv.w); }
                    float ow[8], okm[8], okk[8], obv[8]; float bp = 0.f;
#pragma unroll
                    for (int e = 0; e < 8; ++e) {
                        const float sg = __builtin_amdgcn_rcpf(1.0f + __expf(-(c_w0[e] + lw[e])));
                        ow[e] = __expf(-0.6065306597126334f * sg);
                        const float a = __builtin_amdgcn_rcpf(1.0f + __expf(-(c_a0[e] + aa[e])));
                        okk[e] = k[e] * c_kk[e] * invn; okm[e] = k[e] * (1.0f + (a - 1.0f) * c_ka[e]); obv[e] = okk[e] * a;
                        if (layer > 0) { const float vgs = __builtin_amdgcn_rcpf(1.0f + __expf(-(c_v0[e] + vg[e]))); v[e] = v[e] + (vf[e] - v[e]) * vgs; }
                        bp += r[e] * okm[e] * c_rk[e];
                    }
#define ST8(ptr, src) do { *(LAS f32x4*)(ptr) = (f32x4){src[0], src[1], src[2], src[3]}; *(LAS f32x4*)((ptr) + 4) = (f32x4){src[4], src[5], src[6], src[7]}; } while (0)
                    ST8(WW + lo8, ow); ST8(KS + lo8, okm); ST8(KK + lo8, okk); ST8(BV + lo8, obv); ST8(VS + lo8, v);
                    bp = rowsum8(bp);
                    if (hf == 0) {
                        u32x4 gv, vv; gv.x = pk2(g[0], g[1]); gv.y = pk2(g[2], g[3]); gv.z = pk2(g[4], g[5]); gv.w = pk2(g[6], g[7]);
                        vv.x = pk2(v[0], v[1]); vv.y = pk2(v[2], v[3]); vv.z = pk2(v[4], v[5]); vv.w = pk2(v[6], v[7]);
                        *(u32x4*)(GB + go8) = gv; *(u32x4*)(VC + go8) = vv; if (layer == 0) *(u32x4*)(VF + go8) = vv;
                        if (q == 0) BON[(rowbase + tch + trow) * 8 + h] = bp;
                    }
                }
            }
            __syncthreads();
        }
    }
}

#ifdef MK_GEMM_TWICE
#define GEMM_AGAIN __syncthreads(); pg8::gemm_phase<decltype(E), pg8::StaticOrder, true, true>(lds, g, S, E, wave_s)
#else
#define GEMM_AGAIN
#endif
#ifdef MK_ATTN_TWICE
#define ATTN_CALL2 attn_unit(lds, Zb, XN, u - 128, wave, lane)
#else
#define ATTN_CALL2
#endif
#ifndef MK_NO_SCAN
#define SCAN_CALL scan_unit(lds, p, l, u, tid, wave, lane)
#else
#define SCAN_CALL
#endif
#ifndef MK_NO_ATTN
#define ATTN_CALL attn_unit(lds, Zb, XN, u - 128, wave, lane)
#else
#define ATTN_CALL
#endif
__global__ void __launch_bounds__(512, 2) mk_fwd(Params p) {
    extern __shared__ __attribute__((aligned(16))) unsigned char lds_raw[];
    LAS unsigned char* lds = (LAS unsigned char*)lds_raw;
    cg::grid_group grid = cg::this_grid();
    { volatile LAS unsigned* st0 = (volatile LAS unsigned*)(lds + LDS_BYTES - 64); if (threadIdx.x < 2) st0[threadIdx.x] = 0u; }
    __syncthreads();
    XcdBarrier xbar = xcd_barrier_post((unsigned*)p.ws, (volatile LAS unsigned*)(lds + LDS_BYTES - 64));
    const int G = gridDim.x, NGW = G * 8;
    const int wave_s = __builtin_amdgcn_readfirstlane(threadIdx.x >> 6);
    unsigned char* ws = p.ws;
    bf16* XN = (bf16*)(ws + WS_XN); bf16* Zb = (bf16*)(ws + WS_Z); bf16* Hb = (bf16*)(ws + WS_H); bf16* Y1 = (bf16*)(ws + WS_Y1);
    int ph = 0;
#define PH_ON (ph >= p.ph_lo && ph < p.ph_hi)
#define PH_END do { if (ph + 1 < p.ph_hi) { if (ph == 0) grid.sync(); else xcd_barrier(xbar); } } while (0)
    if (PH_ON) { MK_IDS; prologue(p, lds, gw, NGW, wave, lane); PH_END; } ++ph;
#pragma unroll 1
    for (int l = 0; l < DEPTH; ++l) {
        if (PH_ON) { pg8::Gemm g{XN, (const bf16*)(ws + WS_WIN) + (size_t)l * NZ * 1024, NT, NZ, 1024}; pg8::StaticOrder S; S.init(NT, NZ, G, (int)blockIdx.x);
            pg8::EpiAct<0> E{Zb, NZ}; pg8::gemm_phase<pg8::EpiAct<0>, pg8::StaticOrder, true, true>(lds, g, S, E, wave_s); GEMM_AGAIN; PH_END; } ++ph;
        if (PH_ON) { MK_IDS;
            for (int u = blockIdx.x; u < 128; u += G) { SCAN_CALL; __syncthreads(); }
            for (int u = (blockIdx.x >= 128 ? blockIdx.x : blockIdx.x + ((127 - blockIdx.x) / G + 1) * G); u < 256; u += G) { ATTN_CALL; __syncthreads(); ATTN_CALL2; __syncthreads(); }
#ifdef MK_P2_TWICE
            __syncthreads();
            for (int u = blockIdx.x; u < 128; u += G) { SCAN_CALL; __syncthreads(); }
            for (int u = (blockIdx.x >= 128 ? blockIdx.x : blockIdx.x + ((127 - blockIdx.x) / G + 1) * G); u < 256; u += G) { ATTN_CALL; __syncthreads(); ATTN_CALL2; __syncthreads(); }
#endif
            PH_END; } ++ph;
        if (PH_ON) { MK_IDS; post_phase(XN, (const bf16*)(ws + WS_YS), (const bf16*)(ws + WS_G), (const bf16*)(ws + WS_VC), (const float*)(ws + WS_BON), p.in[9] + l * 512, p.in[20] + l * 512, p.in[21] + l * 512, gw, NGW, lane); PH_END; } ++ph;
        if (PH_ON) { pg8::Gemm g{XN, (const bf16*)(ws + WS_WOUT) + (size_t)l * 1024 * 1024, NT, 1024, 1024}; pg8::StaticOrder S; S.init(NT, 1024, G, (int)blockIdx.x);
            pg8::EpiAct<0> E{Y1, 1024}; pg8::gemm_phase<pg8::EpiAct<0>, pg8::StaticOrder, true, true>(lds, g, S, E, wave_s); GEMM_AGAIN; PH_END; } ++ph;
        if (PH_ON) { MK_IDS; norm_phase(Y1, p.out, XN, p.in[2] + l * 1024, p.in[3] + l * 1024, gw, NGW, lane); PH_END; } ++ph;
        if (PH_ON) { pg8::Gemm g{XN, (const bf16*)(ws + WS_WUP) + (size_t)l * 4096 * 1024, NT, DFF, 1024}; pg8::StaticOrder S; S.init(NT, DFF, G, (int)blockIdx.x);
            pg8::EpiAct<1> E{Hb, DFF}; pg8::gemm_phase<pg8::EpiAct<1>, pg8::StaticOrder, true, true>(lds, g, S, E, wave_s); GEMM_AGAIN; PH_END; } ++ph;
        if (PH_ON) { pg8::Gemm g{Hb, (const bf16*)(ws + WS_WDN) + (size_t)l * 1024 * 4096, NT, 1024, DFF}; pg8::StaticOrder S; S.init(NT, 1024, G, (int)blockIdx.x);
            pg8::EpiAct<0> E{XN, 1024}; pg8::gemm_phase<pg8::EpiAct<0>, pg8::StaticOrder, true, true>(lds, g, S, E, wave_s); GEMM_AGAIN; PH_END; } ++ph;
        if (PH_ON) { MK_IDS; norm_phase(XN, p.out, XN, p.in[4] + l * 1024, (l + 1 < DEPTH) ? p.in[1] + (l + 1) * 1024 : nullptr, gw, NGW, lane); PH_END; } ++ph;
    }
}
constexpr int N_PHASES = 1 + 8 * DEPTH;

extern "C" void kernel_launch(void* const* d_in, const int* in_sizes, int n_in, void* d_out, int out_size, void* d_ws, size_t ws_size, hipStream_t stream) {
    static int grid = 0;
    if (grid == 0) {
        if (n_in != 25 || out_size != NT * DM || ws_size < WS_END) { fprintf(stderr, "kernel_launch: unexpected sizes n_in=%d out=%d ws=%zu\n", n_in, out_size, ws_size); grid = -1; return; }
        int dev = 0, cus = 0, per_cu = 0;
        hipGetDevice(&dev); hipDeviceGetAttribute(&cus, hipDeviceAttributeMultiprocessorCount, dev);
        if (hipFuncSetAttribute((const void*)mk_fwd, hipFuncAttributeMaxDynamicSharedMemorySize, LDS_BYTES) != hipSuccess) { fprintf(stderr, "kernel_launch: hipFuncSetAttribute failed\n"); grid = -1; return; }
        if (hipOccupancyMaxActiveBlocksPerMultiprocessor(&per_cu, (const void*)mk_fwd, 512, LDS_BYTES) != hipSuccess || per_cu < 1) { fprintf(stderr, "kernel_launch: occupancy query gave %d\n", per_cu); per_cu = 1; }
        (void)hipGetLastError();
        grid = cus * per_cu;
        fprintf(stderr, "kernel_launch: grid %d (cus %d x %d)\n", grid, cus, per_cu);
    }
    if (grid < 0) return;
    if (hipMemsetAsync(d_ws, 0, 16384, stream) != hipSuccess) { fprintf(stderr, "kernel_launch: memset of barrier words failed\n"); return; }
    Params p{};
    for (int i = 0; i < 25; ++i) p.in[i] = (const float*)d_in[i];
    p.out = (float*)d_out; p.ws = (unsigned char*)d_ws;
#if MK_MULTI
    for (int ph = 0; ph < N_PHASES; ++ph) { p.ph_lo = ph; p.ph_hi = ph + 1; int reps = 1;
#ifdef MK_REP_P2
        if (ph >= 1 && ((ph - 1) % 8) == 1) reps = 2;
#endif
#ifdef MK_REP_P0
        if (ph == 0) reps = 2;
#endif
        for (int r = 0; r < reps; ++r) hipLaunchKernelGGL(mk_fwd, dim3(grid), dim3(512), LDS_BYTES, stream, p); }
#else
    p.ph_lo = 0; p.ph_hi = N_PHASES;
    void* args[] = {&p};
    hipError_t e = hipLaunchCooperativeKernel((const void*)mk_fwd, dim3(grid), dim3(512), args, LDS_BYTES, stream);
    if (e != hipSuccess) fprintf(stderr, "kernel_launch: cooperative launch failed: %s (grid %d)\n", hipGetErrorString(e), grid);
#endif
}
```
